# Optimizing an MI355X kernel written in HIP

```python
import jax
import jax.numpy as jnp
from jax import lax
import numpy as np

D_MODEL = 1024
BATCH = 8
SEQ = 2048
DEPTH = 4

GRID_W = 64
CTX_LEN = 256

POOL_GROUPS = 4
POOL_GROUP_DIM = 64
POOL_WIDTH = POOL_GROUPS * POOL_GROUP_DIM
POOL_HALF_WINDOWS = (1, 2, 4, 8)
NA_HEADS = 4
NA_HEAD_DIM = 64
NA_WIDTH = NA_HEADS * NA_HEAD_DIM
NA_WIN_ROWS = 8
NA_WIN_COLS = 16
ML_HEADS = 4
ML_HEAD_DIM = 128
ML_WIDTH = ML_HEADS * ML_HEAD_DIM
ML_CHUNK = 128
ML_CONV = 3
ML_M_INIT = -1e30
ROPE_THETA = 10000.0
D_FF = 3584
N_EXPERTS = 8
TOP_K = 2
MOE_BLOCK = 256
N_BRANCHES = 3
ALPHA = (2 * DEPTH) ** 0.25
BETA = (8 * DEPTH) ** -0.25
LN_EPS = 1e-6
OFF_NA = POOL_WIDTH
OFF_ML = OFF_NA + 3 * NA_WIDTH
OFF_MLO = OFF_ML + 3 * ML_WIDTH
OFF_MLG = OFF_MLO + ML_WIDTH
OFF_GATE = OFF_MLG + 4 * ML_HEADS
N_IN = OFF_GATE + N_BRANCHES * D_MODEL
IN_OFFSETS = (OFF_NA, OFF_ML, OFF_MLO, OFF_MLG, OFF_GATE)
F32 = jnp.float32

kernel_name = 'hybrid_pool_natten_mlstm_moe_dit'


def ln_plain(x):
    x32 = x.astype(F32)
    xc = x32 - jnp.mean(x32, axis=-1, keepdims=True)
    return (xc * lax.rsqrt(jnp.mean(xc * xc, axis=-1, keepdims=True) + LN_EPS)).astype(x.dtype)


def ln_affine(x, g, b):
    return ln_plain(x) * g + b


def modulate(xn, shift, scale):
    return xn * (1 + scale) + shift


def swiglu(h, w1, w3, w2):
    return (jax.nn.silu(h @ w1) * (h @ w3)) @ w2


def multiscale_pool(a, pool_w, pool_scale):
    B, L, _ = a.shape
    a32 = a.astype(F32).reshape(B, L, POOL_GROUPS, POOL_GROUP_DIM)
    csum = jnp.concatenate([jnp.zeros_like(a32[:, :1]), jnp.cumsum(a32, axis=1)], axis=1)
    t = jnp.arange(L)[:, None]
    half = jnp.array(POOL_HALF_WINDOWS)[None, :]
    lo = jnp.clip(t - half, 0, L)
    hi = jnp.clip(t + half, 0, L)
    gidx = jnp.arange(POOL_GROUPS)[None, :]
    mean = (csum[:, hi, gidx, :] - csum[:, lo, gidx, :]) / (hi - lo).astype(F32)[None, :, :, None]
    out = jnp.einsum('blgc,gcd->blgd', mean - a32, pool_w.astype(F32)).reshape(B, L, POOL_WIDTH)
    return (out * pool_scale).astype(a.dtype)


def na_heads(qkv):
    B, L, _ = qkv.shape
    t = qkv.reshape(B, L, 3, NA_HEADS, NA_HEAD_DIM)
    return t[:, :, 0] * NA_HEAD_DIM ** -0.5, t[:, :, 1], t[:, :, 2]


def neighbourhood_attention(q, k, v, kc, vc, rpb):
    B, L, H, dh = q.shape
    rows = L // GRID_W
    wr = min(NA_WIN_ROWS, rows)
    r = jnp.arange(rows)
    row_idx = jnp.clip(r - wr // 2, 0, rows - wr)[:, None] + jnp.arange(wr)[None, :]
    col = jnp.arange(GRID_W)
    col_start = jnp.clip(col - NA_WIN_COLS // 2, 0, GRID_W - NA_WIN_COLS)
    in_window = (col[None, :] >= col_start[:, None]) & (col[None, :] < col_start[:, None] + NA_WIN_COLS)
    col_off = jnp.clip(col[None, :] - col[:, None], -(NA_WIN_COLS - 1), NA_WIN_COLS - 1) + NA_WIN_COLS - 1
    row_off = row_idx - r[:, None] + NA_WIN_ROWS - 1
    qg = q.reshape(B, rows, GRID_W, H, dh)
    kg = k.reshape(B, rows, GRID_W, H, dh)[:, row_idx]
    vg = v.reshape(B, rows, GRID_W, H, dh)[:, row_idx]
    bias = rpb[:, row_off[:, None, :, None], col_off[None, :, None, :]]
    s_loc = jnp.einsum('brqhd,brwkhd->bhrqwk', qg, kg).astype(F32) + bias.astype(F32)
    s_loc = jnp.where(in_window[:, None, :], s_loc, -jnp.inf)
    s_ctx = jnp.einsum('brqhd,bchd->bhrqc', qg, kc).astype(F32)
    n_loc = wr * GRID_W
    s = jnp.concatenate([s_loc.reshape(B, H, rows, GRID_W, n_loc), s_ctx], axis=-1)
    p = jax.nn.softmax(s, axis=-1).astype(v.dtype)
    p_loc = p[..., :n_loc].reshape(B, H, rows, GRID_W, wr, GRID_W)
    o = jnp.einsum('bhrqwk,brwkhd->brqhd', p_loc, vg) + jnp.einsum('bhrqc,bchd->brqhd', p[..., n_loc:], vc)
    return o.reshape(B, L, H * dh)


def context_attention(qc, kc, vc):
    B, C, H, dh = qc.shape
    p = jax.nn.softmax(jnp.einsum('bqhd,bkhd->bhqk', qc, kc).astype(F32), axis=-1).astype(vc.dtype)
    return jnp.einsum('bhqk,bkhd->bqhd', p, vc).reshape(B, C, H * dh)


def centred_dwconv(x, w):
    K = w.shape[0]
    return lax.conv_general_dilated(x, w[:, None, :].astype(x.dtype), window_strides=(1,),
                                    padding=[(K // 2, K - 1 - K // 2)],
                                    dimension_numbers=('NWC', 'WIO', 'NWC'),
                                    feature_group_count=x.shape[-1])


def axial_rope(t):
    L, dh = t.shape[2], t.shape[3]
    pos = jnp.arange(L)
    half = dh // 2
    nf = half // 2
    inv = ROPE_THETA ** (-jnp.arange(nf, dtype=F32) / nf)

    def rot(part, p):
        ang = p.astype(F32)[:, None] * inv[None, :]
        cos, sin = jnp.cos(ang), jnp.sin(ang)
        x1, x2 = part[..., :nf], part[..., nf:]
        return jnp.concatenate([x1 * cos - x2 * sin, x1 * sin + x2 * cos], axis=-1)

    return jnp.concatenate([rot(t[..., :half], pos // GRID_W), rot(t[..., half:], pos % GRID_W)], axis=-1)


def mlstm_inputs(qkv, gate_pre, conv_w, gate_bias, rotary):
    B, L, _ = qkv.shape
    qk = jax.nn.silu(centred_dwconv(qkv[..., :2 * ML_WIDTH], conv_w))

    def heads(t):
        return t.astype(F32).reshape(B, L, ML_HEADS, ML_HEAD_DIM).transpose(0, 2, 1, 3)

    q = heads(qk[..., :ML_WIDTH])
    k = heads(qk[..., ML_WIDTH:]) * ML_HEAD_DIM ** -0.5
    v = heads(qkv[..., 2 * ML_WIDTH:])
    if rotary:
        q, k = axial_rope(q), axial_rope(k)
    g = (gate_pre.astype(F32) + gate_bias).reshape(B, L, 4, ML_HEADS).transpose(2, 0, 3, 1)
    return (q, k, v, g[0], jax.nn.log_sigmoid(g[1]), g[2], jax.nn.log_sigmoid(g[3]))


def mlstm_zero_state(B):
    return (jnp.zeros((B, ML_HEADS, ML_HEAD_DIM, ML_HEAD_DIM), F32),
            jnp.zeros((B, ML_HEADS, ML_HEAD_DIM), F32),
            jnp.full((B, ML_HEADS), ML_M_INIT, F32))


def mlstm_chunkwise(q, k, v, ig, lf, state):
    B, H, L, d = q.shape
    nc = L // ML_CHUNK

    def to_chunks(a):
        return jnp.moveaxis(a.reshape(B, H, nc, ML_CHUNK, *a.shape[3:]), 2, 0)

    tril = jnp.tril(jnp.ones((ML_CHUNK, ML_CHUNK), bool))

    def step(carry, xs):
        C, n, m = carry
        qb, kb, vb, ib, fb = xs
        b = jnp.cumsum(fb, axis=-1)
        log_d = jnp.where(tril, b[..., :, None] - b[..., None, :] + ib[..., None, :], -jnp.inf)
        inter = b + m[..., None]
        m_t = jnp.maximum(jnp.max(log_d, axis=-1), inter)
        s = jnp.einsum('bhtd,bhsd->bhts', qb, kb) * jnp.exp(log_d - m_t[..., None])
        w_inter = jnp.exp(inter - m_t)
        num = jnp.einsum('bhts,bhse->bhte', s, vb) + w_inter[..., None] * jnp.einsum('bhtd,bhde->bhte', qb, C)
        den = jnp.sum(s, axis=-1) + w_inter * jnp.einsum('bhtd,bhd->bht', qb, n)
        h = num / jnp.maximum(jnp.abs(den), jnp.exp(-m_t))[..., None]
        b_end = b[..., -1]
        log_w = b_end[..., None] - b + ib
        m_new = jnp.maximum(b_end + m, jnp.max(log_w, axis=-1))
        w = jnp.exp(log_w - m_new[..., None])
        decay = jnp.exp(b_end + m - m_new)
        C_new = decay[..., None, None] * C + jnp.einsum('bhs,bhsd,bhse->bhde', w, kb, vb)
        n_new = decay[..., None] * n + jnp.einsum('bhs,bhsd->bhd', w, kb)
        return (C_new, n_new, m_new), h

    state, h = lax.scan(step, state, (to_chunks(q), to_chunks(k), to_chunks(v), to_chunks(ig), to_chunks(lf)))
    return jnp.moveaxis(h, 0, 2).reshape(B, H, L, d), state


def mlstm_bidirectional(lat, ctx_in):
    q, k, v, igf, lff, igb, lfb = lat
    qc, kc, vc, igcf, lfcf, igcb, lfcb = ctx_in
    zero = mlstm_zero_state(q.shape[0])

    def flip(t):
        return jnp.flip(t, axis=2)

    hc_f, st_f = mlstm_chunkwise(qc, kc, vc, igcf, lfcf, zero)
    hc_b, st_b = mlstm_chunkwise(flip(qc), flip(kc), flip(vc), flip(igcb), flip(lfcb), zero)
    h_f, _ = mlstm_chunkwise(q, k, v, igf, lff, st_f)
    h_b, _ = mlstm_chunkwise(flip(q), flip(k), flip(v), flip(igb), flip(lfb), st_b)
    return h_f + flip(h_b), hc_f + flip(hc_b)


def mlstm_output(h, o_pre, norm_w):
    B, H, L, d = h.shape
    hc = h - jnp.mean(h, axis=-1, keepdims=True)
    hn = (hc * lax.rsqrt(jnp.mean(hc * hc, axis=-1, keepdims=True) + LN_EPS)).transpose(0, 2, 1, 3).reshape(B, L, H * d)
    return (jax.nn.sigmoid(o_pre.astype(F32)) * hn * norm_w).astype(o_pre.dtype)


def merge_branches(a, n, m, gate_pre, w_bp, w_bn, w_bm, w_out):
    ga, gn, gm = jnp.split(jax.nn.sigmoid(gate_pre), N_BRANCHES, axis=-1)
    return (ga * (a @ w_bp) + gn * (n @ w_bn) + gm * (m @ w_bm)) @ w_out


def hybrid_mixer(u, uc, w_in, ml_gate_bias, ml_conv_w, ml_norm_w, pool_w, pool_scale, na_rpb,
                 w_bp, w_bn, w_bm, w_out, with_ctx_out):
    pool_in, na_qkv, ml_qkv, ml_o, ml_g, gates = jnp.split(u @ w_in, IN_OFFSETS, axis=-1)
    pool_c, na_qkv_c, ml_qkv_c, ml_o_c, ml_g_c, gates_c = jnp.split(uc @ w_in, IN_OFFSETS, axis=-1)
    a = multiscale_pool(pool_in, pool_w, pool_scale)
    q, k, v = na_heads(na_qkv)
    qc, kc, vc = na_heads(na_qkv_c)
    n = neighbourhood_attention(q, k, v, kc, vc, na_rpb)
    h, hc = mlstm_bidirectional(mlstm_inputs(ml_qkv, ml_g, ml_conv_w, ml_gate_bias, True),
                                mlstm_inputs(ml_qkv_c, ml_g_c, ml_conv_w, ml_gate_bias, False))
    y = merge_branches(a, n, mlstm_output(h, ml_o, ml_norm_w), gates, w_bp, w_bn, w_bm, w_out)
    if not with_ctx_out:
        return y, None
    yc = merge_branches(multiscale_pool(pool_c, pool_w, pool_scale), context_attention(qc, kc, vc),
                        mlstm_output(hc, ml_o_c, ml_norm_w), gates_c, w_bp, w_bn, w_bm, w_out)
    return y, yc


def moe_swiglu(h, router_w, router_b, w1, w3, w2):
    T, D = h.shape
    probs = jax.nn.softmax((h @ router_w).astype(F32) + router_b, axis=-1)
    top_p, top_e = lax.top_k(probs, TOP_K)
    top_p = top_p / jnp.sum(top_p, axis=-1, keepdims=True)
    n_assign = T * TOP_K
    flat_e = top_e.reshape(-1)
    flat_tok = jnp.repeat(jnp.arange(T, dtype=jnp.int32), TOP_K)
    flat_p = top_p.reshape(-1)
    order = jnp.argsort(flat_e)
    se = flat_e[order]
    counts = jnp.bincount(flat_e, length=N_EXPERTS)
    padded = (counts + MOE_BLOCK - 1) // MOE_BLOCK * MOE_BLOCK
    start = jnp.cumsum(counts) - counts
    pstart = jnp.cumsum(padded) - padded
    dest = pstart[se] + jnp.arange(n_assign) - start[se]
    n_blocks = -(-n_assign // MOE_BLOCK) + N_EXPERTS
    n_rows = n_blocks * MOE_BLOCK
    row_tok = jnp.zeros((n_rows,), jnp.int32).at[dest].set(flat_tok[order])
    row_p = jnp.zeros((n_rows,), F32).at[dest].set(flat_p[order])
    block_e = jnp.minimum(jnp.searchsorted(jnp.cumsum(padded), jnp.arange(n_blocks) * MOE_BLOCK, side='right'),
                          N_EXPERTS - 1)
    xb = h[row_tok].reshape(n_blocks, MOE_BLOCK, D)

    def expert_block(args):
        xe, e = args
        return swiglu(xe, w1[e], w3[e], w2[e])

    yb = lax.map(expert_block, (xb, block_e)).reshape(n_rows, D)
    y = jnp.zeros((T, D), F32).at[row_tok].add(yb.astype(F32) * row_p[:, None])
    return y.astype(h.dtype)


def channel_mixer(tokens, layer, ffn_w1, ffn_w3, ffn_w2, moe_router_w, moe_router_b, moe_w1, moe_w3, moe_w2):
    i = layer // 2
    if layer % 2 == 0:
        return swiglu(tokens, ffn_w1[i], ffn_w3[i], ffn_w2[i])
    return moe_swiglu(tokens, moe_router_w[i], moe_router_b[i], moe_w1[i], moe_w3[i], moe_w2[i])


def setup_inputs(seed: int = 0) -> dict:
    key = jax.random.key(seed)
    ks = jax.random.split(key, 32)
    D = D_MODEL
    n_dense = (DEPTH + 1) // 2
    n_moe = DEPTH // 2

    def nrm(k, shape, s):
        return jax.random.normal(k, shape, F32) * s

    gate_base = jnp.concatenate([jnp.zeros(ML_HEADS), jnp.linspace(3.0, 6.0, ML_HEADS)] * 2)
    return {
        'x': nrm(ks[0], (BATCH, SEQ, D), 1.0),
        'c': nrm(ks[1], (BATCH, D), 1.0),
        'ctx': nrm(ks[2], (BATCH, CTX_LEN, D), 1.0),
        'c_ctx': nrm(ks[3], (D,), 1.0),
        'w_mod': nrm(ks[4], (DEPTH, D, 6 * D), D ** -0.5),
        'b_mod': nrm(ks[5], (DEPTH, 6 * D), 0.02),
        'w_in': nrm(ks[6], (DEPTH, D, N_IN), D ** -0.5),
        'ml_gate_bias': gate_base + nrm(ks[7], (DEPTH, 4 * ML_HEADS), 0.1),
        'ml_conv_w': nrm(ks[8], (DEPTH, ML_CONV, 2 * ML_WIDTH), ML_CONV ** -0.5),
        'ml_norm_w': 1.0 + nrm(ks[9], (DEPTH, ML_WIDTH), 0.1),
        'pool_w': nrm(ks[10], (DEPTH, POOL_GROUPS, POOL_GROUP_DIM, POOL_GROUP_DIM), POOL_GROUP_DIM ** -0.5),
        'pool_scale': 1.0 + nrm(ks[11], (DEPTH, POOL_WIDTH), 0.1),
        'na_rpb': nrm(ks[12], (DEPTH, NA_HEADS, 2 * NA_WIN_ROWS - 1, 2 * NA_WIN_COLS - 1), 0.1),
        'w_branch_pool': nrm(ks[13], (DEPTH, POOL_WIDTH, D), POOL_WIDTH ** -0.5),
        'w_branch_na': nrm(ks[14], (DEPTH, NA_WIDTH, D), NA_WIDTH ** -0.5),
        'w_branch_ml': nrm(ks[15], (DEPTH, ML_WIDTH, D), ML_WIDTH ** -0.5),
        'w_out': nrm(ks[16], (DEPTH, D, D), BETA * D ** -0.5),
        'ln1_g': 1.0 + nrm(ks[17], (DEPTH, D), 0.1),
        'ln1_b': nrm(ks[18], (DEPTH, D), 0.02),
        'ln2_g': 1.0 + nrm(ks[19], (DEPTH, D), 0.1),
        'ln2_b': nrm(ks[20], (DEPTH, D), 0.02),
        'ffn_w1': nrm(ks[21], (n_dense, D, D_FF), D ** -0.5),
        'ffn_w3': nrm(ks[22], (n_dense, D, D_FF), D ** -0.5),
        'ffn_w2': nrm(ks[23], (n_dense, D_FF, D), BETA * D_FF ** -0.5),
        'moe_router_w': nrm(ks[24], (n_moe, D, N_EXPERTS), D ** -0.5),
        'moe_router_b': nrm(ks[25], (n_moe, N_EXPERTS), 0.01),
        'moe_w1': nrm(ks[26], (n_moe, N_EXPERTS, D, D_FF), D ** -0.5),
        'moe_w3': nrm(ks[27], (n_moe, N_EXPERTS, D, D_FF), D ** -0.5),
        'moe_w2': nrm(ks[28], (n_moe, N_EXPERTS, D_FF, D), BETA * D_FF ** -0.5),
    }


def reference(x, c, ctx, c_ctx, w_mod, b_mod, w_in, ml_gate_bias, ml_conv_w, ml_norm_w, pool_w, pool_scale,
              na_rpb, w_branch_pool, w_branch_na, w_branch_ml, w_out, ln1_g, ln1_b, ln2_g, ln2_b,
              ffn_w1, ffn_w3, ffn_w2, moe_router_w, moe_router_b, moe_w1, moe_w3, moe_w2):
    B, L, D = x.shape
    s_c = jax.nn.silu(c)
    s_cc = jax.nn.silu(c_ctx)
    xc = ctx
    for layer in range(DEPTH):
        last = layer == DEPTH - 1
        sh1, sc1, g1, sh2, sc2, g2 = jnp.split((s_c @ w_mod[layer] + b_mod[layer])[:, None, :], 6, axis=-1)
        csh1, csc1, cg1, csh2, csc2, cg2 = jnp.split(s_cc @ w_mod[layer] + b_mod[layer], 6, axis=-1)
        u = modulate(ln_plain(x), sh1, sc1)
        uc = modulate(ln_plain(xc), csh1, csc1)
        y, yc = hybrid_mixer(u, uc, w_in[layer], ml_gate_bias[layer], ml_conv_w[layer], ml_norm_w[layer],
                             pool_w[layer], pool_scale[layer], na_rpb[layer], w_branch_pool[layer],
                             w_branch_na[layer], w_branch_ml[layer], w_out[layer], not last)
        x = ln_affine(ALPHA * x + g1 * y, ln1_g[layer], ln1_b[layer])
        tokens = modulate(ln_plain(x), sh2, sc2).reshape(B * L, D)
        if not last:
            xc = ln_affine(ALPHA * xc + cg1 * yc, ln1_g[layer], ln1_b[layer])
            tokens = jnp.concatenate([tokens, modulate(ln_plain(xc), csh2, csc2).reshape(-1, D)], axis=0)
        f = channel_mixer(tokens, layer, ffn_w1, ffn_w3, ffn_w2, moe_router_w, moe_router_b, moe_w1, moe_w3, moe_w2)
        x = ln_affine(ALPHA * x + g2 * f[:B * L].reshape(B, L, D), ln2_g[layer], ln2_b[layer])
        if not last:
            xc = ln_affine(ALPHA * xc + cg2 * f[B * L:].reshape(xc.shape), ln2_g[layer], ln2_b[layer])
    return x
```

```cpp
#include <hip/hip_runtime.h>
#include <cstdio>
#include <cstdint>

#ifndef MK_FUSED
#define MK_FUSED 1
#endif
#ifndef USE_MLSTM_MFMA
#define USE_MLSTM_MFMA 1
#endif
#ifndef USE_NA_MFMA
#define USE_NA_MFMA 1
#endif
#ifndef PROBE_PH
#define PROBE_PH -1
#endif
#ifndef PROBE_LAYER
#define PROBE_LAYER -1
#endif
#ifndef PROBE_REP
#define PROBE_REP 0
#endif
#ifndef PH_MASK
#define PH_MASK 0xFFFF
#endif
#ifndef USE_MFMA
#define USE_MFMA 1
#endif

#define LAS __attribute__((address_space(3)))
typedef _Float16 f16;
typedef _Float16 f16x8 __attribute__((ext_vector_type(8)));
typedef _Float16 f16x4 __attribute__((ext_vector_type(4)));
typedef _Float16 f16x2 __attribute__((ext_vector_type(2)));
typedef float f32x4 __attribute__((ext_vector_type(4)));
typedef float f32x2 __attribute__((ext_vector_type(2)));
typedef unsigned u32x4 __attribute__((ext_vector_type(4)));
typedef unsigned u32x2 __attribute__((ext_vector_type(2)));

constexpr int D = 1024, NB = 8, SEQ = 2048, CTXL = 256, ML = NB * SEQ, MC = NB * CTXL, MT = ML + MC, DEPTH = 4;
constexpr int NIN = 6160, NP1 = 6144, DFF = 3584, NE = 8, NFF2 = 2 * DFF;
constexpr int MOE_MAXROWS = 38912;
constexpr float ALPHA = 1.6817928305074292f;
constexpr float LN_EPS = 1e-6f;
constexpr int NWAVES = 8, NTHREADS = 512;
constexpr int LDS_BYTES = 155648;

constexpr size_t MiB = 1u << 20;
constexpr size_t WS_CTL = 0, CTL_ZERO_BYTES = 1 * MiB;
constexpr size_t WS_MOD = 2 * MiB;
constexpr size_t WS_ROPE = 2 * MiB + 896 * 1024;
constexpr size_t WS_MLG = 3 * MiB;
constexpr size_t WS_TOK = 5 * MiB;
constexpr size_t WS_XS = 8 * MiB;
constexpr size_t WS_U16 = 80 * MiB;
constexpr size_t WS_P1 = 116 * MiB;
constexpr size_t WS_QK = 382 * MiB;
constexpr size_t WS_HFB = 418 * MiB;
constexpr size_t WS_CAT = 494 * MiB;
constexpr size_t WS_YF = 530 * MiB;
constexpr size_t YF_PART = 80 * MiB;
constexpr size_t WS_Z16 = 682 * MiB;
constexpr size_t WS_W = 718 * MiB;
constexpr size_t WO_IN = 0, WO_BP = 12 * MiB, WO_BN = WO_BP + MiB / 2, WO_BM = WO_BN + MiB / 2, WO_OUT = WO_BM + MiB, WO_13 = WO_OUT + 2 * MiB, WO_2 = WO_13 + 112 * MiB;
constexpr size_t WO_13D = 184 * MiB, WO_2D = WO_13D + 14 * MiB;
constexpr size_t WS_END = WS_W + 206 * MiB;
static_assert(WO_2 + 56 * MiB == 184 * MiB && WO_2D + 7 * MiB <= 206 * MiB, "weight map");
constexpr int CW_TMO = 0;
constexpr int CW_BAR = 4096;
constexpr int CW_MOECNT = 16384;
constexpr size_t TK_E = 0, TK_P = 160 * 1024, TK_POS = 320 * 1024, TK_DEST = 480 * 1024, TK_BLKE = 640 * 1024, TK_BCNT = 704 * 1024, TK_SRC = 768 * 1024;

__device__ __forceinline__ float row16_sum(float v) {
    v += __builtin_bit_cast(float, __builtin_amdgcn_update_dpp(0, __builtin_bit_cast(int, v), 0xB1, 0xF, 0xF, true));
    v += __builtin_bit_cast(float, __builtin_amdgcn_update_dpp(0, __builtin_bit_cast(int, v), 0x4E, 0xF, 0xF, true));
    v += __builtin_bit_cast(float, __builtin_amdgcn_update_dpp(0, __builtin_bit_cast(int, v), 0x141, 0xF, 0xF, true));
    v += __builtin_bit_cast(float, __builtin_amdgcn_update_dpp(0, __builtin_bit_cast(int, v), 0x140, 0xF, 0xF, true));
    return v;
}
__device__ __forceinline__ float wave_sum(float v) {
    v = row16_sum(v);
    v += __shfl_xor(v, 16); v += __shfl_xor(v, 32);
    return v;
}
__device__ __forceinline__ float wave_max(float v) {
#pragma unroll
    for (int o = 1; o < 64; o <<= 1) v = fmaxf(v, __shfl_xor(v, o));
    return v;
}
__device__ __forceinline__ float sigmoid_(float x) { return __builtin_amdgcn_rcpf(1.f + __expf(-x)); }
__device__ __forceinline__ float silu_(float x) { return x * __builtin_amdgcn_rcpf(1.f + __expf(-x)); }
#define LDS_WAIT() asm volatile("s_waitcnt lgkmcnt(0)" ::: "memory")
#define VM_WAIT() asm volatile("s_waitcnt vmcnt(0)" ::: "memory")


__device__ __forceinline__ int opaque_u32(int x) { int t = x; asm volatile("" : "+v"(t)); return __builtin_amdgcn_readfirstlane(t); }
__device__ __forceinline__ unsigned long long opaque_u64(unsigned long long x) { unsigned lo = (unsigned)x, hi = (unsigned)(x >> 32); asm volatile("" : "+v"(lo), "+v"(hi));
    return ((unsigned long long)(unsigned)__builtin_amdgcn_readfirstlane(hi) << 32) | (unsigned)__builtin_amdgcn_readfirstlane(lo); }

#define XB_TMO      128
#define XB_XCNT(j)  (256  + 64 * (j))
#define XB_XSUB(j)  (1280 + 64 * (j))
#define XB_XGEN(j)  (2304 + 64 * (j))
#define XB_TOP      3328
#define XB_TOPGEN   3392
#define XCD_BAR_WORDS 3456
#define XB_SPIN_CAP (1u << 22)
__device__ __forceinline__ unsigned xb_ld(unsigned* p)              { return __hip_atomic_load(p, __ATOMIC_RELAXED, __HIP_MEMORY_SCOPE_AGENT); }
__device__ __forceinline__ unsigned xb_add(unsigned* p, unsigned v) { return __hip_atomic_fetch_add(p, v, __ATOMIC_RELAXED, __HIP_MEMORY_SCOPE_AGENT); }
__device__ __forceinline__ unsigned xb_xcc_id() { return (unsigned)__builtin_amdgcn_s_getreg((3 << 11) | 20) & 0xFu; }
#define XB_SPIN(cond, bar) do { unsigned _sp = 0; while (cond) { __builtin_amdgcn_s_sleep(1); \
    if ((++_sp & 255u) == 0u) { if (xb_ld(&(bar)[XB_TMO])) break; if (_sp > XB_SPIN_CAP) { atomicAdd(&(bar)[XB_TMO], 1u); break; } } } } while (0)
struct XcdBarrier { unsigned* bar; unsigned x; volatile LAS unsigned* st; };
__device__ __forceinline__ XcdBarrier xcd_barrier_post(unsigned* bar, volatile LAS unsigned* st) {
    XcdBarrier b; b.bar = bar; b.x = xb_xcc_id(); b.st = st;
    if (threadIdx.x == 0) (void)xb_add(&bar[XB_XCNT(b.x)], 1u);
    return b;
}
__device__ __forceinline__ void xcd_barrier_complete(unsigned* bar, unsigned x, unsigned& nloc, unsigned& nx) {
    const unsigned G = gridDim.x * gridDim.y * gridDim.z;
    unsigned sum, cnt, mine, sp = 0u;
    for (;;) {
        sum = 0u; cnt = 0u; mine = 0u;
#pragma unroll
        for (unsigned j = 0; j < 16; ++j) { const unsigned c = xb_ld(&bar[XB_XCNT(j)]); sum += c; cnt += (c > 0u) ? 1u : 0u; }
        mine = xb_ld(&bar[XB_XCNT(x)]);
        if (sum == G) break;
        __builtin_amdgcn_s_sleep(1);
        if ((++sp & 255u) == 0u) { if (xb_ld(&bar[XB_TMO])) break; if (sp > XB_SPIN_CAP) { atomicAdd(&bar[XB_TMO], 1u); break; } }
    }
    nloc = mine > 0u ? mine : 1u; nx = cnt > 0u ? cnt : 1u;
}
__device__ __forceinline__ void xcd_barrier(const XcdBarrier& b) {
    asm volatile("s_waitcnt vmcnt(0)" ::: "memory");
    __syncthreads();
    if (threadIdx.x == 0) {
        const unsigned long long bi_ = opaque_u64((unsigned long long)b.bar); unsigned* bar = (unsigned*)(__attribute__((address_space(1))) unsigned*)bi_;
        __builtin_amdgcn_s_waitcnt(0);
        unsigned nloc = b.st[0], nx = b.st[1];
        if (nloc == 0u) { xcd_barrier_complete(bar, b.x, nloc, nx); b.st[0] = nloc; b.st[1] = nx; }
        const unsigned old = xb_add(&bar[XB_XSUB(b.x)], 1u);
        const unsigned gen = old / nloc;
        if (old + 1u == (gen + 1u) * nloc) {
            __builtin_amdgcn_fence(__ATOMIC_RELEASE, "agent");
            asm volatile("s_waitcnt vmcnt(0)" ::: "memory");
            const unsigned og = xb_add(&bar[XB_TOP], 1u);
            const unsigned tg = og / nx;
            if (og + 1u == (tg + 1u) * nx) xb_add(&bar[XB_TOPGEN], 1u);
            else XB_SPIN(xb_ld(&bar[XB_TOPGEN]) == tg, bar);
            __builtin_amdgcn_fence(__ATOMIC_ACQUIRE, "agent");
            xb_add(&bar[XB_XGEN(b.x)], 1u);
            asm volatile("s_waitcnt vmcnt(0)" ::: "memory");
        } else {
            XB_SPIN(xb_ld(&bar[XB_XGEN(b.x)]) == gen, bar);
            __builtin_amdgcn_fence(__ATOMIC_ACQUIRE, "agent");
            asm volatile("s_waitcnt vmcnt(0)" ::: "memory");
        }
    }
    __syncthreads();
}

struct Args { const float* in[29]; float* out; unsigned char* ws; int s_lo, s_hi; };
enum { I_X = 0, I_C, I_CTX, I_CCTX, I_WMOD, I_BMOD, I_WIN, I_GBIAS, I_CONVW, I_NORMW, I_POOLW, I_POOLS, I_RPB, I_WBP, I_WBN, I_WBM, I_WOUT,
       I_LN1G, I_LN1B, I_LN2G, I_LN2B, I_FW1, I_FW3, I_FW2, I_RW, I_RB, I_MW1, I_MW3, I_MW2 };


constexpr int TAIL_OFF = LDS_BYTES - 1024, PTAB_OFF = TAIL_OFF + 256;
__device__ __forceinline__ const float* inp_ptr(LAS unsigned char* lds, int i) {
    const LAS unsigned* t = (const LAS unsigned*)(lds + PTAB_OFF);
    const unsigned lo = __builtin_amdgcn_readfirstlane(t[2 * i]), hi = __builtin_amdgcn_readfirstlane(t[2 * i + 1]);
    return (const float*)(const __attribute__((address_space(1))) float*)(((unsigned long long)hi << 32) | lo);
}
#define INP(i) inp_ptr(lds, (i))

__device__ __forceinline__ u32x4 pack8(const float (&v)[8]) {
    f16x8 h;
#pragma unroll
    for (int i = 0; i < 8; ++i) h[i] = (f16)v[i];
    return __builtin_bit_cast(u32x4, h);
}
struct EpiP1 {
    static constexpr bool MIDK = false, GATHER = false;
    f16* P1;
    __device__ __forceinline__ void emit_part(int, int, int, const float (&)[8]) const {}
    __device__ __forceinline__ void emit8(int row, int col, const float (&v)[8]) const {
        const float s = (col >= 256 && col < 512) ? 0.125f : 1.f;
        float w[8];
        if (col >= 2560) {
#pragma unroll
            for (int i = 0; i < 8; ++i) w[i] = sigmoid_(v[i]);
        } else {
#pragma unroll
            for (int i = 0; i < 8; ++i) w[i] = v[i] * s;
        }
        *(u32x4*)(P1 + (size_t)row * NP1 + col) = pack8(w);
    }
};
struct EpiMerge {
    static constexpr bool MIDK = true, GATHER = false;
    const f16* P1; f16* Z16; float* PART;
    __device__ __forceinline__ void emit_part(int part, int row, int col, const float (&v)[8]) const {
        const int gi = part < 2 ? part : 2;
        const f16x8 g = *(const f16x8*)(P1 + (size_t)row * NP1 + 3072 + gi * 1024 + col);
        float* p = PART + ((size_t)part * MC + (row - ML)) * D + col;
        f32x4 w0, w1;
#pragma unroll
        for (int i = 0; i < 4; ++i) { w0[i] = v[i] * (gi == 0 ? (float)g[i] : fmaxf((float)g[i], 1e-4f)); w1[i] = v[4 + i] * (gi == 0 ? (float)g[4 + i] : fmaxf((float)g[4 + i], 1e-4f)); }
        *(f32x4*)p = w0; *(f32x4*)(p + 4) = w1;
    }
    __device__ __forceinline__ void mid8(int row, int col, float (&v)[8], int which) const {
        const f16* gp = P1 + (size_t)row * NP1 + 3072 + col;
        const f16x8 gnum = *(const f16x8*)(gp + (which == 0 ? 0 : 1024)), gden = *(const f16x8*)(gp + (which == 0 ? 1024 : 2048));
#pragma unroll
        for (int i = 0; i < 8; ++i) { const float num = which == 0 ? (float)gnum[i] : fmaxf((float)gnum[i], 1e-4f); v[i] *= num * __builtin_amdgcn_rcpf(fmaxf((float)gden[i], 1e-4f)); }
    }
    __device__ __forceinline__ void emit8(int row, int col, const float (&v)[8]) const {
        const f16x8 g = *(const f16x8*)(P1 + (size_t)row * NP1 + 3072 + 2048 + col);
        float w[8];
#pragma unroll
        for (int i = 0; i < 8; ++i) w[i] = v[i] * fmaxf((float)g[i], 1e-4f);
        *(u32x4*)(Z16 + (size_t)row * D + col) = pack8(w);
    }
};
struct EpiF32 {
    static constexpr bool MIDK = false, GATHER = false;
    f16* C; int ldc; float* PART; int prow0, prows;
    __device__ __forceinline__ void emit_part(int part, int row, int col, const float (&v)[8]) const {
        float* p = PART + ((size_t)part * prows + (row - prow0)) * ldc + col;
        *(f32x4*)p = (f32x4){v[0], v[1], v[2], v[3]}; *(f32x4*)(p + 4) = (f32x4){v[4], v[5], v[6], v[7]}; }
    __device__ __forceinline__ void emit8(int row, int col, const float (&v)[8]) const {
        *(u32x4*)(C + (size_t)row * ldc + col) = pack8(v);
    }
};
struct EpiSwiGLU {
    static constexpr bool MIDK = false, GATHER = false;
    f16* H; const int* SRC;
    __device__ __forceinline__ void emit_part(int, int, int, const float (&)[8]) const {}
    __device__ __forceinline__ void emit8(int row, int col, const float (&v)[8]) const {
        f16x4 h;
#pragma unroll
        for (int i = 0; i < 4; ++i) h[i] = (f16)(silu_(v[i]) * v[i + 4]);
        *(f16x4*)(H + (size_t)row * DFF + (col >> 1)) = h;
    }
};

struct EpiSwiGLUG : EpiSwiGLU { static constexpr bool GATHER = true; };

template <class Epi, class BSel>
__device__ __forceinline__ void gemm_naive(LAS unsigned char* lds, const f16* A, int lda, int K, int nMt, int nNt, const Epi& E, const BSel& bsel, int vb, int nvb, int tid) {
    LAS float* As = (LAS float*)lds;
    LAS float* Bs = As + 32 * 132;
    const int ty = tid >> 4, tx = tid & 15, lr = tid >> 2, kc = (tid & 3) * 8;
    for (int tile = vb; tile < nMt * nNt; tile += nvb) {
        const int tm = tile / nNt, tn = tile % nNt;
        const f16* Bt = bsel(tm * 128);
        float acc[4][8];
#pragma unroll
        for (int i = 0; i < 4; ++i)
#pragma unroll
            for (int j = 0; j < 8; ++j) acc[i][j] = 0.f;
        for (int k0 = 0; k0 < K; k0 += 32) {
            const f16x8 av = *(const f16x8*)(A + (size_t)(tm * 128 + lr) * lda + k0 + kc);
            const f16x8 bv = *(const f16x8*)(Bt + (size_t)(tn * 128 + lr) * K + k0 + kc);
            __syncthreads();
#pragma unroll
            for (int i = 0; i < 8; ++i) { As[(kc + i) * 132 + lr] = (float)av[i]; Bs[(kc + i) * 132 + lr] = (float)bv[i]; }
            __syncthreads();
#pragma unroll 8
            for (int kk = 0; kk < 32; ++kk) {
                const f32x4 a = *(const LAS f32x4*)(As + kk * 132 + ty * 4);
                const f32x4 b0 = *(const LAS f32x4*)(Bs + kk * 132 + tx * 8), b1 = *(const LAS f32x4*)(Bs + kk * 132 + tx * 8 + 4);
#pragma unroll
                for (int i = 0; i < 4; ++i) {
#pragma unroll
                    for (int j = 0; j < 4; ++j) { acc[i][j] += a[i] * b0[j]; acc[i][4 + j] += a[i] * b1[j]; }
                }
            }
        }
#pragma unroll
        for (int i = 0; i < 4; ++i) E.emit8(tm * 128 + ty * 4 + i, tn * 128 + tx * 8, acc[i]);
    }
    __syncthreads();
}
struct BSelOne { const f16* Bt; __device__ __forceinline__ const f16* operator()(int) const { return Bt; } };
struct BSelMoe { const f16* Bt; size_t estride; const int* blke; __device__ __forceinline__ const f16* operator()(int row) const { return Bt + (size_t)blke[row >> 8] * estride; } };


namespace pg8 {
constexpr int BM = 256, BK = 64, HALF = 128, HTB = HALF * BK * 2, STAGE_BYTES = 8 * HTB, NXCD = 8, WGM = 8;
__device__ __forceinline__ int lds_byte(int r, int c) { const int st = (r >> 4) * 2 + (c >> 5), rr = r & 15, cc = c & 31, ob = rr * 64 + cc * 2; return st * 1024 + (ob ^ (((ob >> 9) & 1) << 5)); }
__device__ __forceinline__ void stage_rc(int b, int& R, int& C) { const int st = b / 1024, sb = b % 1024, swz = sb ^ (((sb >> 9) & 1) << 5); R = (st >> 1) * 16 + swz / 64; C = (st & 1) * 32 + (swz % 64) / 2; }
__device__ __forceinline__ int perm32(int rho) { const int n = rho >> 4, i = rho & 15; return 8 * (i >> 2) + 4 * n + (i & 3); }
struct Unit { int pm, pn, eb, kb, nt, part; };
struct Gemm { const f16* A; const f16* Bt; int lda, K; size_t bstride; };
struct Order {
    int nM, nN, nwg, G, c, ntile; const int* blke; int tailM, tailS, tail_nt;
    __device__ void init(int nM_, int nN_, int G_, int c_, const int* blke_, int ntile_) { nM = nM_; nN = nN_; nwg = nM * nN; G = G_; c = c_; blke = blke_; ntile = ntile_; tailM = 0; tailS = 1; tail_nt = ntile_; }
    __device__ void set_tail(int tailM_, int tailS_) { tailM = tailM_; tailS = tailS_; tail_nt = ntile / tailS_; }
    __device__ bool next(int i, Unit& u) const {
        const long L = (long)i * G + c;
        if (L >= nwg) { const int q = (int)(L - nwg); if (q >= tailM * nN * tailS) return false;
            const int uu = q / tailS, ks = q - uu * tailS; u.pm = nM + uu / nN; u.pn = uu % nN; u.eb = blke ? __builtin_amdgcn_readfirstlane(blke[u.pm]) : 0; u.kb = ks * tail_nt; u.nt = tail_nt; u.part = ks; return true; }
        int wgid = (int)L; { const int q = nwg / NXCD, r = nwg % NXCD, xcd = wgid % NXCD, off = wgid / NXCD; wgid = (xcd < r ? xcd * (q + 1) : r * (q + 1) + (xcd - r) * q) + off; }
        const int nig = WGM * nN, gid = wgid / nig, fm = gid * WGM, gsz = (nM - fm) < WGM ? (nM - fm) : WGM;
        u.pm = fm + ((wgid % nig) % gsz); u.pn = (wgid % nig) / gsz; u.eb = blke ? __builtin_amdgcn_readfirstlane(blke[u.pm]) : 0; u.kb = 0; u.nt = ntile; u.part = -1; return true;
    }
};
template <class Epi>
__device__ __forceinline__ void gemm_phase(LAS unsigned char* lds, const Gemm g, const Order& S, const Epi& E, int tid) {
    const int wid = __builtin_amdgcn_readfirstlane(tid >> 6), lane = tid & 63, wr = wid >> 2, wc = wid & 3, fr = lane & 15, fq = lane >> 4;
    const int K = g.K;
    unsigned voffA[2], voffB[2];
#pragma unroll
    for (int i = 0; i < 2; ++i) { int R, C; stage_rc(tid * 16 + i * 8192, R, C); const int Rb = (R & ~31) + perm32(R & 31);
        voffA[i] = (unsigned)(R * g.lda + C) * 2u; voffB[i] = (unsigned)(Rb * K + C) * 2u; }
    const size_t kstep = (size_t)(BK * 2);
    const size_t hstepA = (size_t)HALF * g.lda * 2, tstepA = 2 * hstepA, hstepB = (size_t)HALF * K * 2, tstepB = 2 * hstepB;
    const unsigned ldsw = (unsigned)wid * 1024u;
    const int aoff = lds_byte(wr * 64 + fr, fq * 8), boff = lds_byte(wc * 32 + fr, fq * 8);
#define PG8_SA(b, h) (((b) * 2 + (h)) * HTB)
#define PG8_SB(b, h) ((4 + (b) * 2 + (h)) * HTB)
#define PG8_STAGE(bufoff, gbase, voff) do { _Pragma("unroll") for (int _i = 0; _i < 2; ++_i) \
        __builtin_amdgcn_global_load_lds((const unsigned*)((const char*)(gbase) + (voff)[_i]), (LAS unsigned*)(lds + (bufoff) + ldsw + _i * 8192), 16, 0, 0); } while (0)
#define PG8_LDA(dst, b, h) do { _Pragma("unroll") for (int m = 0; m < 4; ++m) _Pragma("unroll") for (int k = 0; k < 2; ++k) dst[m][k] = *(const LAS f16x8*)(lds + PG8_SA(b, h) + aoff + m * 2048 + k * 1024); } while (0)
#define PG8_LDB(dst, b, h) do { _Pragma("unroll") for (int n = 0; n < 2; ++n) _Pragma("unroll") for (int k = 0; k < 2; ++k) dst[n][k] = *(const LAS f16x8*)(lds + PG8_SB(b, h) + boff + n * 2048 + k * 1024); } while (0)
#define PG8_MMA(ai, bj, At, Bt) do { __builtin_amdgcn_s_setprio(1); _Pragma("unroll") for (int m = 0; m < 4; ++m) _Pragma("unroll") for (int n = 0; n < 2; ++n) _Pragma("unroll") for (int k = 0; k < 2; ++k) \
        acc[ai][bj][m][n] = __builtin_amdgcn_mfma_f32_16x16x32_f16(Bt[n][k], At[m][k], acc[ai][bj][m][n], 0, 0, 0); __builtin_amdgcn_s_setprio(0); } while (0)
#define PG8_WAIT_V(n) asm volatile("s_waitcnt vmcnt(" #n ")" ::: "memory")
#define PG8_WAIT_L(n) asm volatile("s_waitcnt lgkmcnt(" #n ")" ::: "memory")
#define PG8_BAR __builtin_amdgcn_s_barrier()
#define PG8_SCHED __builtin_amdgcn_sched_barrier(0)
#define PG8_STAGE2(bufoff, gbase, o0, o1) do { __builtin_amdgcn_global_load_lds((const unsigned*)((const char*)(gbase) + (o0)), (LAS unsigned*)(lds + (bufoff) + ldsw), 16, 0, 0); \
        __builtin_amdgcn_global_load_lds((const unsigned*)((const char*)(gbase) + (o1)), (LAS unsigned*)(lds + (bufoff) + ldsw + 8192), 16, 0, 0); } while (0)
#define PG8_STA(bufoff, gbase, h, nx) do { if constexpr (Epi::GATHER) { PG8_STAGE2(bufoff, gbase, (nx) ? vn[h][0] : vc[h][0], (nx) ? vn[h][1] : vc[h][1]); } else { PG8_STAGE(bufoff, (gbase) + (h) * hstepA, voffA); } } while (0)
    constexpr int IDX_OFF = STAGE_BYTES;
    Unit cur, nxt; int ui = 0;
    if (!S.next(0, cur)) return;
    unsigned vc[2][2] = {{0u, 0u}, {0u, 0u}}, vn[2][2] = {{0u, 0u}, {0u, 0u}};
    if constexpr (Epi::GATHER) {
#pragma unroll
        for (int h = 0; h < 2; ++h)
#pragma unroll
            for (int i = 0; i < 2; ++i) { int R, C; stage_rc(tid * 16 + i * 8192, R, C); vc[h][i] = (unsigned)(E.SRC[cur.pm * BM + h * HALF + R] * g.lda + C) * 2u; vn[h][i] = vc[h][i]; }
    }
    f32x4 acc[2][2][4][2];
#pragma unroll
    for (int a = 0; a < 2; ++a)
#pragma unroll
        for (int b = 0; b < 2; ++b)
#pragma unroll
            for (int m = 0; m < 4; ++m)
#pragma unroll
                for (int n = 0; n < 2; ++n) acc[a][b][m][n] = (f32x4){0.f, 0.f, 0.f, 0.f};
    f16x8 At[4][2], B0[2][2], B1[2][2];
    const char* cA = (const char*)g.A + (Epi::GATHER ? (size_t)0 : (size_t)cur.pm * tstepA) + (size_t)cur.kb * kstep; const char* cB = (const char*)g.Bt + (size_t)cur.eb * g.bstride * 2 + (size_t)cur.pn * tstepB + (size_t)cur.kb * kstep;
    PG8_STAGE(PG8_SB(0, 0), cB, voffB); PG8_STAGE(PG8_SB(0, 1), cB + hstepB, voffB); PG8_STA(PG8_SA(0, 0), cA, 0, false); PG8_STA(PG8_SA(0, 1), cA, 1, false);
    if (wr == 1) PG8_BAR;
    PG8_WAIT_V(2); PG8_BAR;
    PG8_STAGE(PG8_SB(1, 0), cB + kstep, voffB); PG8_STA(PG8_SA(1, 0), cA + kstep, 0, false); PG8_STAGE(PG8_SB(1, 1), cB + hstepB + kstep, voffB);
    PG8_WAIT_V(6); PG8_BAR;
    for (;;) {
        const bool has_next = S.next(ui + 1, nxt);
        const char* nA = has_next ? (const char*)g.A + (Epi::GATHER ? (size_t)0 : (size_t)nxt.pm * tstepA) + (size_t)nxt.kb * kstep : cA;
        if constexpr (Epi::GATHER) { if (has_next && wid == 0) __builtin_amdgcn_global_load_lds((const unsigned*)(E.SRC + nxt.pm * BM + lane * 4), (LAS unsigned*)(lds + IDX_OFF + ((ui + 1) & 1) * 1024), 16, 0, 0); } const char* nB = has_next ? (const char*)g.Bt + (size_t)nxt.eb * g.bstride * 2 + (size_t)nxt.pn * tstepB + (size_t)nxt.kb * kstep : cB;
        const int nt = cur.nt;
        int t = 0;
#pragma unroll 1
        for (int seg = 0; seg < (Epi::MIDK ? 3 : 1); ++seg) {
        const int tend = Epi::MIDK ? (seg == 0 ? (nt < 4 ? nt : 4) : (seg == 1 ? (nt < 8 ? nt : 8) : nt)) : nt;
        for (; t < tend; t += 2) {
            const bool last = (t == nt - 2);
            if constexpr (Epi::GATHER) { if (last && has_next) {
                const LAS int* ix = (const LAS int*)(lds + IDX_OFF + ((ui + 1) & 1) * 1024);
#pragma unroll
                for (int h = 0; h < 2; ++h)
#pragma unroll
                    for (int i = 0; i < 2; ++i) { int R, C; stage_rc(tid * 16 + i * 8192, R, C); vn[h][i] = (unsigned)(ix[h * HALF + R] * g.lda + C) * 2u; } } }
            const char* a1 = cA + (size_t)(t + 1) * kstep;
            const char* a2 = last ? nA : cA + (size_t)(t + 2) * kstep; const char* b2 = last ? nB : cB + (size_t)(t + 2) * kstep;
            const char* a3 = a2 + kstep; const char* b3 = b2 + kstep;
            PG8_LDB(B0, 0, 0); PG8_LDB(B1, 0, 1); PG8_SCHED; PG8_LDA(At, 0, 0); PG8_STA(PG8_SA(1, 1), a1, 1, false);
            PG8_WAIT_V(8); PG8_WAIT_L(0); PG8_BAR; PG8_MMA(0, 0, At, B0); PG8_MMA(0, 1, At, B1); PG8_BAR; PG8_SCHED;
            PG8_LDA(At, 0, 1); PG8_STAGE(PG8_SB(0, 0), b2, voffB); PG8_STAGE(PG8_SB(0, 1), b2 + hstepB, voffB); PG8_STA(PG8_SA(0, 0), a2, 0, last);
            PG8_WAIT_V(8); PG8_WAIT_L(0); PG8_BAR; PG8_MMA(1, 0, At, B0); PG8_MMA(1, 1, At, B1); PG8_BAR; PG8_SCHED;
            PG8_LDB(B0, 1, 0); PG8_LDB(B1, 1, 1); PG8_SCHED; PG8_LDA(At, 1, 0); PG8_STA(PG8_SA(0, 1), a2, 1, last);
            PG8_WAIT_V(8); PG8_WAIT_L(0); PG8_BAR; PG8_MMA(0, 0, At, B0); PG8_MMA(0, 1, At, B1); PG8_BAR; PG8_SCHED;
            PG8_LDA(At, 1, 1); PG8_STAGE(PG8_SB(1, 0), b3, voffB); PG8_STAGE(PG8_SB(1, 1), b3 + hstepB, voffB); PG8_STA(PG8_SA(1, 0), a3, 0, last);
            PG8_WAIT_V(8); PG8_WAIT_L(0); PG8_BAR; PG8_MMA(1, 0, At, B0); PG8_MMA(1, 1, At, B1); PG8_BAR; PG8_SCHED;
        }
        if constexpr (Epi::MIDK) { if (seg < 2 && cur.part < 0) {
#pragma unroll
                for (int ai = 0; ai < 2; ++ai)
#pragma unroll
                    for (int m = 0; m < 4; ++m) { int row = cur.pm * BM + ai * HALF + wr * 64 + m * 16 + fr; asm volatile("" : "+v"(row));
#pragma unroll
                        for (int bj = 0; bj < 2; ++bj) { const f32x4 v0 = acc[ai][bj][m][0], v1 = acc[ai][bj][m][1];
                            float v[8] = {v0[0], v0[1], v0[2], v0[3], v1[0], v1[1], v1[2], v1[3]};
                            E.mid8(row, cur.pn * BM + bj * HALF + wc * 32 + 8 * fq, v, seg);
                            acc[ai][bj][m][0] = (f32x4){v[0], v[1], v[2], v[3]}; acc[ai][bj][m][1] = (f32x4){v[4], v[5], v[6], v[7]}; }
                        asm volatile("" : "+v"(acc[ai][0][m][0]), "+v"(acc[ai][0][m][1]), "+v"(acc[ai][1][m][0]), "+v"(acc[ai][1][m][1]) :: "memory"); } } }
        }
        if (wr == 0) PG8_BAR;
        {
#pragma unroll
            for (int ai = 0; ai < 2; ++ai)
#pragma unroll
                for (int m = 0; m < 4; ++m) { int row = cur.pm * BM + ai * HALF + wr * 64 + m * 16 + fr; if constexpr (Epi::MIDK) asm volatile("" : "+v"(row));
#pragma unroll
                    for (int bj = 0; bj < 2; ++bj) { const f32x4 v0 = acc[ai][bj][m][0], v1 = acc[ai][bj][m][1];
                        const float v[8] = {v0[0], v0[1], v0[2], v0[3], v1[0], v1[1], v1[2], v1[3]};
                        if (cur.part >= 0) E.emit_part(cur.part, row, cur.pn * BM + bj * HALF + wc * 32 + 8 * fq, v); else E.emit8(row, cur.pn * BM + bj * HALF + wc * 32 + 8 * fq, v); } }
        }
        if (!has_next) break;
#pragma unroll
        for (int a = 0; a < 2; ++a)
#pragma unroll
            for (int b = 0; b < 2; ++b)
#pragma unroll
                for (int m = 0; m < 4; ++m)
#pragma unroll
                    for (int n = 0; n < 2; ++n) acc[a][b][m][n] = (f32x4){0.f, 0.f, 0.f, 0.f};
        cur = nxt; cA = nA; cB = nB; ++ui;
        if constexpr (Epi::GATHER) {
#pragma unroll
            for (int h = 0; h < 2; ++h)
#pragma unroll
                for (int i = 0; i < 2; ++i) vc[h][i] = vn[h][i]; }
        if (wr == 1) PG8_BAR;
    }
    PG8_WAIT_V(0);
    PG8_BAR;
#undef PG8_SA
#undef PG8_SB
#undef PG8_STAGE
#undef PG8_STAGE2
#undef PG8_STA
#undef PG8_LDA
#undef PG8_LDB
#undef PG8_MMA
#undef PG8_WAIT_V
#undef PG8_WAIT_L
#undef PG8_BAR
#undef PG8_SCHED
}
}
template <class Epi>
__device__ __forceinline__ void gemm_run(LAS unsigned char* lds, const f16* A, int lda, int K, int nrows, int N, const f16* Bt, size_t bstride, const int* blke, const Epi& E, int vb, int nvb, int tid, int tail_rows = 0, int tailS = 1) {
#if USE_MFMA
    pg8::Gemm g{A, Bt, lda, K, bstride}; pg8::Order S; S.init((nrows - tail_rows) / 256, N / 256, nvb, vb, blke, K / 64); if (tail_rows) S.set_tail(tail_rows / 256, tailS);
    pg8::gemm_phase(lds, g, S, E, tid);
#else
    static_assert(!Epi::MIDK, "the naive GEMM has no mid-K hook");
    if (blke) gemm_naive(lds, A, lda, K, nrows / 128, N / 128, E, BSelMoe{Bt, bstride, blke}, vb, nvb, tid);
    else gemm_naive(lds, A, lda, K, nrows / 128, N / 128, E, BSelOne{Bt}, vb, nvb, tid);
#endif
}

__device__ __forceinline__ void conv_item(const float* S0, const float* S1, int ld, int K, int N, f16* dst, int ldd, int mode, int skipfrom, int skip, LAS float* scr, int item, int lane) {
    const int nblk = N / 32, kb = item / nblk, nb = item % nblk, k0 = 64 * kb, n0 = 32 * nb;
    const int n = n0 + (lane & 31);
    const float* sp;
    if (mode == 0) sp = S0 + n + (n >= skipfrom ? skip : 0);
    else { const int j = n >> 3, i = n & 7; sp = (i < 4 ? S0 : S1) + 4 * j + (i & 3); }
#pragma unroll 8
    for (int i = 0; i < 32; ++i) { const int kk = 2 * i + (lane >> 5); scr[kk * 33 + (lane & 31)] = sp[(size_t)(k0 + kk) * ld]; }
    LDS_WAIT();
    const int c = lane & 7;
#pragma unroll
    for (int j = 0; j < 4; ++j) { const int nn = (lane >> 3) + 8 * j; const LAS float* s = scr + (8 * c) * 33 + nn;
        f16x8 h;
#pragma unroll
        for (int q = 0; q < 8; ++q) h[q] = (f16)s[q * 33];
        *(f16x8*)(dst + (size_t)(n0 + nn) * ldd + k0 + 8 * c) = h; }
    LDS_WAIT();
}
constexpr int FFN_ITEMS = 16 * (NFF2 / 32) + 56 * 32;
__device__ __forceinline__ void conv_layer(unsigned char* ws, int layer, LAS unsigned char* lds, int gw, int ngw, int wave, int lane, int ffn_lo) {
    LAS float* scr = (LAS float*)(lds + wave * 8448);
    unsigned char* W = ws + WS_W;
    const int I_IN = 16 * (NP1 / 32), I_BP = 4 * 32, I_BM = 8 * 32, I_OUT = 16 * 32, I_13 = 16 * (NFF2 / 32), I_2 = 56 * 32;
    const bool moe = (layer & 1); const int fi = layer >> 1;
    const int nexp = moe ? NE : 1;
    const int ncommon = I_IN + 2 * I_BP + I_BM + I_OUT;
    const int total = ncommon + nexp * (I_13 + I_2) - ffn_lo;
    for (int it = gw; it < total; it += ngw) {
        int r = it < ncommon ? it : it + ffn_lo;
        if (r < I_IN) { conv_item(INP(I_WIN) + (size_t)layer * D * NIN, nullptr, NIN, D, NP1, (f16*)(W + WO_IN), D, 0, 3072, 16, scr, r, lane); continue; } r -= I_IN;
        if (r < I_BP) { conv_item(INP(I_WBP) + (size_t)layer * 256 * D, nullptr, D, 256, D, (f16*)(W + WO_BP), D, 0, 1 << 30, 0, scr, r, lane); continue; } r -= I_BP;
        if (r < I_BP) { conv_item(INP(I_WBN) + (size_t)layer * 256 * D, nullptr, D, 256, D, (f16*)(W + WO_BP) + 256, D, 0, 1 << 30, 0, scr, r, lane); continue; } r -= I_BP;
        if (r < I_BM) { conv_item(INP(I_WBM) + (size_t)layer * 512 * D, nullptr, D, 512, D, (f16*)(W + WO_BP) + 512, D, 0, 1 << 30, 0, scr, r, lane); continue; } r -= I_BM;
        if (r < I_OUT) { conv_item(INP(I_WOUT) + (size_t)layer * D * D, nullptr, D, D, D, (f16*)(W + WO_OUT), D, 0, 1 << 30, 0, scr, r, lane); continue; } r -= I_OUT;
        const int e = r / (I_13 + I_2); r -= e * (I_13 + I_2);
        const size_t eo = (size_t)(fi * nexp + e) * D * DFF;
        const float* w1 = (moe ? INP(I_MW1) : INP(I_FW1)) + eo;
        const float* w3 = (moe ? INP(I_MW3) : INP(I_FW3)) + eo;
        const float* w2 = (moe ? INP(I_MW2) : INP(I_FW2)) + eo;
        if (r < I_13) conv_item(w1, w3, DFF, D, NFF2, (f16*)(W + (moe ? WO_13 : WO_13D)) + (size_t)e * NFF2 * D, D, 1, 0, 0, scr, r, lane);
        else conv_item(w2, nullptr, D, DFF, D, (f16*)(W + (moe ? WO_2 : WO_2D)) + (size_t)e * D * DFF, DFF, 0, 1 << 30, 0, scr, r - I_13, lane);
    }
}

__device__ __forceinline__ void conv_seg(int l, int nvb, int& LA, int& a0, int& an, int& LB, int& b0, int& bn) {
    LA = 0; a0 = 0; an = 0; LB = 0; b0 = 0; bn = 0;
    if (nvb != 256) return;
    constexpr int HALF = 9 * NWAVES * 256;
    if (l == 0) { LA = 1; a0 = 0; an = HALF; }
    else if (l == 1) { LA = 1; a0 = HALF; an = HALF; LB = 2; b0 = 0; bn = FFN_ITEMS; }
    else if (l == 2) { LA = 3; a0 = 0; an = HALF; }
    else { LA = 3; a0 = HALF; an = HALF; }
}
__device__ __forceinline__ int ffn_dma_items(int L, int nvb) {
    if (L <= 0 || L >= DEPTH || nvb != 256) return 0;
    const int tot = ((L & 1) ? NE : 1) * FFN_ITEMS, cap = 18 * NWAVES * 256;
    return tot < cap ? tot : cap;
}

__device__ __forceinline__ void ln_stats(const f32x4 (&v)[4], float& mean, float& rstd) {
    float s = 0.f;
#pragma unroll
    for (int j = 0; j < 4; ++j) s += (v[j][0] + v[j][1]) + (v[j][2] + v[j][3]);
    mean = wave_sum(s) * (1.f / D);
    float q = 0.f;
#pragma unroll
    for (int j = 0; j < 4; ++j) { const f32x4 d = v[j] - mean; q += (d[0] * d[0] + d[1] * d[1]) + (d[2] * d[2] + d[3] * d[3]); }
    rstd = 1.f / sqrtf(wave_sum(q) * (1.f / D) + LN_EPS);
}
__device__ __forceinline__ const float* mod_row(unsigned char* ws, LAS unsigned char* lds, int layer, int r) {
    const int rb = r < ML ? r / SEQ : NB;
    return (const float*)(ws + WS_MOD) + (size_t)(layer * 9 + rb) * 6144;
}
__device__ __forceinline__ void load_gate_table(LAS unsigned char* lds, int layer, LAS float* T, int tid) {
    const float* src = INP(I_WIN) + (size_t)layer * D * NIN + 3072;
    for (int i = tid; i < D * 4; i += NTHREADS) { const int k = i >> 2, q = i & 3; const f32x4 w = *(const f32x4*)(src + (size_t)k * NIN + 4 * q);
        T[(4 * q + 0) * D + k] = w[0]; T[(4 * q + 1) * D + k] = w[1]; T[(4 * q + 2) * D + k] = w[2]; T[(4 * q + 3) * D + k] = w[3]; }
    __syncthreads();
}
__device__ __forceinline__ void load_router_table(LAS unsigned char* lds, int mi, LAS float* T, int tid) {
    const float* src = INP(I_RW) + (size_t)mi * D * NE;
    for (int i = tid; i < D * 2; i += NTHREADS) { const int k = i >> 1, q = i & 1; const f32x4 w = *(const f32x4*)(src + (size_t)k * NE + 4 * q);
        T[(4 * q + 0) * D + k] = w[0]; T[(4 * q + 1) * D + k] = w[1]; T[(4 * q + 2) * D + k] = w[2]; T[(4 * q + 3) * D + k] = w[3]; }
    __syncthreads();
}
__device__ __forceinline__ float dot4_rows(const f32x4 (&u)[4], const LAS float* T, int g0, int lane) {
    float p[4];
#pragma unroll
    for (int i = 0; i < 4; ++i) { float s = 0.f;
#pragma unroll
        for (int j = 0; j < 4; ++j) { const f32x4 w = *(const LAS f32x4*)(T + (g0 + i) * D + 256 * j + 4 * lane); s += (u[j][0] * w[0] + u[j][1] * w[1]) + (u[j][2] * w[2] + u[j][3] * w[3]); }
        p[i] = s; }
    const bool b5 = (lane & 32) != 0, b4 = (lane & 16) != 0;
    const float q0 = (b5 ? p[2] : p[0]) + __shfl_xor(b5 ? p[0] : p[2], 32), q1 = (b5 ? p[3] : p[1]) + __shfl_xor(b5 ? p[1] : p[3], 32);
    float s = (b4 ? q1 : q0) + __shfl_xor(b4 ? q0 : q1, 16);
    return row16_sum(s);
}
__device__ __forceinline__ void row_A(unsigned char* ws, LAS unsigned char* lds, int layer, int r, const f32x4 (&x)[4], const LAS float* GT, int lane) {
    float mean, rstd; ln_stats(x, mean, rstd);
    const float* mod = mod_row(ws, lds, layer, r);
    f32x4 u[4];
    f16* up = (f16*)(ws + WS_U16) + (size_t)r * D;
#pragma unroll
    for (int j = 0; j < 4; ++j) { const int k = 256 * j + 4 * lane; const f32x4 sh = *(const f32x4*)(mod + k), sc = *(const f32x4*)(mod + 1024 + k);
        u[j] = (x[j] - mean) * rstd * (sc + 1.f) + sh;
        f16x4 h; h[0] = (f16)u[j][0]; h[1] = (f16)u[j][1]; h[2] = (f16)u[j][2]; h[3] = (f16)u[j][3];
        *(f16x4*)(up + k) = h; }
#pragma unroll 1
    for (int gb = 0; gb < 4; ++gb) { const float s = dot4_rows(u, GT, 4 * gb, lane);
        if ((lane & 15) == 0) ((float*)(ws + WS_MLG))[(size_t)r * 16 + 4 * gb + (lane >> 4)] = s; }
}
__device__ __forceinline__ void row_A_pre(unsigned char* ws, int r, const f32x4 (&x)[4], const f32x4 (&sh)[4], const f32x4 (&sc)[4], const LAS float* GT, int lane) {
    float mean, rstd; ln_stats(x, mean, rstd);
    f32x4 u[4];
    f16* up = (f16*)(ws + WS_U16) + (size_t)r * D;
#pragma unroll
    for (int j = 0; j < 4; ++j) { const int k = 256 * j + 4 * lane;
        u[j] = (x[j] - mean) * rstd * (sc[j] + 1.f) + sh[j];
        f16x4 h; h[0] = (f16)u[j][0]; h[1] = (f16)u[j][1]; h[2] = (f16)u[j][2]; h[3] = (f16)u[j][3];
        *(f16x4*)(up + k) = h; }
#pragma unroll 1
    for (int gb = 0; gb < 4; ++gb) { const float s = dot4_rows(u, GT, 4 * gb, lane);
        if ((lane & 15) == 0) ((float*)(ws + WS_MLG))[(size_t)r * 16 + 4 * gb + (lane >> 4)] = s; }
}
__device__ __forceinline__ void load_row(const float* p, f32x4 (&v)[4], int lane) {
#pragma unroll
    for (int j = 0; j < 4; ++j) v[j] = *(const f32x4*)(p + 256 * j + 4 * lane);
}
__device__ __forceinline__ void load_row_h(const f16* p, f32x4 (&v)[4], int lane) {
#pragma unroll
    for (int j = 0; j < 4; ++j) { const f16x4 h = *(const f16x4*)(p + 256 * j + 4 * lane); v[j] = (f32x4){(float)h[0], (float)h[1], (float)h[2], (float)h[3]}; }
}
__device__ __forceinline__ void store_row_h(f16* p, const f32x4 (&v)[4], int lane) {
#pragma unroll
    for (int j = 0; j < 4; ++j) { f16x4 h; h[0] = (f16)v[j][0]; h[1] = (f16)v[j][1]; h[2] = (f16)v[j][2]; h[3] = (f16)v[j][3]; *(f16x4*)(p + 256 * j + 4 * lane) = h; }
}
template <int layer>
__device__ __forceinline__ void load_x(unsigned char* ws, LAS unsigned char* lds, int r, f32x4 (&v)[4], int lane) {
    if constexpr (layer == 0) load_row(r < ML ? INP(I_X) + (size_t)r * D : INP(I_CTX) + (size_t)(r - ML) * D, v, lane);
    else load_row_h((const f16*)(ws + WS_XS) + (size_t)r * D, v, lane);
}
__device__ __forceinline__ void load_row_sum(const float* p, size_t stride, int n, f32x4 (&v)[4], int lane) {
    load_row(p, v, lane);
    for (int s = 1; s < n; ++s) { f32x4 t[4]; load_row(p + (size_t)s * stride, t, lane);
#pragma unroll
        for (int j = 0; j < 4; ++j) v[j] += t[j]; }
}
__device__ __forceinline__ const float* x_src(unsigned char* ws, LAS unsigned char* lds, int layer, int r) {
    if (layer == 0) return r < ML ? INP(I_X) + (size_t)r * D : INP(I_CTX) + (size_t)(r - ML) * D;
    return (const float*)(ws + WS_XS) + (size_t)r * D;
}

__device__ __forceinline__ void pool_phase(unsigned char* ws, int layer, LAS unsigned char* lds, int vb, int nvb, int tid) {
    LAS float* in = (LAS float*)lds;
    LAS f16* dif16 = (LAS f16*)(lds + 80 * 64 * 4);
    LAS f16* Wt16 = dif16 + 64 * 72;
    const f16* P1 = (const f16*)(ws + WS_P1);
    f16* CAT = (f16*)(ws + WS_CAT);
    const int nrows = (layer == DEPTH - 1) ? ML : MT;
    const int nunits = (nrows / 64) * 4;
    const int lane = tid & 63, w = __builtin_amdgcn_readfirstlane(tid >> 6), gq = lane >> 4, c = lane & 15;
    int gl = -1;
    for (int un = vb; un < nunits; un += nvb) {
        const int ch = un >> 2, g = un & 3, r0 = ch * 64;
        const int seq0 = r0 < ML ? (r0 / SEQ) * SEQ : ML + ((r0 - ML) / CTXL) * CTXL, seqlen = r0 < ML ? SEQ : CTXL;
        const int t0 = r0 - seq0, half = 1 << g;
        __syncthreads();
        for (int i = tid; i < 80 * 8; i += NTHREADS) { const int rr = i >> 3, c8 = (i & 7) * 8; const int t = t0 - 8 + rr;
            f16x8 v; if (t >= 0 && t < seqlen) v = *(const f16x8*)(P1 + (size_t)(seq0 + t) * NP1 + g * 64 + c8); else { for (int q = 0; q < 8; ++q) v[q] = (f16)0.f; }
#pragma unroll
            for (int q = 0; q < 8; ++q) in[rr * 64 + c8 + q] = (float)v[q]; }
        if (g != gl) { const float* pw = INP(I_POOLW) + (size_t)(layer * 4 + g) * 4096;
            for (int i = tid; i < 4096; i += NTHREADS) { const int cc = i >> 6, dd = i & 63; Wt16[dd * 72 + cc] = (f16)pw[i]; } gl = g; }
        __syncthreads();
        { const int tt = tid >> 3, c8 = (tid & 7) * 8, t = t0 + tt; int lo = t - half; if (lo < 0) lo = 0; int hi = t + half; if (hi > seqlen) hi = seqlen;
          const float inv = 1.f / (float)(hi - lo);
          float sacc[8];
#pragma unroll
          for (int q = 0; q < 8; ++q) sacc[q] = 0.f;
          for (int p = lo; p < hi; ++p) { const LAS float* ip = in + (p - t0 + 8) * 64 + c8;
#pragma unroll
              for (int q = 0; q < 8; ++q) sacc[q] += ip[q]; }
          f16x8 dv;
#pragma unroll
          for (int q = 0; q < 8; ++q) dv[q] = (f16)(sacc[q] * inv - in[(tt + 8) * 64 + c8 + q]);
          *(LAS f16x8*)(dif16 + tt * 72 + c8) = dv; }
        __syncthreads();
        { const int tt = w >> 1;
          f16x8 bfr[2];
#pragma unroll
          for (int ks = 0; ks < 2; ++ks) bfr[ks] = *(const LAS f16x8*)(dif16 + (16 * tt + c) * 72 + 32 * ks + 8 * gq);
#pragma unroll
          for (int q = 0; q < 2; ++q) { const int dt = (w & 1) * 2 + q;
              f32x4 acc = (f32x4){0.f, 0.f, 0.f, 0.f};
#pragma unroll
              for (int ks = 0; ks < 2; ++ks) { const f16x8 afr = *(const LAS f16x8*)(Wt16 + (16 * dt + c) * 72 + 32 * ks + 8 * gq);
                  acc = __builtin_amdgcn_mfma_f32_16x16x32_f16(afr, bfr[ks], acc, 0, 0, 0); }
              const f32x4 ps = *(const f32x4*)(INP(I_POOLS) + layer * 256 + g * 64 + 16 * dt + 4 * gq);
              f16x4 h; h[0] = (f16)(acc[0] * ps[0]); h[1] = (f16)(acc[1] * ps[1]); h[2] = (f16)(acc[2] * ps[2]); h[3] = (f16)(acc[3] * ps[3]);
              *(f16x4*)(CAT + (size_t)(r0 + 16 * tt + c) * D + g * 64 + 16 * dt + 4 * gq) = h; } }
    }
    __syncthreads();
}
__device__ __forceinline__ void na_phase(unsigned char* ws, int layer, LAS unsigned char* lds, int gw, int ngw, int wave, int lane) {
    LAS float* qs = (LAS float*)(lds + wave * 2048);
    LAS float* ps = qs + 64;
    const f16* P1 = (const f16*)(ws + WS_P1);
    f16* CAT = (f16*)(ws + WS_CAT);
    const float* rpb = INP(I_RPB) + (size_t)layer * 4 * 15 * 31;
    const int nq = (layer == DEPTH - 1) ? ML : MT;
    for (int item = gw; item < nq * 4; item += ngw) {
        const int tq = item >> 2, h = item & 3;
        qs[lane] = (float)P1[(size_t)tq * NP1 + 256 + h * 64 + lane];
        LDS_WAIT();
        const bool lat = tq < ML;
        const int b = lat ? tq / SEQ : (tq - ML) / CTXL;
        const int pos = tq % SEQ, r = pos >> 6, qc = pos & 63;
        int r0 = r - 4; r0 = r0 < 0 ? 0 : (r0 > 24 ? 24 : r0);
        int cs = qc - 8; cs = cs < 0 ? 0 : (cs > 48 ? 48 : cs);
        const int nloc = lat ? 128 : 0, nk = nloc + 256;
        float sc[6]; int tk[6];
        float mx = -3.0e38f;
#pragma unroll
        for (int i = 0; i < 6; ++i) {
            const int j = lane + 64 * i; sc[i] = -3.0e38f; tk[i] = 0;
            if (j < nk) {
                float bias = 0.f; int tok;
                if (j < nloc) { const int w = j >> 4, kk = j & 15; tok = b * SEQ + (r0 + w) * 64 + cs + kk;
                    int co = cs + kk - qc; co = co < -15 ? -15 : (co > 15 ? 15 : co);
                    bias = rpb[(h * 15 + (r0 + w - r + 7)) * 31 + co + 15]; }
                else tok = ML + b * CTXL + (j - nloc);
                tk[i] = tok;
                const f16* kp = P1 + (size_t)tok * NP1 + 512 + h * 64;
                float s = 0.f;
#pragma unroll
                for (int c = 0; c < 8; ++c) { const f16x8 kv = *(const f16x8*)(kp + 8 * c);
#pragma unroll
                    for (int q = 0; q < 8; ++q) s += qs[8 * c + q] * (float)kv[q]; }
                sc[i] = s + bias; mx = fmaxf(mx, sc[i]);
            }
        }
        mx = wave_max(mx);
        float sum = 0.f;
#pragma unroll
        for (int i = 0; i < 6; ++i) { const int j = lane + 64 * i; if (j < nk) { const float p = __expf(sc[i] - mx); sum += p; ps[j] = p; } }
        sum = wave_sum(sum);
        LDS_WAIT();
        float o = 0.f;
        for (int j = 0; j < nk; ++j) {
            int tok;
            if (j < nloc) tok = b * SEQ + (r0 + (j >> 4)) * 64 + cs + (j & 15); else tok = ML + b * CTXL + (j - nloc);
            o += ps[j] * (float)P1[(size_t)tok * NP1 + 768 + h * 64 + lane];
        }
        CAT[(size_t)tq * D + 256 + h * 64 + lane] = (f16)(o / sum);
        LDS_WAIT();
    }
}
__device__ __forceinline__ void mlprep_phase(unsigned char* ws, LAS unsigned char* lds, int layer, int gw, int ngw, int lane) {
    const f16* P1 = (const f16*)(ws + WS_P1);
    f16* QK = (f16*)(ws + WS_QK);
    const float* cw = INP(I_CONVW) + (size_t)layer * 3 * 1024;
    const float2* ROPE = (const float2*)(ws + WS_ROPE);
    float wq[3][8], wk[3][8];
#pragma unroll
    for (int t = 0; t < 3; ++t) { const f32x4 a0 = *(const f32x4*)(cw + t * 1024 + 8 * lane), a1 = *(const f32x4*)(cw + t * 1024 + 8 * lane + 4), b0 = *(const f32x4*)(cw + t * 1024 + 512 + 8 * lane), b1 = *(const f32x4*)(cw + t * 1024 + 512 + 8 * lane + 4);
#pragma unroll
        for (int j = 0; j < 4; ++j) { wq[t][j] = a0[j]; wq[t][4 + j] = a1[j]; wk[t][j] = b0[j]; wk[t][4 + j] = b1[j]; } }
    const int fi0 = (lane & 3) * 8;
    const bool first = (lane & 4) == 0;
    const int half = (lane >> 3) & 1;
    f16x8 z8; for (int j = 0; j < 8; ++j) z8[j] = (f16)0.f;
    f16x8 q0n = z8, q1n = z8, q2n = z8, k0n = z8, k1n = z8, k2n = z8, vvn = z8;
#define PREP_LOAD(r_) do { const bool lat_ = (r_) < ML; const int s0_ = lat_ ? ((r_) / SEQ) * SEQ : ML + (((r_) - ML) / CTXL) * CTXL, sl_ = lat_ ? SEQ : CTXL, t_ = (r_) - s0_; \
        const f16* p_ = P1 + (size_t)(r_) * NP1 + 1024 + 8 * lane; \
        q0n = t_ > 0 ? *(const f16x8*)(p_ - NP1) : z8; q1n = *(const f16x8*)p_; q2n = t_ + 1 < sl_ ? *(const f16x8*)(p_ + NP1) : z8; \
        k0n = t_ > 0 ? *(const f16x8*)(p_ - NP1 + 512) : z8; k1n = *(const f16x8*)(p_ + 512); k2n = t_ + 1 < sl_ ? *(const f16x8*)(p_ + NP1 + 512) : z8; } while (0)
    if (gw < MT) PREP_LOAD(gw);
    for (int r = gw; r < MT; r += ngw) {
        const bool lat = r < ML;
        const int seq0 = lat ? (r / SEQ) * SEQ : ML + ((r - ML) / CTXL) * CTXL, t = r - seq0;
        const f16x8 q0 = q0n, q1 = q1n, q2 = q2n, k0 = k0n, k1 = k1n, k2 = k2n;
        if (r + ngw < MT) PREP_LOAD(r + ngw);
        float vq[8], vk[8];
#pragma unroll
        for (int j = 0; j < 8; ++j) { vq[j] = silu_(wq[0][j] * (float)q0[j] + wq[1][j] * (float)q1[j] + wq[2][j] * (float)q2[j]);
            vk[j] = silu_(wk[0][j] * (float)k0[j] + wk[1][j] * (float)k1[j] + wk[2][j] * (float)k2[j]) * 0.08838834764831845f; }
        if (lat) {
            const int pp = half ? (t & 63) : (t >> 6);
            const float2* rp = ROPE + pp * 32 + fi0;
#pragma unroll
            for (int j = 0; j < 8; ++j) { const float2 cs = rp[j];
                const float oq = __shfl_xor(vq[j], 4), ok = __shfl_xor(vk[j], 4);
                vq[j] = first ? vq[j] * cs.x - oq * cs.y : oq * cs.y + vq[j] * cs.x;
                vk[j] = first ? vk[j] * cs.x - ok * cs.y : ok * cs.y + vk[j] * cs.x; }
        }
        f16x8 hq, hk;
#pragma unroll
        for (int j = 0; j < 8; ++j) { hq[j] = (f16)vq[j]; hk[j] = (f16)vk[j]; }
        *(f16x8*)(QK + (size_t)r * 1024 + 8 * lane) = hq; *(f16x8*)(QK + (size_t)r * 1024 + 512 + 8 * lane) = hk;
    }
}
__device__ __forceinline__ void mlstm_naive_phase(unsigned char* ws, int layer, LAS unsigned char* lds, int vb, int nvb, int tid) {
    LAS float* qs = (LAS float*)lds;
    LAS float* ks = qs + 32 * 128;
    LAS float* vs = ks + 32 * 128;
    LAS float* gi = vs + 32 * 128;
    LAS float* gf = gi + 32;
    LAS float* part = gf + 32;
    LAS float* partd = part + 1024;
    const f16* P1 = (const f16*)(ws + WS_P1);
    const f16* QK = (const f16*)(ws + WS_QK);
    const float* MLG = (const float*)(ws + WS_MLG);
    float* HFB = (float*)(ws + WS_HFB);
    const float* gb = INP(I_GBIAS) + layer * 16;
    const int dg = tid >> 7, e = tid & 127;
    for (int job = vb; job < 64; job += nvb) {
        const int b = job >> 3, h = (job >> 1) & 3, dir = job & 1;
        float C[32], n[32];
#pragma unroll
        for (int i = 0; i < 32; ++i) { C[i] = 0.f; n[i] = 0.f; }
        for (int s0 = 0; s0 < CTXL + SEQ; s0 += 32) {
            __syncthreads();
            for (int i = tid; i < 32 * 128; i += NTHREADS) { const int s = s0 + (i >> 7), d = i & 127;
                const int tok = s < CTXL ? ML + b * CTXL + (dir ? CTXL - 1 - s : s) : b * SEQ + (dir ? SEQ - 1 - (s - CTXL) : (s - CTXL));
                qs[i] = (float)QK[(size_t)tok * 1024 + h * 128 + d]; ks[i] = (float)QK[(size_t)tok * 1024 + 512 + h * 128 + d];
                vs[i] = (float)P1[(size_t)tok * NP1 + 2048 + h * 128 + d];
                if (d == 0) { gi[i >> 7] = __expf(MLG[(size_t)tok * 16 + dir * 8 + h] + gb[dir * 8 + h]); gf[i >> 7] = sigmoid_(MLG[(size_t)tok * 16 + dir * 8 + 4 + h] + gb[dir * 8 + 4 + h]); } }
            __syncthreads();
            for (int s = 0; s < 32; ++s) {
                const float fi = gf[s], ii = gi[s], ve = vs[s * 128 + e] * ii;
                float pn = 0.f, pd = 0.f;
#pragma unroll
                for (int i = 0; i < 32; ++i) { const float kd = ks[s * 128 + dg * 32 + i], qd = qs[s * 128 + dg * 32 + i];
                    C[i] = fi * C[i] + kd * ve; n[i] = fi * n[i] + ii * kd; pn += qd * C[i]; pd += qd * n[i]; }
                part[((s & 1) * 4 + dg) * 128 + e] = pn; if (e == 0) partd[(s & 1) * 4 + dg] = pd;
                __syncthreads();
                if (dg == 0) { const int sb = (s & 1) * 4;
                    const float num = (part[(sb + 0) * 128 + e] + part[(sb + 1) * 128 + e]) + (part[(sb + 2) * 128 + e] + part[(sb + 3) * 128 + e]);
                    const float den = (partd[sb] + partd[sb + 1]) + (partd[sb + 2] + partd[sb + 3]);
                    const int sg = s0 + s;
                    const int tok = sg < CTXL ? ML + b * CTXL + (dir ? CTXL - 1 - sg : sg) : b * SEQ + (dir ? SEQ - 1 - (sg - CTXL) : (sg - CTXL));
                    HFB[((size_t)dir * MT + tok) * 512 + h * 128 + e] = num / fmaxf(fabsf(den), 1.f); }
            }
        }
    }
    __syncthreads();
}

#define TR_READ2(r0, r1, a0, a1) asm volatile("ds_read_b64_tr_b16 %0, %2\n\tds_read_b64_tr_b16 %1, %3\n\ts_waitcnt lgkmcnt(0)" : "=&v"(r0), "=&v"(r1) : "v"(a0), "v"(a1) : "memory")
__device__ __forceinline__ float scan_sum64(float v, int lane) {
    v += __builtin_bit_cast(float, __builtin_amdgcn_update_dpp(0, __builtin_bit_cast(int, v), 0x111, 0xF, 0xF, true));
    v += __builtin_bit_cast(float, __builtin_amdgcn_update_dpp(0, __builtin_bit_cast(int, v), 0x112, 0xF, 0xF, true));
    v += __builtin_bit_cast(float, __builtin_amdgcn_update_dpp(0, __builtin_bit_cast(int, v), 0x114, 0xF, 0xF, true));
    v += __builtin_bit_cast(float, __builtin_amdgcn_update_dpp(0, __builtin_bit_cast(int, v), 0x118, 0xF, 0xF, true));
    const int vi = __builtin_bit_cast(int, v);
    const float t0 = __builtin_bit_cast(float, __builtin_amdgcn_readlane(vi, 15)), t1 = __builtin_bit_cast(float, __builtin_amdgcn_readlane(vi, 31)), t2 = __builtin_bit_cast(float, __builtin_amdgcn_readlane(vi, 47));
    const int row = lane >> 4;
    return v + (row == 0 ? 0.f : (row == 1 ? t0 : (row == 2 ? t0 + t1 : (t0 + t1) + t2)));
}
__device__ __forceinline__ float scan_max64(float v, int lane) {
    const int ninf = __builtin_bit_cast(int, -3.0e38f);
    v = fmaxf(v, __builtin_bit_cast(float, __builtin_amdgcn_update_dpp(ninf, __builtin_bit_cast(int, v), 0x111, 0xF, 0xF, false)));
    v = fmaxf(v, __builtin_bit_cast(float, __builtin_amdgcn_update_dpp(ninf, __builtin_bit_cast(int, v), 0x112, 0xF, 0xF, false)));
    v = fmaxf(v, __builtin_bit_cast(float, __builtin_amdgcn_update_dpp(ninf, __builtin_bit_cast(int, v), 0x114, 0xF, 0xF, false)));
    v = fmaxf(v, __builtin_bit_cast(float, __builtin_amdgcn_update_dpp(ninf, __builtin_bit_cast(int, v), 0x118, 0xF, 0xF, false)));
    const int vi = __builtin_bit_cast(int, v);
    const float t0 = __builtin_bit_cast(float, __builtin_amdgcn_readlane(vi, 15)), t1 = __builtin_bit_cast(float, __builtin_amdgcn_readlane(vi, 31)), t2 = __builtin_bit_cast(float, __builtin_amdgcn_readlane(vi, 47));
    const int row = lane >> 4;
    return fmaxf(v, row == 0 ? -3.0e38f : (row == 1 ? t0 : (row == 2 ? fmaxf(t0, t1) : fmaxf(fmaxf(t0, t1), t2))));
}
__device__ __forceinline__ float log_sigmoid_(float x) { return x >= 0.f ? -log1pf(__expf(-x)) : x - log1pf(__expf(x)); }
__device__ __forceinline__ int ml_tok(int b, int dir, int ch, int s) {
    if (ch < 2) { const int idx = ch * 128 + s; return ML + b * CTXL + (dir ? CTXL - 1 - idx : idx); }
    const int idx = (ch - 2) * 128 + s; return b * SEQ + (dir ? SEQ - 1 - idx : idx);
}
#define TR_READ6(r0, r1, r2, r3, r4, r5, a, o0, o1, o2, o3, o4, o5) asm volatile( \
    "ds_read_b64_tr_b16 %0, %6 offset:" #o0 "\n\tds_read_b64_tr_b16 %1, %6 offset:" #o1 "\n\tds_read_b64_tr_b16 %2, %6 offset:" #o2 "\n\t" \
    "ds_read_b64_tr_b16 %3, %6 offset:" #o3 "\n\tds_read_b64_tr_b16 %4, %6 offset:" #o4 "\n\tds_read_b64_tr_b16 %5, %6 offset:" #o5 "\n\ts_waitcnt lgkmcnt(0)" \
    : "=&v"(r0), "=&v"(r1), "=&v"(r2), "=&v"(r3), "=&v"(r4), "=&v"(r5) : "v"(a) : "memory")
#define TR_READ8(r0, r1, r2, r3, r4, r5, r6, r7, a, b, o0, o1, p0, p1, p2, p3, p4, p5) asm volatile( \
    "ds_read_b64_tr_b16 %0, %8 offset:" #o0 "\n\tds_read_b64_tr_b16 %1, %8 offset:" #o1 "\n\t" \
    "ds_read_b64_tr_b16 %2, %9 offset:" #p0 "\n\tds_read_b64_tr_b16 %3, %9 offset:" #p1 "\n\tds_read_b64_tr_b16 %4, %9 offset:" #p2 "\n\t" \
    "ds_read_b64_tr_b16 %5, %9 offset:" #p3 "\n\tds_read_b64_tr_b16 %6, %9 offset:" #p4 "\n\tds_read_b64_tr_b16 %7, %9 offset:" #p5 "\n\ts_waitcnt lgkmcnt(0)" \
    : "=&v"(r0), "=&v"(r1), "=&v"(r2), "=&v"(r3), "=&v"(r4), "=&v"(r5), "=&v"(r6), "=&v"(r7) : "v"(a), "v"(b) : "memory")
struct FfnItem { unsigned long long s0, s1; f16* dst; int ld, ldd, k0, n0, mode; };
__device__ __forceinline__ void ffn_item(unsigned char* ws, LAS unsigned char* lds, int L, int it, unsigned long long& s0, unsigned long long& s1, f16*& dst, int& ld, int& ldd, int& k0, int& n0, int& mode) {
    const bool moe = (L & 1); const int fi = L >> 1, nexp = moe ? NE : 1;
    const int e = it / FFN_ITEMS, r = it - e * FFN_ITEMS;
    const size_t eo = (size_t)(fi * nexp + e) * D * DFF;
    unsigned char* W = ws + WS_W;
    if (r < 16 * (NFF2 / 32)) { mode = 1; s0 = (unsigned long long)((moe ? INP(I_MW1) : INP(I_FW1)) + eo); s1 = (unsigned long long)((moe ? INP(I_MW3) : INP(I_FW3)) + eo);
        ld = DFF; ldd = D; k0 = 64 * (r / (NFF2 / 32)); n0 = 32 * (r % (NFF2 / 32)); dst = (f16*)(W + (moe ? WO_13 : WO_13D)) + (size_t)e * NFF2 * D; }
    else { const int r2 = r - 16 * (NFF2 / 32); mode = 0; s0 = (unsigned long long)((moe ? INP(I_MW2) : INP(I_FW2)) + eo); s1 = s0;
        ld = D; ldd = DFF; k0 = 64 * (r2 / 32); n0 = 32 * (r2 % 32); dst = (f16*)(W + (moe ? WO_2 : WO_2D)) + (size_t)e * D * DFF; }
}
__device__ __forceinline__ void ffn_dma_issue(unsigned char* ws, LAS unsigned char* lds, LAS unsigned char* cscr, int L, int it, int lane) {
    unsigned long long s0, s1; f16* dst; int ld, ldd, k0, n0, mode; ffn_item(ws, lds, L, it, s0, s1, dst, ld, ldd, k0, n0, mode);
    const int n = n0 + 4 * (lane & 7);
    const bool useS1 = (mode != 0) && (n & 4);
    const unsigned lo = useS1 ? (unsigned)s1 : (unsigned)s0, hi = useS1 ? (unsigned)(s1 >> 32) : (unsigned)(s0 >> 32);
    const float* sp = (const float*)(const __attribute__((address_space(1))) float*)(((unsigned long long)hi << 32) | lo);
    sp += (mode == 0 ? n : 4 * (n >> 3)) + (size_t)(k0 + (lane >> 3)) * ld;
#pragma unroll
    for (int j = 0; j < 8; ++j) __builtin_amdgcn_global_load_lds((const unsigned*)(sp + (size_t)(8 * j) * ld), (LAS unsigned*)(cscr + j * 1040), 16, 0, 2);
}
__device__ __forceinline__ void ffn_dma_finish(unsigned char* ws, LAS unsigned char* lds, LAS unsigned char* cscr, int L, int it, int lane) {
    unsigned long long s0, s1; f16* dst; int ld, ldd, k0, n0, mode; ffn_item(ws, lds, L, it, s0, s1, dst, ld, ldd, k0, n0, mode);
    const int c8 = lane & 7;
#pragma unroll
    for (int jj = 0; jj < 4; ++jj) { const int nn = (lane >> 3) + 8 * jj; const LAS float* sc = (const LAS float*)(cscr + c8 * 1040) + nn;
        f16x8 h;
#pragma unroll
        for (int q = 0; q < 8; ++q) h[q] = (f16)sc[q * 32];
        *(f16x8*)(dst + (size_t)(n0 + nn) * ldd + k0 + 8 * c8) = h; }
}
struct ConvSeg { int LA, a0, an, LB, b0, bn; };
__device__ __forceinline__ void mlstm_mfma_phase(unsigned char* ws, int layer, LAS unsigned char* lds, int vb, int nvb, int tid, const ConvSeg cs) {
    const int conv_n = cs.an + cs.bn;
    constexpr int KROW = 272, VROW = 112, CROW = 272;
    static_assert(16 * VROW == 1792 && 4 * VROW == 448 && 4 * KROW == 1088, "TR_READ offsets below are written out as literals");
    constexpr int OFF_K = 0, OFF_V = 128 * KROW, OFF_CT = OFF_V + 128 * VROW, OFF_G = OFF_CT + 48 * CROW, GBUF = 2560, OFF_RAW = OFF_G + 2 * GBUF;
    LAS unsigned char* Ks = lds + OFF_K; LAS unsigned char* Vs = lds + OFF_V; LAS unsigned char* CTs = lds + OFF_CT;
    const f16* P1 = (const f16*)(ws + WS_P1);
    const f16* QK = (const f16*)(ws + WS_QK);
    const float* MLG = (const float*)(ws + WS_MLG);
    float* HFB = (float*)(ws + WS_HFB);
    const float* gb = INP(I_GBIAS) + layer * 16;
    const int lane = tid & 63, w = __builtin_amdgcn_readfirstlane(tid >> 6), g = lane >> 4, c = lane & 15, cq = c >> 2, cp = c & 3;
    const int srow = tid >> 2, sq = tid & 3;
    LAS unsigned char* cscr = lds + OFF_RAW + 2 * 2304 * 4 + w * 8320;
    const int cgw = vb * NWAVES + w, cngw = nvb * NWAVES;
    for (int job = vb; job < 256; job += nvb) {
        const int b = job >> 5, h = (job >> 3) & 3, dir = (job >> 2) & 1, eq = job & 3;
        const float gbi = gb[dir * 8 + h], gbf = gb[dir * 8 + 4 + h];
        __syncthreads();
        for (int i = tid; i < 48 * CROW / 16; i += NTHREADS) *(LAS u32x4*)(CTs + 16 * i) = (u32x4){0u, 0u, 0u, 0u};
        if (sq == 0) { unsigned ob = 0x3C00u, zb = 0u; asm volatile("" : "+v"(ob), "+v"(zb));
            *(LAS u32x4*)(Vs + srow * VROW + 64) = (u32x4){ob, zb, zb, zb}; *(LAS u32x4*)(Vs + srow * VROW + 80) = (u32x4){zb, zb, zb, zb}; }
        f32x4 C[3];
#pragma unroll
        for (int et = 0; et < 3; ++et) C[et] = (f32x4){0.f, 0.f, 0.f, 0.f};
        float m = -1e30f;
        { LAS float* raw = (LAS float*)(lds + OFF_RAW);
          for (int i = tid; i < 2304; i += NTHREADS) { const int tk = ml_tok(b, dir, i >> 7, i & 127); raw[i] = MLG[(size_t)tk * 16 + dir * 8 + h]; raw[2304 + i] = MLG[(size_t)tk * 16 + dir * 8 + 4 + h]; } }
        f16x8 kreg[4], vreg, qreg[4];
        { const int tokS = ml_tok(b, dir, 0, srow);
#pragma unroll
          for (int i = 0; i < 4; ++i) kreg[i] = *(const f16x8*)(QK + (size_t)tokS * 1024 + 512 + h * 128 + (4 * i + sq) * 8);
          vreg = *(const f16x8*)(P1 + (size_t)tokS * NP1 + 2048 + h * 128 + eq * 32 + sq * 8);
          const int tokT = ml_tok(b, dir, 0, 16 * w + c);
#pragma unroll
          for (int kd = 0; kd < 4; ++kd) qreg[kd] = *(const f16x8*)(QK + (size_t)tokT * 1024 + h * 128 + 32 * kd + 8 * g);
        }
        __syncthreads();
#define ML_GATES(chn_) do { LAS float* gq = (LAS float*)(lds + OFF_G + ((chn_) & 1) * GBUF); const LAS float* raw = (const LAS float*)(lds + OFF_RAW) + (chn_) * 128; \
            const float ig0 = raw[lane] + gbi, ig1 = raw[lane + 64] + gbi, lf0 = log_sigmoid_(raw[2304 + lane] + gbf), lf1 = log_sigmoid_(raw[2304 + lane + 64] + gbf); \
            const float b0 = scan_sum64(lf0, lane), tot0 = __shfl(b0, 63), b1 = scan_sum64(lf1, lane) + tot0, b_end = __shfl(b1, 63); \
            const float ct0 = ig0 - b0, ct1 = ig1 - b1; \
            const float a0 = scan_max64(ct0, lane), am0 = __shfl(a0, 63), a1 = fmaxf(scan_max64(ct1, lane), am0), amax = __shfl(a1, 63); \
            const float M = fmaxf(m, amax), Mt0 = fmaxf(a0, m), Mt1 = fmaxf(a1, m); \
            gq[lane] = ct0; gq[lane + 64] = ct1; gq[128 + lane] = Mt0; gq[192 + lane] = Mt1; \
            gq[256 + lane] = __expf(-(b0 + Mt0)); gq[320 + lane] = __expf(-(b1 + Mt1)); gq[384 + lane] = __expf(m - Mt0); gq[448 + lane] = __expf(m - Mt1); \
            ((LAS f16*)(gq + 512))[lane] = (f16)__expf(ct0 - M); ((LAS f16*)(gq + 512))[lane + 64] = (f16)__expf(ct1 - M); \
            if (lane == 0) gq[576] = __expf(m - M); \
            m = b_end + M; } while (0)
        if (w == 0) ML_GATES(0);
        for (int ch = 0; ch < 18; ++ch) {
            LAS float* g_ct = (LAS float*)(lds + OFF_G + (ch & 1) * GBUF); LAS float* g_mt = g_ct + 128; LAS float* g_emt = g_ct + 256; LAS float* g_wi = g_ct + 384; LAS f16* g_w16 = (LAS f16*)(g_ct + 512);
#pragma unroll
            for (int i = 0; i < 4; ++i) *(LAS f16x8*)(Ks + srow * KROW + (4 * i + sq) * 16) = kreg[i];
            *(LAS f16x8*)(Vs + srow * VROW + sq * 16) = vreg;
            f16x8 qf[4];
#pragma unroll
            for (int kd = 0; kd < 4; ++kd) qf[kd] = qreg[kd];
            const int tokT = ml_tok(b, dir, ch, 16 * w + c);
            __syncthreads();
            if (conv_n > 0 && ch > 0) { const int itp = (ch - 1) * cngw + cgw; if (itp < conv_n) { asm volatile("s_waitcnt vmcnt(2)" ::: "memory"); ffn_dma_finish(ws, lds, cscr, itp < cs.an ? cs.LA : cs.LB, itp < cs.an ? cs.a0 + itp : cs.b0 + itp - cs.an, lane); } }
            if (ch + 1 < 18) { const int tokS = ml_tok(b, dir, ch + 1, srow);
#pragma unroll
                for (int i = 0; i < 4; ++i) kreg[i] = *(const f16x8*)(QK + (size_t)tokS * 1024 + 512 + h * 128 + (4 * i + sq) * 8);
                vreg = *(const f16x8*)(P1 + (size_t)tokS * NP1 + 2048 + h * 128 + eq * 32 + sq * 8);
                const int tokN = ml_tok(b, dir, ch + 1, 16 * w + c);
#pragma unroll
                for (int kd = 0; kd < 4; ++kd) qreg[kd] = *(const f16x8*)(QK + (size_t)tokN * 1024 + h * 128 + 32 * kd + 8 * g);
            }
            const float decay = g_ct[576];
            f32x4 st[8];
#pragma unroll
            for (int j = 0; j < 8; ++j) { st[j] = (f32x4){0.f, 0.f, 0.f, 0.f};
                if (j <= w) {
#pragma unroll
                    for (int ks = 0; ks < 4; ++ks) { const f16x8 a = *(const LAS f16x8*)(Ks + (16 * j + c) * KROW + (32 * ks + 8 * g) * 2);
                        st[j] = __builtin_amdgcn_mfma_f32_16x16x32_f16(a, qf[ks], st[j], 0, 0, 0); } } }
            const int tl = 16 * w + c; const float mt = g_mt[tl];
            f16x8 pf[4];
#pragma unroll
            for (int ks = 0; ks < 4; ++ks) {
#pragma unroll
                for (int hh = 0; hh < 2; ++hh) { const int j = 2 * ks + hh;
                    if (j <= w) { const f32x4 cv = *(const LAS f32x4*)(g_ct + 16 * j + 4 * g);
#pragma unroll
                        for (int i = 0; i < 4; ++i) { const int sl = 16 * j + 4 * g + i; const float v = (sl <= tl) ? st[j][i] * __expf(cv[i] - mt) : 0.f; pf[ks][4 * hh + i] = (f16)v; } }
                    else {
#pragma unroll
                        for (int i = 0; i < 4; ++i) pf[ks][4 * hh + i] = (f16)0.f; } } }
            if (conv_n > 0) { const int itc = ch * cngw + cgw; if (itc < conv_n) { LDS_WAIT(); ffn_dma_issue(ws, lds, cscr, itc < cs.an ? cs.LA : cs.LB, itc < cs.an ? cs.a0 + itc : cs.b0 + itc - cs.an, lane); } }
            f32x4 o1[3], o2[3];
#pragma unroll
            for (int et = 0; et < 3; ++et) { o1[et] = (f32x4){0.f, 0.f, 0.f, 0.f}; o2[et] = (f32x4){0.f, 0.f, 0.f, 0.f}; }
            const unsigned vs_base = (unsigned)(size_t)Vs, ks_base = (unsigned)(size_t)Ks;
#pragma unroll
            for (int ks = 0; ks < 4; ++ks) if (2 * ks <= w) {
                f16x4 t0, t1, t2, t3, t4, t5;
                const unsigned a0 = vs_base + (32 * ks + 4 * g + cq) * VROW + (4 * cp) * 2;
                TR_READ6(t0, t1, t2, t3, t4, t5, a0, 0, 1792, 32, 1824, 64, 1856);
                o1[0] = __builtin_amdgcn_mfma_f32_16x16x32_f16(__builtin_shufflevector(t0, t1, 0, 1, 2, 3, 4, 5, 6, 7), pf[ks], o1[0], 0, 0, 0);
                o1[1] = __builtin_amdgcn_mfma_f32_16x16x32_f16(__builtin_shufflevector(t2, t3, 0, 1, 2, 3, 4, 5, 6, 7), pf[ks], o1[1], 0, 0, 0);
                o1[2] = __builtin_amdgcn_mfma_f32_16x16x32_f16(__builtin_shufflevector(t4, t5, 0, 1, 2, 3, 4, 5, 6, 7), pf[ks], o1[2], 0, 0, 0); }
#pragma unroll
            for (int kd = 0; kd < 4; ++kd) {
#pragma unroll
                for (int et = 0; et < 3; ++et) { const f16x8 av = *(const LAS f16x8*)(CTs + (16 * et + c) * CROW + (32 * kd + 8 * g) * 2);
                    o2[et] = __builtin_amdgcn_mfma_f32_16x16x32_f16(av, qf[kd], o2[et], 0, 0, 0); } }
            { const float wi = g_wi[tl];
              const float denl = o1[2][0] + wi * o2[2][0];
              const float den = __shfl(denl, c);
              const float inv = 1.f / fmaxf(fabsf(den), g_emt[tl]);
              float* hp = HFB + ((size_t)dir * MT + tokT) * 512 + h * 128 + eq * 32 + 4 * g;
#pragma unroll
              for (int et = 0; et < 2; ++et) *(f32x4*)(hp + 16 * et) = (o1[et] + o2[et] * wi) * inv; }
#pragma unroll
            for (int et = 0; et < 3; ++et) C[et] = C[et] * decay;
#pragma unroll
            for (int ks = 0; ks < 4; ++ks) { f16x4 k0, k1, v0, v1, v2, v3, v4, v5;
                const unsigned ka = ks_base + (32 * ks + 8 * g + cq) * KROW + (16 * w + 4 * cp) * 2;
                const unsigned va = vs_base + (32 * ks + 8 * g + cq) * VROW + (4 * cp) * 2;
                TR_READ8(k0, k1, v0, v1, v2, v3, v4, v5, ka, va, 0, 1088, 0, 448, 32, 480, 64, 512);
                f16x8 kt = __builtin_shufflevector(k0, k1, 0, 1, 2, 3, 4, 5, 6, 7);
                const f16x8 wv = *(const LAS f16x8*)(g_w16 + 32 * ks + 8 * g);
                kt = kt * wv;
                C[0] = __builtin_amdgcn_mfma_f32_16x16x32_f16(kt, __builtin_shufflevector(v0, v1, 0, 1, 2, 3, 4, 5, 6, 7), C[0], 0, 0, 0);
                C[1] = __builtin_amdgcn_mfma_f32_16x16x32_f16(kt, __builtin_shufflevector(v2, v3, 0, 1, 2, 3, 4, 5, 6, 7), C[1], 0, 0, 0);
                C[2] = __builtin_amdgcn_mfma_f32_16x16x32_f16(kt, __builtin_shufflevector(v4, v5, 0, 1, 2, 3, 4, 5, 6, 7), C[2], 0, 0, 0); }
            if (w == 0 && ch + 1 < 18) ML_GATES(ch + 1);
            __syncthreads();
#pragma unroll
            for (int et = 0; et < 3; ++et) { f16x4 cv; cv[0] = (f16)C[et][0]; cv[1] = (f16)C[et][1]; cv[2] = (f16)C[et][2]; cv[3] = (f16)C[et][3];
                *(LAS f16x4*)(CTs + (16 * et + c) * CROW + (16 * w + 4 * g) * 2) = cv; }
        }
        if (conv_n > 0) { const int itp = 17 * cngw + cgw; if (itp < conv_n) { asm volatile("s_waitcnt vmcnt(2)" ::: "memory"); ffn_dma_finish(ws, lds, cscr, itp < cs.an ? cs.LA : cs.LB, itp < cs.an ? cs.a0 + itp : cs.b0 + itp - cs.an, lane); } }
#undef ML_GATES
    }
    __syncthreads();
}

__device__ __forceinline__ void na_mfma_phase(unsigned char* ws, int layer, LAS unsigned char* lds, int vb, int nvb, int tid) {
    constexpr int VROW = 144;
    constexpr int OFF_B = 768 * VROW, OFF_M = OFF_B + 2048;
    LAS unsigned char* Vs = lds; LAS float* Bs = (LAS float*)(lds + OFF_B); LAS float* Ms = (LAS float*)(lds + OFF_M);
    const f16* P1 = (const f16*)(ws + WS_P1);
    f16* CAT = (f16*)(ws + WS_CAT);
    const int lane = tid & 63, w = __builtin_amdgcn_readfirstlane(tid >> 6), g = lane >> 4, c = lane & 15, cq = c >> 2, cp = c & 3;
    const int qt = w & 3, kh = w >> 2, kt0 = qt < 2 ? 0 : 1;
    const int nU = 1024 + ((layer == DEPTH - 1) ? 0 : 128);
    for (int un = vb; un < nU; un += nvb) {
        const bool lat = un < 1024;
        int b, r, h, qblk;
        if (lat) { b = un >> 7; r = (un >> 2) & 31; h = un & 3; qblk = 0; } else { const int u2 = un - 1024; b = u2 >> 4; h = (u2 >> 2) & 3; qblk = u2 & 3; r = 0; }
        int r0 = r - 4; r0 = r0 < 0 ? 0 : (r0 > 24 ? 24 : r0);
        const int qtok = lat ? b * SEQ + r * 64 + 16 * qt + c : ML + b * CTXL + qblk * 64 + 16 * qt + c;
        __syncthreads();
        {
            const int nch = (lat ? 768 : 256) * 8;
            for (int ch = tid; ch < nch; ch += NTHREADS) { const int row = ch >> 3, pc = ch & 7;
                const int tok = lat ? (row < 512 ? b * SEQ + (r0 + (row >> 6)) * 64 + (row & 63) : ML + b * CTXL + row - 512) : ML + b * CTXL + row;
                *(LAS u32x4*)(Vs + row * VROW + pc * 16) = *(const u32x4*)(P1 + (size_t)tok * NP1 + 768 + h * 64 + pc * 8); }
            if (lat) { const float* rp = INP(I_RPB) + (size_t)(layer * 4 + h) * 465; for (int i = tid; i < 465; i += NTHREADS) Bs[i] = rp[i]; }
        }
        f16x8 qf[2];
#pragma unroll
        for (int ks = 0; ks < 2; ++ks) qf[ks] = *(const f16x8*)(P1 + (size_t)qtok * NP1 + 256 + h * 64 + 32 * ks + 8 * g);
        f32x4 st[20];
#pragma unroll
        for (int idx = 0; idx < 20; ++idx) {
            st[idx] = (f32x4){0.f, 0.f, 0.f, 0.f};
            if (idx >= 12 || lat) {
                int tok;
                if (idx < 12) tok = b * SEQ + (r0 + kh * 4 + idx / 3) * 64 + 16 * (kt0 + idx % 3) + c;
                else tok = ML + b * CTXL + kh * 128 + 16 * (idx - 12) + c;
                const f16* kp = P1 + (size_t)tok * NP1 + 512 + h * 64 + 8 * g;
                const f16x8 k0 = *(const f16x8*)kp, k1 = *(const f16x8*)(kp + 32);
                st[idx] = __builtin_amdgcn_mfma_f32_16x16x32_f16(k0, qf[0], st[idx], 0, 0, 0);
                st[idx] = __builtin_amdgcn_mfma_f32_16x16x32_f16(k1, qf[1], st[idx], 0, 0, 0);
            }
        }
        __syncthreads();
        const int qc = 16 * qt + c; int cs = qc - 8; cs = cs < 0 ? 0 : (cs > 48 ? 48 : cs);
        float mx = -3.0e38f;
#pragma unroll
        for (int idx = 0; idx < 20; ++idx) {
            if (idx < 12) {
                const int wrow = kh * 4 + idx / 3, kt = kt0 + idx % 3;
#pragma unroll
                for (int i = 0; i < 4; ++i) { const int kc = 16 * kt + 4 * g + i; const bool ok = lat && kc >= cs && kc < cs + 16;
                    const float bias = ok ? Bs[(r0 + wrow - r + 7) * 31 + kc - qc + 15] : 0.f;
                    st[idx][i] = ok ? st[idx][i] + bias : -1.0e30f; }
            }
#pragma unroll
            for (int i = 0; i < 4; ++i) mx = fmaxf(mx, st[idx][i]);
        }
        mx = fmaxf(mx, __shfl_xor(mx, 16)); mx = fmaxf(mx, __shfl_xor(mx, 32));
        float l = 0.f;
        f16x8 pf[10];
#pragma unroll
        for (int idx = 0; idx < 20; ++idx) {
#pragma unroll
            for (int i = 0; i < 4; ++i) { const float p = __expf(st[idx][i] - mx); l += p; pf[idx >> 1][4 * (idx & 1) + i] = (f16)p; }
        }
        l += __shfl_xor(l, 16); l += __shfl_xor(l, 32);
        f32x4 o[4];
#pragma unroll
        for (int dt = 0; dt < 4; ++dt) o[dt] = (f32x4){0.f, 0.f, 0.f, 0.f};
        const unsigned vs_base = (unsigned)(size_t)Vs;
#pragma unroll
        for (int kk = 0; kk < 10; ++kk) {
            if (kk >= 6 || lat) {
                int rb0, rb1;
                if (kk < 6) { const int i0 = 2 * kk, i1 = 2 * kk + 1; rb0 = (kh * 4 + i0 / 3) * 64 + 16 * (kt0 + i0 % 3); rb1 = (kh * 4 + i1 / 3) * 64 + 16 * (kt0 + i1 % 3); }
                else { rb0 = (lat ? 512 : 0) + kh * 128 + 16 * (2 * kk - 12); rb1 = rb0 + 16; }
                { f16x4 x0, x1, x2, x3, y0, y1, y2, y3;
                  const unsigned a0 = vs_base + (rb0 + 4 * g + cq) * VROW + (4 * cp) * 2, a1 = vs_base + (rb1 + 4 * g + cq) * VROW + (4 * cp) * 2;
                  asm volatile("ds_read_b64_tr_b16 %0, %8\n\tds_read_b64_tr_b16 %1, %8 offset:32\n\tds_read_b64_tr_b16 %2, %8 offset:64\n\tds_read_b64_tr_b16 %3, %8 offset:96\n\t"
                               "ds_read_b64_tr_b16 %4, %9\n\tds_read_b64_tr_b16 %5, %9 offset:32\n\tds_read_b64_tr_b16 %6, %9 offset:64\n\tds_read_b64_tr_b16 %7, %9 offset:96\n\ts_waitcnt lgkmcnt(0)"
                               : "=&v"(x0), "=&v"(x1), "=&v"(x2), "=&v"(x3), "=&v"(y0), "=&v"(y1), "=&v"(y2), "=&v"(y3) : "v"(a0), "v"(a1) : "memory");
                  o[0] = __builtin_amdgcn_mfma_f32_16x16x32_f16(__builtin_shufflevector(x0, y0, 0, 1, 2, 3, 4, 5, 6, 7), pf[kk], o[0], 0, 0, 0);
                  o[1] = __builtin_amdgcn_mfma_f32_16x16x32_f16(__builtin_shufflevector(x1, y1, 0, 1, 2, 3, 4, 5, 6, 7), pf[kk], o[1], 0, 0, 0);
                  o[2] = __builtin_amdgcn_mfma_f32_16x16x32_f16(__builtin_shufflevector(x2, y2, 0, 1, 2, 3, 4, 5, 6, 7), pf[kk], o[2], 0, 0, 0);
                  o[3] = __builtin_amdgcn_mfma_f32_16x16x32_f16(__builtin_shufflevector(x3, y3, 0, 1, 2, 3, 4, 5, 6, 7), pf[kk], o[3], 0, 0, 0); }
            }
        }
        LAS float* mp = Ms + (qt * 64 + lane) * 18;
        if (kh == 1) { mp[0] = mx; mp[1] = l;
#pragma unroll
            for (int dt = 0; dt < 4; ++dt) *(LAS f32x4*)(mp + 2 + 4 * dt) = o[dt]; }
        __syncthreads();
        if (kh == 0) {
            const float mx2 = mp[0], l2 = mp[1], mxn = fmaxf(mx, mx2), fa = __expf(mx - mxn), fb = __expf(mx2 - mxn);
            const float inv = 1.f / (l * fa + l2 * fb);
            f16* op = CAT + (size_t)qtok * D + 256 + h * 64 + 4 * g;
#pragma unroll
            for (int dt = 0; dt < 4; ++dt) { const f32x4 o2 = *(const LAS f32x4*)(mp + 2 + 4 * dt); const f32x4 v = (o[dt] * fa + o2 * fb) * inv;
                f16x4 hv; hv[0] = (f16)v[0]; hv[1] = (f16)v[1]; hv[2] = (f16)v[2]; hv[3] = (f16)v[3];
                *(f16x4*)(op + 16 * dt) = hv; }
        }
    }
    __syncthreads();
}

__device__ __forceinline__ void mout_phase(unsigned char* ws, LAS unsigned char* lds, int layer, int gw, int ngw, int lane) {
    const f16* P1 = (const f16*)(ws + WS_P1);
    const float* HFB = (const float*)(ws + WS_HFB);
    f16* CAT = (f16*)(ws + WS_CAT);
    const float* nw = INP(I_NORMW) + layer * 512;
    const int nrows = (layer == DEPTH - 1) ? ML : MT;
    const f32x4 nw0 = *(const f32x4*)(nw + 8 * lane), nw1 = *(const f32x4*)(nw + 8 * lane + 4);
    f32x4 a0n, a1n, b0n, b1n; f16x8 ogn;
#define MOUT_LOAD(r_) do { const float* pf = HFB + (size_t)(r_) * 512 + 8 * lane; const float* pb = HFB + ((size_t)MT + (r_)) * 512 + 8 * lane; \
        a0n = *(const f32x4*)pf; a1n = *(const f32x4*)(pf + 4); b0n = *(const f32x4*)pb; b1n = *(const f32x4*)(pb + 4); ogn = *(const f16x8*)(P1 + (size_t)(r_) * NP1 + 2560 + 8 * lane); } while (0)
    if (gw < nrows) MOUT_LOAD(gw);
    for (int r = gw; r < nrows; r += ngw) {
        const f32x4 a0 = a0n, a1 = a1n, b0 = b0n, b1 = b1n; const f16x8 og = ogn;
        if (r + ngw < nrows) MOUT_LOAD(r + ngw);
        float v[8] = {a0[0] + b0[0], a0[1] + b0[1], a0[2] + b0[2], a0[3] + b0[3], a1[0] + b1[0], a1[1] + b1[1], a1[2] + b1[2], a1[3] + b1[3]};
        float s = 0.f;
#pragma unroll
        for (int i = 0; i < 8; ++i) s += v[i];
        s = row16_sum(s);
        const float mean = s * (1.f / 128.f); float q = 0.f;
#pragma unroll
        for (int i = 0; i < 8; ++i) { v[i] -= mean; q += v[i] * v[i]; }
        q = row16_sum(q);
        const float rstd = 1.f / sqrtf(q * (1.f / 128.f) + LN_EPS);
        f16x8 h;
#pragma unroll
        for (int i = 0; i < 8; ++i) h[i] = (f16)((float)og[i] * v[i] * rstd * (i < 4 ? nw0[i] : nw1[i - 4]));
        *(f16x8*)(CAT + (size_t)r * D + 512 + 8 * lane) = h;
    }
#undef MOUT_LOAD
}

__device__ __forceinline__ void moe_tail(int nblk, int& tail_blocks, int& S) {
    const int R = (nblk & 63) * 4;
    tail_blocks = nblk & 63; S = R == 0 ? 1 : (R <= 36 ? 7 : (R <= 64 ? 4 : (R <= 128 ? 2 : 1)));
    if (S == 1) tail_blocks = 0;
}
constexpr int NPH = 13;
#if MK_FUSED
#define GRID_BAR() xcd_barrier(bar)
#else
#define GRID_BAR() do {} while (0)
#endif
template <int layer>
__device__ __forceinline__ void layer_body(const Args& args, LAS unsigned char* lds, const int tid0, const int wave0, const int vb0, const int nvb0,
                                           unsigned char* ws0, unsigned* ctl, const XcdBarrier& bar, const int s_lo, const int s_hi) {
        constexpr bool last = (layer == DEPTH - 1), moe = (layer & 1) != 0;
        constexpr int mi = layer >> 1;
        const int nrows = last ? ML : MT;
#define STEP(p) (layer * NPH + (p))
#if MK_FUSED
#define RUN(p) (((PH_MASK >> (p)) & 1) != 0)
#else
#define RUN(p) (((PH_MASK >> (p)) & 1) && STEP(p) >= s_lo && STEP(p) < s_hi)
#endif
#define NREP(p) (((p) == PROBE_PH && (PROBE_LAYER < 0 || layer == PROBE_LAYER)) ? 1 + PROBE_REP : 1)
#define FRESH_TID() int tid = tid0; asm volatile("" : "+v"(tid)); const int lane = tid & 63; (void)lane; \
    const unsigned long long wsi_ = opaque_u64((unsigned long long)ws0); unsigned char* ws = (unsigned char*)(__attribute__((address_space(1))) unsigned char*)wsi_; const int wave = opaque_u32(wave0), vb = opaque_u32(vb0), nvb = opaque_u32(nvb0); const int gw = vb * NWAVES + wave, ngw = nvb * NWAVES; (void)gw; (void)ngw; \
    f16* U16 = (f16*)(ws + WS_U16); f16* P1 = (f16*)(ws + WS_P1); f16* CAT = (f16*)(ws + WS_CAT); f16* Z16 = (f16*)(ws + WS_Z16); \
    f16* YF = (f16*)(ws + WS_YF); f16* XS = (f16*)(ws + WS_XS); f16* HB16 = (f16*)(ws + WS_P1); f16* AMOE = (f16*)(ws + WS_HFB); unsigned char* W = ws + WS_W; \
    int2* TOKE = (int2*)(ws + WS_TOK + TK_E); float2* TOKP = (float2*)(ws + WS_TOK + TK_P); int2* TOKPOS = (int2*)(ws + WS_TOK + TK_POS); int2* TOKDEST = (int2*)(ws + WS_TOK + TK_DEST); \
    int* BLKE = (int*)(ws + WS_TOK + TK_BLKE); \
    (void)U16; (void)P1; (void)CAT; (void)Z16; (void)YF; (void)XS; (void)HB16; (void)AMOE; (void)W; (void)TOKE; (void)TOKP; (void)TOKPOS; (void)TOKDEST; (void)BLKE
#if MK_FUSED
#define SEAM(p) do { if (!(last && (p) == NPH - 1)) GRID_BAR(); } while (0)
#else
#define SEAM(p) do { } while (0)
#endif

        if (layer == 0 && RUN(0)) { for (int rep_ = 0; rep_ < NREP(0); ++rep_) {
            FRESH_TID();
            {
                LAS float* sv = (LAS float*)(lds + 69632);
                LAS float* red = sv + 9 * 1024;
                for (int i = tid; i < 9 * 1024; i += NTHREADS) { const int r = i >> 10, k = i & 1023; const float c = r < 8 ? INP(I_C)[r * 1024 + k] : INP(I_CCTX)[k]; sv[i] = silu_(c); }
                __syncthreads();
                const int kg = tid >> 7, jj = tid & 127;
                for (int job = vb; job < 4 * 48; job += nvb) {
                    const int l = job / 48, j = (job % 48) * 128 + jj;
                    const float* wp = INP(I_WMOD) + (size_t)l * D * 6144 + j;
                    float acc[9];
#pragma unroll
                    for (int r = 0; r < 9; ++r) acc[r] = 0.f;
                    for (int k = kg * 256; k < kg * 256 + 256; ++k) { const float w = wp[(size_t)k * 6144];
#pragma unroll
                        for (int r = 0; r < 9; ++r) acc[r] += sv[r * 1024 + k] * w; }
#pragma unroll
                    for (int r = 0; r < 9; ++r) red[(kg * 9 + r) * 128 + jj] = acc[r];
                    __syncthreads();
                    for (int i = tid; i < 9 * 128; i += NTHREADS) { const int r = i >> 7, c = i & 127;
                        const float s = (red[(0 * 9 + r) * 128 + c] + red[(1 * 9 + r) * 128 + c]) + (red[(2 * 9 + r) * 128 + c] + red[(3 * 9 + r) * 128 + c]);
                        const int jc = (job % 48) * 128 + c;
                        ((float*)(ws + WS_MOD))[(size_t)(l * 9 + r) * 6144 + jc] = s + INP(I_BMOD)[l * 6144 + jc]; }
                    __syncthreads();
                }
            }
            if (vb == 0) for (int i = tid; i < 2048; i += NTHREADS) { const int p = i >> 5, fi = i & 31; const float inv = exp2f(-(float)fi * (13.287712379549449f / 32.f));
                float sn, cs; sincosf((float)p * inv, &sn, &cs); ((float2*)(ws + WS_ROPE))[i] = make_float2(cs, sn); }
            conv_layer(ws, 0, lds, gw, ngw, wave, lane, 0);
            SEAM(0);
        } }
        if (layer == 0 && RUN(1)) { for (int rep_ = 0; rep_ < NREP(1); ++rep_) {
            FRESH_TID();
            LAS float* GT = (LAS float*)(lds + 73728);
            load_gate_table(lds, 0, GT, tid);
            { f32x4 xn[4], shn[4], scn[4];
#define LOAD_MOD0(r_) do { const float* q_ = mod_row(ws, lds, 0, (r_)); _Pragma("unroll") for (int j = 0; j < 4; ++j) { shn[j] = *(const f32x4*)(q_ + 256 * j + 4 * lane); scn[j] = *(const f32x4*)(q_ + 1024 + 256 * j + 4 * lane); } } while (0)
              if (gw < MT) { load_x<0>(ws, lds, gw, xn, lane); LOAD_MOD0(gw); }
              for (int r = gw; r < MT; r += ngw) { f32x4 x[4], sh[4], sc[4];
#pragma unroll
                  for (int j = 0; j < 4; ++j) { x[j] = xn[j]; sh[j] = shn[j]; sc[j] = scn[j]; }
                  if (r + ngw < MT) { load_x<0>(ws, lds, r + ngw, xn, lane); LOAD_MOD0(r + ngw); }
                  row_A_pre(ws, r, x, sh, sc, GT, lane); } }
            SEAM(1);
        } }
        if (RUN(2)) { for (int rep_ = 0; rep_ < NREP(2); ++rep_) {
            FRESH_TID();
            EpiP1 E{P1};
            gemm_run(lds, U16, D, D, MT, NP1, (const f16*)(W + WO_IN), 0, nullptr, E, vb, nvb, tid);
            SEAM(2);
        } }
        if (RUN(3)) { for (int rep_ = 0; rep_ < NREP(3); ++rep_) {
            FRESH_TID();
            pool_phase(ws, layer, lds, vb, nvb, tid);
#if USE_NA_MFMA
            na_mfma_phase(ws, layer, lds, vb, nvb, tid);
#else
            na_phase(ws, layer, lds, gw, ngw, wave, lane);
#endif
            mlprep_phase(ws, lds, layer, gw, ngw, lane);
            SEAM(3);
        } }
#if USE_MLSTM_MFMA
        if (RUN(4)) { for (int rep_ = 0; rep_ < NREP(4); ++rep_) { FRESH_TID(); ConvSeg cs; conv_seg(layer, nvb, cs.LA, cs.a0, cs.an, cs.LB, cs.b0, cs.bn); mlstm_mfma_phase(ws, layer, lds, vb, nvb, tid, cs); SEAM(4); } }
#else
        if (RUN(4)) { for (int rep_ = 0; rep_ < NREP(4); ++rep_) { FRESH_TID(); mlstm_naive_phase(ws, layer, lds, vb, nvb, tid); SEAM(4); } }
#endif
        if (RUN(5)) { for (int rep_ = 0; rep_ < NREP(5); ++rep_) { FRESH_TID(); mout_phase(ws, lds, layer, gw, ngw, lane); SEAM(5); } }
        if (RUN(6)) { for (int rep_ = 0; rep_ < NREP(6); ++rep_) {
            FRESH_TID();
            { EpiMerge E{P1, Z16, (float*)(ws + WS_YF + YF_PART)}; gemm_run(lds, CAT, D, D, nrows, D, (const f16*)(W + WO_BP), 0, nullptr, E, vb, nvb, tid, last ? 0 : MC, 4); }
            SEAM(6);
        } }
        if (RUN(7)) { for (int rep_ = 0; rep_ < NREP(7); ++rep_) {
            FRESH_TID();
            if constexpr (!last) {
                const float* PZ = (const float*)(ws + WS_YF + YF_PART);
                for (int r = gw; r < MC; r += ngw) { f32x4 z[4]; load_row_sum(PZ + (size_t)r * D, (size_t)MC * D, 4, z, lane); store_row_h(Z16 + (size_t)(ML + r) * D, z, lane); }
                GRID_BAR();
            }
            EpiF32 E{YF, D, (float*)(ws + WS_YF + YF_PART), ML, MC};
            gemm_run(lds, Z16, D, D, nrows, D, (const f16*)(W + WO_OUT), 0, nullptr, E, vb, nvb, tid, last ? 0 : MC, 4);
            SEAM(7);
        } }
        if (RUN(8)) { for (int rep_ = 0; rep_ < NREP(8); ++rep_) {
            FRESH_TID();
            LAS float* RT = (LAS float*)lds;
            LAS int* lcnt = (LAS int*)(lds + 32768);
            LAS int* lrec = lcnt + 128;
            if (moe) { load_router_table(lds, mi, RT, tid); if (tid < 128) lcnt[tid] = 0; __syncthreads(); }
            const float* g1p = INP(I_LN1G) + layer * D; const float* b1p = INP(I_LN1B) + layer * D;
            int slot = wave;
            f32x4 xn[4], yn[4];
            const float* PARTp = (const float*)(ws + WS_YF + YF_PART);
#define LOAD_Y(r_, dst_) do { if ((r_) >= ML) load_row_sum(PARTp + (size_t)((r_) - ML) * D, (size_t)MC * D, 4, dst_, lane); else load_row_h(YF + (size_t)(r_) * D, dst_, lane); } while (0)
            f32x4 lg_[4], lb_[4], mgn[4], mshn[4], mscn[4];
#pragma unroll
            for (int j = 0; j < 4; ++j) { lg_[j] = *(const f32x4*)(g1p + 256 * j + 4 * lane); lb_[j] = *(const f32x4*)(b1p + 256 * j + 4 * lane); }
#define LOAD_MOD(r_) do { const float* m_ = mod_row(ws, lds, layer, (r_)); _Pragma("unroll") for (int j = 0; j < 4; ++j) { mgn[j] = *(const f32x4*)(m_ + 2048 + 256 * j + 4 * lane); mshn[j] = *(const f32x4*)(m_ + 3072 + 256 * j + 4 * lane); mscn[j] = *(const f32x4*)(m_ + 4096 + 256 * j + 4 * lane); } } while (0)
            if (gw < nrows) { load_x<layer>(ws, lds, gw, xn, lane); LOAD_Y(gw, yn); LOAD_MOD(gw); }
            for (int r = gw; r < nrows; r += ngw, slot += NWAVES) {
                f32x4 x[4], y[4], mg[4], msh[4], msc[4];
#pragma unroll
                for (int j = 0; j < 4; ++j) { x[j] = xn[j]; y[j] = yn[j]; mg[j] = mgn[j]; msh[j] = mshn[j]; msc[j] = mscn[j]; }
                if (r + ngw < nrows) { load_x<layer>(ws, lds, r + ngw, xn, lane); LOAD_Y(r + ngw, yn); LOAD_MOD(r + ngw); }
#pragma unroll
                for (int j = 0; j < 4; ++j) x[j] = x[j] * ALPHA + mg[j] * y[j];
                float mean, rstd; ln_stats(x, mean, rstd);
#pragma unroll
                for (int j = 0; j < 4; ++j) x[j] = (x[j] - mean) * rstd * lg_[j] + lb_[j];
                store_row_h(XS + (size_t)r * D, x, lane);
                ln_stats(x, mean, rstd);
                f32x4 u[4];
#pragma unroll
                for (int j = 0; j < 4; ++j) { const int k = 256 * j + 4 * lane; u[j] = (x[j] - mean) * rstd * (msc[j] + 1.f) + msh[j];
                    f16x4 h; h[0] = (f16)u[j][0]; h[1] = (f16)u[j][1]; h[2] = (f16)u[j][2]; h[3] = (f16)u[j][3];
                    *(f16x4*)(U16 + (size_t)r * D + k) = h; }
                if (moe) {
                    float lg[8];
                    { const float s0 = dot4_rows(u, RT, 0, lane), s1 = dot4_rows(u, RT, 4, lane);
#pragma unroll
                      for (int e = 0; e < 4; ++e) { lg[e] = __shfl(s0, 16 * e) + INP(I_RB)[mi * 8 + e]; lg[4 + e] = __shfl(s1, 16 * e) + INP(I_RB)[mi * 8 + 4 + e]; } }
                    int e1 = 0; float l1 = lg[0];
#pragma unroll
                    for (int e = 1; e < 8; ++e) if (lg[e] > l1) { l1 = lg[e]; e1 = e; }
                    int e2 = -1; float l2 = -3.0e38f;
#pragma unroll
                    for (int e = 0; e < 8; ++e) if (e != e1 && lg[e] > l2) { l2 = lg[e]; e2 = e; }
                    const float p2 = __expf(l2 - l1), inv = 1.f / (1.f + p2);
                    if (lane == 0) { const int lp1 = lcnt[wave * 8 + e1], lp2 = lcnt[wave * 8 + e2]; lcnt[wave * 8 + e1] = lp1 + 1; lcnt[wave * 8 + e2] = lp2 + 1;
                        lrec[slot * 4 + 0] = e1; lrec[slot * 4 + 1] = e2; lrec[slot * 4 + 2] = lp1; lrec[slot * 4 + 3] = lp2;
                        TOKE[r] = make_int2(e1, e2); TOKP[r] = make_float2(inv, p2 * inv); }
                }
            }
            if (moe) {
                __syncthreads();
                if (tid < 64) { const int w_ = tid >> 3, e_ = tid & 7; int b_ = 0; for (int q = 0; q < w_; ++q) b_ += lcnt[q * 8 + e_]; lcnt[64 + tid] = b_;
                    if (w_ == 7) ((int*)(ws + WS_TOK + TK_BCNT))[vb * 8 + e_] = b_ + lcnt[56 + e_]; }
                __syncthreads();
                slot = wave;
                for (int r = gw; r < nrows; r += ngw, slot += NWAVES)
                    if (lane == 0) TOKPOS[r] = make_int2(lcnt[64 + wave * 8 + lrec[slot * 4 + 0]] + lrec[slot * 4 + 2], lcnt[64 + wave * 8 + lrec[slot * 4 + 1]] + lrec[slot * 4 + 3]);
            }
            SEAM(8);
        } }
        if (moe && RUN(9)) { for (int rep_ = 0; rep_ < NREP(9); ++rep_) {
            FRESH_TID();
            LAS int* ps = (LAS int*)lds;
            LAS int* bc = ps + 16;
            { const int* BC = (const int*)(ws + WS_TOK + TK_BCNT); for (int i = tid; i < nvb * 8; i += NTHREADS) bc[i] = BC[i]; }
            __syncthreads();
            if (tid < 8) { int tot = 0, mine = 0; for (int q = 0; q < nvb; ++q) { const int c = bc[q * 8 + tid]; mine += (q < vb) ? c : 0; tot += c; } bc[nvb * 8 + tid] = tot; bc[nvb * 8 + 8 + tid] = mine; }
            __syncthreads();
            if (tid == 0) { int acc = 0;
#pragma unroll 1
                for (int e = 0; e < 8; ++e) { ps[e] = acc + bc[nvb * 8 + 8 + e]; const int c = bc[nvb * 8 + e]; acc += ((c + 255) >> 8) * 256; }
                ps[8] = acc; }
            __syncthreads();
            if (vb == 0) { const int nb = ps[8] >> 8; if (tid == 0) BLKE[160] = nb;
                if (tid < nb) { int e = 0;
#pragma unroll 1
                    for (int q = 1; q < 8; ++q) if (tid * 256 >= ps[q]) e = q;
                    BLKE[tid] = e; } }
            {
                int* SRC = (int*)(ws + WS_TOK + TK_SRC);
                if (vb == 0) {
#pragma unroll 1
                    for (int e = 0; e < 8; ++e) { const int c = bc[nvb * 8 + e], st = ps[e] + c, pad = ((c + 255) & ~255) - c; if (tid < pad) SRC[st + tid] = 0; }
                }
                for (int r = gw + lane * ngw; r < nrows; r += 64 * ngw) {
                    const int2 e = TOKE[r], p = TOKPOS[r];
                    const int d0 = ps[e.x] + p.x, d1 = ps[e.y] + p.y;
                    SRC[d0] = r; SRC[d1] = r; TOKDEST[r] = make_int2(d0, d1);
                }
            }
            SEAM(9);
        } }
        if (RUN(10)) { for (int rep_ = 0; rep_ < NREP(10); ++rep_) {
            FRESH_TID();
            if constexpr (moe) { EpiSwiGLUG E; E.H = HB16; E.SRC = (const int*)(ws + WS_TOK + TK_SRC);
                const int nr = __builtin_amdgcn_readfirstlane(BLKE[160]) * 256;
                gemm_run(lds, U16, D, D, nr, NFF2, (const f16*)(W + WO_13), (size_t)NFF2 * D, BLKE, E, vb, nvb, tid);
            } else { EpiSwiGLU E{HB16, nullptr};
                gemm_run(lds, U16, D, D, nrows, NFF2, (const f16*)(W + WO_13D), (size_t)NFF2 * D, nullptr, E, vb, nvb, tid); }
            SEAM(10);
        } }
        if (RUN(11)) { for (int rep_ = 0; rep_ < NREP(11); ++rep_) {
            FRESH_TID();
            if (moe) {
                const int nblk = __builtin_amdgcn_readfirstlane(BLKE[160]); int tb, S; moe_tail(nblk, tb, S);
                EpiF32 E{YF, D, (float*)(ws + WS_HFB), (nblk - tb) * 256, tb * 256};
                gemm_run(lds, HB16, DFF, DFF, nblk * 256, D, (const f16*)(W + WO_2), (size_t)D * DFF, BLKE, E, vb, nvb, tid, tb * 256, S);
            } else {
                EpiF32 E{YF, D, (float*)(ws + WS_YF + YF_PART), ML, MC};
                gemm_run(lds, HB16, DFF, DFF, nrows, D, (const f16*)(W + WO_2D), (size_t)D * DFF, nullptr, E, vb, nvb, tid, last ? 0 : MC, 7);
            }
            SEAM(11);
        } }
        if (RUN(12)) { for (int rep_ = 0; rep_ < NREP(12); ++rep_) {
            FRESH_TID();
            LAS float* GT = (LAS float*)(lds + 73728);
            if (!last) load_gate_table(lds, layer + 1, GT, tid);
            const float* g2p = INP(I_LN2G) + layer * D; const float* b2p = INP(I_LN2B) + layer * D;
            const float* PARTp = (const float*)(ws + WS_YF + YF_PART);
#define LOAD_F(r_, dst_) do { if ((r_) >= ML) load_row_sum(PARTp + (size_t)((r_) - ML) * D, (size_t)MC * D, 7, dst_, lane); else load_row_h(YF + (size_t)(r_) * D, dst_, lane); } while (0)
            int m_split = 1 << 30, m_S = 1, m_trows = 0;
            if (moe) { const int nblk = __builtin_amdgcn_readfirstlane(BLKE[160]); int tb; moe_tail(nblk, tb, m_S); if (tb) { m_split = (nblk - tb) * 256; m_trows = tb * 256; } }
            const float* MPART = (const float*)(ws + WS_HFB);
#define LOAD_YB(d_, dst_) do { if ((d_) >= m_split) load_row_sum(MPART + (size_t)((d_) - m_split) * D, (size_t)m_trows * D, m_S, dst_, lane); else load_row_h(YF + (size_t)(d_) * D, dst_, lane); } while (0)
            f32x4 xn[4], fn0[4], fn1[4]; float2 pn = make_float2(0.f, 0.f); int2 dnn = make_int2(0, 0);
            f32x4 mgn[4];
#define LOAD_MOD2(r_) do { const float* m_ = mod_row(ws, lds, layer, (r_)); _Pragma("unroll") for (int j = 0; j < 4; ++j) mgn[j] = *(const f32x4*)(m_ + 5120 + 256 * j + 4 * lane); } while (0)
            if (gw < nrows) LOAD_MOD2(gw);
            if (gw < nrows) { load_row_h(XS + (size_t)gw * D, xn, lane);
                if (moe) { const int2 d = TOKDEST[gw]; pn = TOKP[gw]; LOAD_YB(d.x, fn0); LOAD_YB(d.y, fn1); if (gw + ngw < nrows) dnn = TOKDEST[gw + ngw]; }
                else LOAD_F(gw, fn0); }
            for (int r = gw; r < nrows; r += ngw) {
                f32x4 x[4], f[4], mg[4], msh[4], msc[4], lg_[4], lb_[4];
#pragma unroll
                for (int j = 0; j < 4; ++j) { x[j] = xn[j]; f[j] = moe ? fn0[j] * pn.x + fn1[j] * pn.y : fn0[j]; mg[j] = mgn[j]; }
                { const float* q_ = mod_row(ws, lds, last ? layer : layer + 1, r);
#pragma unroll
                  for (int j = 0; j < 4; ++j) { lg_[j] = *(const f32x4*)(g2p + 256 * j + 4 * lane); lb_[j] = *(const f32x4*)(b2p + 256 * j + 4 * lane); msh[j] = *(const f32x4*)(q_ + 256 * j + 4 * lane); msc[j] = *(const f32x4*)(q_ + 1024 + 256 * j + 4 * lane); } }
                if (r + ngw < nrows) { const int rn = r + ngw; LOAD_MOD2(rn); load_row_h(XS + (size_t)rn * D, xn, lane);
                    if (moe) { const int2 d = dnn; pn = TOKP[rn]; LOAD_YB(d.x, fn0); LOAD_YB(d.y, fn1); if (rn + ngw < nrows) dnn = TOKDEST[rn + ngw]; }
                    else LOAD_F(rn, fn0); }
#pragma unroll
                for (int j = 0; j < 4; ++j) x[j] = x[j] * ALPHA + mg[j] * f[j];
                float mean, rstd; ln_stats(x, mean, rstd);
#pragma unroll
                for (int j = 0; j < 4; ++j) { const int k = 256 * j + 4 * lane; x[j] = (x[j] - mean) * rstd * lg_[j] + lb_[j];
                    if (last) *(f32x4*)(args.out + (size_t)r * D + k) = x[j]; }
                if (!last) store_row_h(XS + (size_t)r * D, x, lane);
                if (!last) row_A_pre(ws, r, x, msh, msc, GT, lane);
            }
            if (!last) { __syncthreads(); conv_layer(ws, layer + 1, lds, gw, ngw, wave, lane, ffn_dma_items(layer + 1, nvb)); }
            SEAM(12);
        } }
#undef STEP
#undef RUN
#undef SEAM
}
__global__ void __launch_bounds__(NTHREADS, 2) mega(Args args) {
    extern __shared__ __attribute__((aligned(16))) unsigned char lds_raw[];
    LAS unsigned char* lds = (LAS unsigned char*)lds_raw;
    const int tid0 = threadIdx.x, wave0 = __builtin_amdgcn_readfirstlane(tid0 >> 6);
    const int vb0 = blockIdx.x, nvb0 = gridDim.x;
    unsigned char* ws0 = args.ws;
    unsigned* ctl = (unsigned*)(ws0 + WS_CTL);
    volatile LAS unsigned* MISC = (volatile LAS unsigned*)(lds + TAIL_OFF);
    if (tid0 < 64) MISC[tid0] = 0u;
    if (tid0 < 29) *(LAS unsigned long long*)(lds + PTAB_OFF + 8 * tid0) = (unsigned long long)args.in[tid0];
    __syncthreads();
#if MK_FUSED
    XcdBarrier bar = xcd_barrier_post(ctl + CW_BAR, MISC + 8);
#else
    XcdBarrier bar; bar.bar = ctl + CW_BAR; bar.x = 0; bar.st = MISC + 8;
#endif
    const int s_lo = args.s_lo, s_hi = args.s_hi; (void)s_lo; (void)s_hi;

    layer_body<0>(args, lds, tid0, wave0, vb0, nvb0, ws0, ctl, bar, s_lo, s_hi);
    layer_body<1>(args, lds, tid0, wave0, vb0, nvb0, ws0, ctl, bar, s_lo, s_hi);
    layer_body<2>(args, lds, tid0, wave0, vb0, nvb0, ws0, ctl, bar, s_lo, s_hi);
    layer_body<3>(args, lds, tid0, wave0, vb0, nvb0, ws0, ctl, bar, s_lo, s_hi);
}

static bool step_applicable(int layer, int p) {
    if (p == 0 || p == 1) return layer == 0;
    if (p == 9) return (layer & 1) != 0;
    return true;
}
extern "C" void kernel_launch(void* const* d_in, const int* in_sizes, int n_in, void* d_out, int out_size, void* d_ws, size_t ws_size, hipStream_t stream) {
    static int grid = 0;
    if (grid == 0) {
        if (n_in != 29 || out_size != ML * D || ws_size < WS_END) { fprintf(stderr, "kernel_launch: unexpected sizes (n_in %d out %d ws %zu need %zu)\n", n_in, out_size, ws_size, (size_t)WS_END); grid = -1; return; }
        int dev = 0, cus = 0, per_cu = 0;
        hipGetDevice(&dev); hipDeviceGetAttribute(&cus, hipDeviceAttributeMultiprocessorCount, dev);
        if (hipFuncSetAttribute((const void*)mega, hipFuncAttributeMaxDynamicSharedMemorySize, LDS_BYTES) != hipSuccess) { fprintf(stderr, "kernel_launch: hipFuncSetAttribute failed\n"); grid = -1; return; }
        if (hipOccupancyMaxActiveBlocksPerMultiprocessor(&per_cu, (const void*)mega, NTHREADS, LDS_BYTES) != hipSuccess || per_cu < 1) { fprintf(stderr, "kernel_launch: occupancy query says %d\n", per_cu); }
        (void)hipGetLastError();
        grid = cus > 0 ? cus : 256;
    }
    if (grid < 0) return;
    hipMemsetAsync((char*)d_ws + WS_CTL, 0, CTL_ZERO_BYTES, stream);
    Args a{};
    for (int i = 0; i < 29; ++i) a.in[i] = (const float*)d_in[i];
    a.out = (float*)d_out; a.ws = (unsigned char*)d_ws;
#if MK_FUSED
    a.s_lo = 0; a.s_hi = DEPTH * NPH;
    hipLaunchKernelGGL(mega, dim3(grid), dim3(NTHREADS), LDS_BYTES, stream, a);
#else
    for (int layer = 0; layer < DEPTH; ++layer)
        for (int p = 0; p < NPH; ++p) {
            if (!step_applicable(layer, p)) continue;
            a.s_lo = layer * NPH + p; a.s_hi = a.s_lo + 1;
            hipLaunchKernelGGL(mega, dim3(grid), dim3(NTHREADS), LDS_BYTES, stream, a);
        }
#endif
}
```

```cpp
#include <hip/hip_runtime.h>
#include <cstdio>
#include <cstdint>

#ifndef MK_FUSED
#define MK_FUSED 1
#endif
#ifndef USE_MLSTM_MFMA
#define USE_MLSTM_MFMA 1
#endif
#ifndef USE_NA_MFMA
#define USE_NA_MFMA 1
#endif
#ifndef PROBE_PH
#define PROBE_PH -1
#endif
#ifndef PROBE_LAYER
#define PROBE_LAYER -1
#endif
#ifndef PROBE_REP
#define PROBE_REP 0
#endif
#ifndef PH_MASK
#define PH_MASK 0xFFFF
#endif
#ifndef USE_MFMA
#define USE_MFMA 1
#endif

#define LAS __attribute__((address_space(3)))
typedef _Float16 f16;
typedef _Float16 f16x8 __attribute__((ext_vector_type(8)));
typedef _Float16 f16x4 __attribute__((ext_vector_type(4)));
typedef _Float16 f16x2 __attribute__((ext_vector_type(2)));
typedef float f32x4 __attribute__((ext_vector_type(4)));
typedef float f32x2 __attribute__((ext_vector_type(2)));
typedef unsigned u32x4 __attribute__((ext_vector_type(4)));
typedef unsigned u32x2 __attribute__((ext_vector_type(2)));

constexpr int D = 1024, NB = 8, SEQ = 2048, CTXL = 256, ML = NB * SEQ, MC = NB * CTXL, MT = ML + MC, DEPTH = 4;
constexpr int NIN = 6160, NP1 = 6144, DFF = 3584, NE = 8, NFF2 = 2 * DFF;
constexpr int MOE_MAXROWS = 38912;
constexpr float ALPHA = 1.6817928305074292f;
constexpr float LN_EPS = 1e-6f;
constexpr int NWAVES = 8, NTHREADS = 512;
constexpr int LDS_BYTES = 155648;

constexpr size_t MiB = 1u << 20;
constexpr size_t WS_CTL = 0, CTL_ZERO_BYTES = 1 * MiB;
constexpr size_t WS_MOD = 2 * MiB;
constexpr size_t WS_ROPE = 2 * MiB + 896 * 1024;
constexpr size_t WS_MLG = 3 * MiB;
constexpr size_t WS_TOK = 5 * MiB;
constexpr size_t WS_XS = 8 * MiB;
constexpr size_t WS_U16 = 80 * MiB;
constexpr size_t WS_P1 = 116 * MiB;
constexpr size_t WS_QK = 382 * MiB;
constexpr size_t WS_HFB = 418 * MiB;
constexpr size_t WS_CAT = 494 * MiB;
constexpr size_t WS_YF = 530 * MiB;
constexpr size_t YF_PART = 80 * MiB;
constexpr size_t WS_Z16 = 682 * MiB;
constexpr size_t WS_W = 718 * MiB;
constexpr size_t WO_IN = 0, WO_BP = 12 * MiB, WO_BN = WO_BP + MiB / 2, WO_BM = WO_BN + MiB / 2, WO_OUT = WO_BM + MiB, WO_13 = WO_OUT + 2 * MiB, WO_2 = WO_13 + 112 * MiB;
constexpr size_t WO_13D = 184 * MiB, WO_2D = WO_13D + 14 * MiB;
constexpr size_t WS_END = WS_W + 206 * MiB;
static_assert(WO_2 + 56 * MiB == 184 * MiB && WO_2D + 7 * MiB <= 206 * MiB, "weight map");
constexpr int CW_TMO = 0;
constexpr int CW_BAR = 4096;
constexpr int CW_MOECNT = 16384;
constexpr size_t TK_E = 0, TK_P = 160 * 1024, TK_POS = 320 * 1024, TK_DEST = 480 * 1024, TK_BLKE = 640 * 1024, TK_BCNT = 704 * 1024;

__device__ __forceinline__ float row16_sum(float v) {
    v += __builtin_bit_cast(float, __builtin_amdgcn_update_dpp(0, __builtin_bit_cast(int, v), 0xB1, 0xF, 0xF, true));
    v += __builtin_bit_cast(float, __builtin_amdgcn_update_dpp(0, __builtin_bit_cast(int, v), 0x4E, 0xF, 0xF, true));
    v += __builtin_bit_cast(float, __builtin_amdgcn_update_dpp(0, __builtin_bit_cast(int, v), 0x141, 0xF, 0xF, true));
    v += __builtin_bit_cast(float, __builtin_amdgcn_update_dpp(0, __builtin_bit_cast(int, v), 0x140, 0xF, 0xF, true));
    return v;
}
__device__ __forceinline__ float wave_sum(float v) {
    v = row16_sum(v);
    v += __shfl_xor(v, 16); v += __shfl_xor(v, 32);
    return v;
}
__device__ __forceinline__ float wave_max(float v) {
#pragma unroll
    for (int o = 1; o < 64; o <<= 1) v = fmaxf(v, __shfl_xor(v, o));
    return v;
}
__device__ __forceinline__ float sigmoid_(float x) { return __builtin_amdgcn_rcpf(1.f + __expf(-x)); }
__device__ __forceinline__ float silu_(float x) { return x * __builtin_amdgcn_rcpf(1.f + __expf(-x)); }
#define LDS_WAIT() asm volatile("s_waitcnt lgkmcnt(0)" ::: "memory")
#define VM_WAIT() asm volatile("s_waitcnt vmcnt(0)" ::: "memory")


__device__ __forceinline__ int opaque_u32(int x) { int t = x; asm volatile("" : "+v"(t)); return __builtin_amdgcn_readfirstlane(t); }
__device__ __forceinline__ unsigned long long opaque_u64(unsigned long long x) { unsigned lo = (unsigned)x, hi = (unsigned)(x >> 32); asm volatile("" : "+v"(lo), "+v"(hi));
    return ((unsigned long long)(unsigned)__builtin_amdgcn_readfirstlane(hi) << 32) | (unsigned)__builtin_amdgcn_readfirstlane(lo); }

#define XB_TMO      128
#define XB_XCNT(j)  (256  + 64 * (j))
#define XB_XSUB(j)  (1280 + 64 * (j))
#define XB_XGEN(j)  (2304 + 64 * (j))
#define XB_TOP      3328
#define XB_TOPGEN   3392
#define XCD_BAR_WORDS 3456
#define XB_SPIN_CAP (1u << 22)
__device__ __forceinline__ unsigned xb_ld(unsigned* p)              { return __hip_atomic_load(p, __ATOMIC_RELAXED, __HIP_MEMORY_SCOPE_AGENT); }
__device__ __forceinline__ unsigned xb_add(unsigned* p, unsigned v) { return __hip_atomic_fetch_add(p, v, __ATOMIC_RELAXED, __HIP_MEMORY_SCOPE_AGENT); }
__device__ __forceinline__ unsigned xb_xcc_id() { return (unsigned)__builtin_amdgcn_s_getreg((3 << 11) | 20) & 0xFu; }
#define XB_SPIN(cond, bar) do { unsigned _sp = 0; while (cond) { __builtin_amdgcn_s_sleep(1); \
    if ((++_sp & 255u) == 0u) { if (xb_ld(&(bar)[XB_TMO])) break; if (_sp > XB_SPIN_CAP) { atomicAdd(&(bar)[XB_TMO], 1u); break; } } } } while (0)
struct XcdBarrier { unsigned* bar; unsigned x; volatile LAS unsigned* st; };
__device__ __forceinline__ XcdBarrier xcd_barrier_post(unsigned* bar, volatile LAS unsigned* st) {
    XcdBarrier b; b.bar = bar; b.x = xb_xcc_id(); b.st = st;
    if (threadIdx.x == 0) (void)xb_add(&bar[XB_XCNT(b.x)], 1u);
    return b;
}
__device__ __forceinline__ void xcd_barrier_complete(unsigned* bar, unsigned x, unsigned& nloc, unsigned& nx) {
    const unsigned G = gridDim.x * gridDim.y * gridDim.z;
    unsigned sum, cnt, mine, sp = 0u;
    for (;;) {
        sum = 0u; cnt = 0u; mine = 0u;
#pragma unroll
        for (unsigned j = 0; j < 16; ++j) { const unsigned c = xb_ld(&bar[XB_XCNT(j)]); sum += c; cnt += (c > 0u) ? 1u : 0u; }
        mine = xb_ld(&bar[XB_XCNT(x)]);
        if (sum == G) break;
        __builtin_amdgcn_s_sleep(1);
        if ((++sp & 255u) == 0u) { if (xb_ld(&bar[XB_TMO])) break; if (sp > XB_SPIN_CAP) { atomicAdd(&bar[XB_TMO], 1u); break; } }
    }
    nloc = mine > 0u ? mine : 1u; nx = cnt > 0u ? cnt : 1u;
}
__device__ __forceinline__ void xcd_barrier(const XcdBarrier& b) {
    asm volatile("s_waitcnt vmcnt(0)" ::: "memory");
    __syncthreads();
    if (threadIdx.x == 0) {
        const unsigned long long bi_ = opaque_u64((unsigned long long)b.bar); unsigned* bar = (unsigned*)(__attribute__((address_space(1))) unsigned*)bi_;
        __builtin_amdgcn_s_waitcnt(0);
        unsigned nloc = b.st[0], nx = b.st[1];
        if (nloc == 0u) { xcd_barrier_complete(bar, b.x, nloc, nx); b.st[0] = nloc; b.st[1] = nx; }
        const unsigned old = xb_add(&bar[XB_XSUB(b.x)], 1u);
        const unsigned gen = old / nloc;
        if (old + 1u == (gen + 1u) * nloc) {
            __builtin_amdgcn_fence(__ATOMIC_RELEASE, "agent");
            asm volatile("s_waitcnt vmcnt(0)" ::: "memory");
            const unsigned og = xb_add(&bar[XB_TOP], 1u);
            const unsigned tg = og / nx;
            if (og + 1u == (tg + 1u) * nx) xb_add(&bar[XB_TOPGEN], 1u);
            else XB_SPIN(xb_ld(&bar[XB_TOPGEN]) == tg, bar);
            __builtin_amdgcn_fence(__ATOMIC_ACQUIRE, "agent");
            xb_add(&bar[XB_XGEN(b.x)], 1u);
            asm volatile("s_waitcnt vmcnt(0)" ::: "memory");
        } else {
            XB_SPIN(xb_ld(&bar[XB_XGEN(b.x)]) == gen, bar);
            __builtin_amdgcn_fence(__ATOMIC_ACQUIRE, "agent");
            asm volatile("s_waitcnt vmcnt(0)" ::: "memory");
        }
    }
    __syncthreads();
}

struct Args { const float* in[29]; float* out; unsigned char* ws; int s_lo, s_hi; };
enum { I_X = 0, I_C, I_CTX, I_CCTX, I_WMOD, I_BMOD, I_WIN, I_GBIAS, I_CONVW, I_NORMW, I_POOLW, I_POOLS, I_RPB, I_WBP, I_WBN, I_WBM, I_WOUT,
       I_LN1G, I_LN1B, I_LN2G, I_LN2B, I_FW1, I_FW3, I_FW2, I_RW, I_RB, I_MW1, I_MW3, I_MW2 };


constexpr int TAIL_OFF = LDS_BYTES - 1024, PTAB_OFF = TAIL_OFF + 256;
__device__ __forceinline__ const float* inp_ptr(LAS unsigned char* lds, int i) {
    const LAS unsigned* t = (const LAS unsigned*)(lds + PTAB_OFF);
    const unsigned lo = __builtin_amdgcn_readfirstlane(t[2 * i]), hi = __builtin_amdgcn_readfirstlane(t[2 * i + 1]);
    return (const float*)(const __attribute__((address_space(1))) float*)(((unsigned long long)hi << 32) | lo);
}
#define INP(i) inp_ptr(lds, (i))

__device__ __forceinline__ u32x4 pack8(const float (&v)[8]) {
    f16x8 h;
#pragma unroll
    for (int i = 0; i < 8; ++i) h[i] = (f16)v[i];
    return __builtin_bit_cast(u32x4, h);
}
struct EpiP1 {
    static constexpr bool MIDK = false;
    f16* P1;
    __device__ __forceinline__ void emit_part(int, int, int, const float (&)[8]) const {}
    __device__ __forceinline__ void emit8(int row, int col, const float (&v)[8]) const {
        const float s = (col >= 256 && col < 512) ? 0.125f : 1.f;
        float w[8];
        if (col >= 2560) {
#pragma unroll
            for (int i = 0; i < 8; ++i) w[i] = sigmoid_(v[i]);
        } else {
#pragma unroll
            for (int i = 0; i < 8; ++i) w[i] = v[i] * s;
        }
        *(u32x4*)(P1 + (size_t)row * NP1 + col) = pack8(w);
    }
};
struct EpiMerge {
    static constexpr bool MIDK = true;
    const f16* P1; f16* Z16; float* PART;
    __device__ __forceinline__ void emit_part(int part, int row, int col, const float (&v)[8]) const {
        const int gi = part < 2 ? part : 2;
        const f16x8 g = *(const f16x8*)(P1 + (size_t)row * NP1 + 3072 + gi * 1024 + col);
        float* p = PART + ((size_t)part * MC + (row - ML)) * D + col;
        f32x4 w0, w1;
#pragma unroll
        for (int i = 0; i < 4; ++i) { w0[i] = v[i] * (gi == 0 ? (float)g[i] : fmaxf((float)g[i], 1e-4f)); w1[i] = v[4 + i] * (gi == 0 ? (float)g[4 + i] : fmaxf((float)g[4 + i], 1e-4f)); }
        *(f32x4*)p = w0; *(f32x4*)(p + 4) = w1;
    }
    __device__ __forceinline__ void mid8(int row, int col, float (&v)[8], int which) const {
        const f16* gp = P1 + (size_t)row * NP1 + 3072 + col;
        const f16x8 gnum = *(const f16x8*)(gp + (which == 0 ? 0 : 1024)), gden = *(const f16x8*)(gp + (which == 0 ? 1024 : 2048));
#pragma unroll
        for (int i = 0; i < 8; ++i) { const float num = which == 0 ? (float)gnum[i] : fmaxf((float)gnum[i], 1e-4f); v[i] *= num * __builtin_amdgcn_rcpf(fmaxf((float)gden[i], 1e-4f)); }
    }
    __device__ __forceinline__ void emit8(int row, int col, const float (&v)[8]) const {
        const f16x8 g = *(const f16x8*)(P1 + (size_t)row * NP1 + 3072 + 2048 + col);
        float w[8];
#pragma unroll
        for (int i = 0; i < 8; ++i) w[i] = v[i] * fmaxf((float)g[i], 1e-4f);
        *(u32x4*)(Z16 + (size_t)row * D + col) = pack8(w);
    }
};
struct EpiF32 {
    static constexpr bool MIDK = false;
    f16* C; int ldc; float* PART; int prow0, prows;
    __device__ __forceinline__ void emit_part(int part, int row, int col, const float (&v)[8]) const {
        float* p = PART + ((size_t)part * prows + (row - prow0)) * ldc + col;
        *(f32x4*)p = (f32x4){v[0], v[1], v[2], v[3]}; *(f32x4*)(p + 4) = (f32x4){v[4], v[5], v[6], v[7]}; }
    __device__ __forceinline__ void emit8(int row, int col, const float (&v)[8]) const {
        *(u32x4*)(C + (size_t)row * ldc + col) = pack8(v);
    }
};
struct EpiSwiGLU {
    static constexpr bool MIDK = false;
    f16* H;
    __device__ __forceinline__ void emit_part(int, int, int, const float (&)[8]) const {}
    __device__ __forceinline__ void emit8(int row, int col, const float (&v)[8]) const {
        f16x4 h;
#pragma unroll
        for (int i = 0; i < 4; ++i) h[i] = (f16)(silu_(v[i]) * v[i + 4]);
        *(f16x4*)(H + (size_t)row * DFF + (col >> 1)) = h;
    }
};

template <class Epi, class BSel>
__device__ __forceinline__ void gemm_naive(LAS unsigned char* lds, const f16* A, int lda, int K, int nMt, int nNt, const Epi& E, const BSel& bsel, int vb, int nvb, int tid) {
    LAS float* As = (LAS float*)lds;
    LAS float* Bs = As + 32 * 132;
    const int ty = tid >> 4, tx = tid & 15, lr = tid >> 2, kc = (tid & 3) * 8;
    for (int tile = vb; tile < nMt * nNt; tile += nvb) {
        const int tm = tile / nNt, tn = tile % nNt;
        const f16* Bt = bsel(tm * 128);
        float acc[4][8];
#pragma unroll
        for (int i = 0; i < 4; ++i)
#pragma unroll
            for (int j = 0; j < 8; ++j) acc[i][j] = 0.f;
        for (int k0 = 0; k0 < K; k0 += 32) {
            const f16x8 av = *(const f16x8*)(A + (size_t)(tm * 128 + lr) * lda + k0 + kc);
            const f16x8 bv = *(const f16x8*)(Bt + (size_t)(tn * 128 + lr) * K + k0 + kc);
            __syncthreads();
#pragma unroll
            for (int i = 0; i < 8; ++i) { As[(kc + i) * 132 + lr] = (float)av[i]; Bs[(kc + i) * 132 + lr] = (float)bv[i]; }
            __syncthreads();
#pragma unroll 8
            for (int kk = 0; kk < 32; ++kk) {
                const f32x4 a = *(const LAS f32x4*)(As + kk * 132 + ty * 4);
                const f32x4 b0 = *(const LAS f32x4*)(Bs + kk * 132 + tx * 8), b1 = *(const LAS f32x4*)(Bs + kk * 132 + tx * 8 + 4);
#pragma unroll
                for (int i = 0; i < 4; ++i) {
#pragma unroll
                    for (int j = 0; j < 4; ++j) { acc[i][j] += a[i] * b0[j]; acc[i][4 + j] += a[i] * b1[j]; }
                }
            }
        }
#pragma unroll
        for (int i = 0; i < 4; ++i) E.emit8(tm * 128 + ty * 4 + i, tn * 128 + tx * 8, acc[i]);
    }
    __syncthreads();
}
struct BSelOne { const f16* Bt; __device__ __forceinline__ const f16* operator()(int) const { return Bt; } };
struct BSelMoe { const f16* Bt; size_t estride; const int* blke; __device__ __forceinline__ const f16* operator()(int row) const { return Bt + (size_t)blke[row >> 8] * estride; } };


namespace pg8 {
constexpr int BM = 256, BK = 64, HALF = 128, HTB = HALF * BK * 2, STAGE_BYTES = 8 * HTB, NXCD = 8, WGM = 8;
__device__ __forceinline__ int lds_byte(int r, int c) { const int st = (r >> 4) * 2 + (c >> 5), rr = r & 15, cc = c & 31, ob = rr * 64 + cc * 2; return st * 1024 + (ob ^ (((ob >> 9) & 1) << 5)); }
__device__ __forceinline__ void stage_rc(int b, int& R, int& C) { const int st = b / 1024, sb = b % 1024, swz = sb ^ (((sb >> 9) & 1) << 5); R = (st >> 1) * 16 + swz / 64; C = (st & 1) * 32 + (swz % 64) / 2; }
__device__ __forceinline__ int perm32(int rho) { const int n = rho >> 4, i = rho & 15; return 8 * (i >> 2) + 4 * n + (i & 3); }
struct Unit { int pm, pn, eb, kb, nt, part; };
struct Gemm { const f16* A; const f16* Bt; int lda, K; size_t bstride; };
struct Order {
    int nM, nN, nwg, G, c, ntile; const int* blke; int tailM, tailS, tail_nt;
    __device__ void init(int nM_, int nN_, int G_, int c_, const int* blke_, int ntile_) { nM = nM_; nN = nN_; nwg = nM * nN; G = G_; c = c_; blke = blke_; ntile = ntile_; tailM = 0; tailS = 1; tail_nt = ntile_; }
    __device__ void set_tail(int tailM_, int tailS_) { tailM = tailM_; tailS = tailS_; tail_nt = ntile / tailS_; }
    __device__ bool next(int i, Unit& u) const {
        const long L = (long)i * G + c;
        if (L >= nwg) { const int q = (int)(L - nwg); if (q >= tailM * nN * tailS) return false;
            const int uu = q / tailS, ks = q - uu * tailS; u.pm = nM + uu / nN; u.pn = uu % nN; u.eb = blke ? __builtin_amdgcn_readfirstlane(blke[u.pm]) : 0; u.kb = ks * tail_nt; u.nt = tail_nt; u.part = ks; return true; }
        int wgid = (int)L; { const int q = nwg / NXCD, r = nwg % NXCD, xcd = wgid % NXCD, off = wgid / NXCD; wgid = (xcd < r ? xcd * (q + 1) : r * (q + 1) + (xcd - r) * q) + off; }
        const int nig = WGM * nN, gid = wgid / nig, fm = gid * WGM, gsz = (nM - fm) < WGM ? (nM - fm) : WGM;
        u.pm = fm + ((wgid % nig) % gsz); u.pn = (wgid % nig) / gsz; u.eb = blke ? __builtin_amdgcn_readfirstlane(blke[u.pm]) : 0; u.kb = 0; u.nt = ntile; u.part = -1; return true;
    }
};
template <class Epi>
__device__ __forceinline__ void gemm_phase(LAS unsigned char* lds, const Gemm g, const Order& S, const Epi& E, int tid) {
    const int wid = __builtin_amdgcn_readfirstlane(tid >> 6), lane = tid & 63, wr = wid >> 2, wc = wid & 3, fr = lane & 15, fq = lane >> 4;
    const int K = g.K;
    unsigned voffA[2], voffB[2];
#pragma unroll
    for (int i = 0; i < 2; ++i) { int R, C; stage_rc(tid * 16 + i * 8192, R, C); const int Rb = (R & ~31) + perm32(R & 31);
        voffA[i] = (unsigned)(R * g.lda + C) * 2u; voffB[i] = (unsigned)(Rb * K + C) * 2u; }
    const size_t kstep = (size_t)(BK * 2);
    const size_t hstepA = (size_t)HALF * g.lda * 2, tstepA = 2 * hstepA, hstepB = (size_t)HALF * K * 2, tstepB = 2 * hstepB;
    const unsigned ldsw = (unsigned)wid * 1024u;
    const int aoff = lds_byte(wr * 64 + fr, fq * 8), boff = lds_byte(wc * 32 + fr, fq * 8);
#define PG8_SA(b, h) (((b) * 2 + (h)) * HTB)
#define PG8_SB(b, h) ((4 + (b) * 2 + (h)) * HTB)
#define PG8_STAGE(bufoff, gbase, voff) do { _Pragma("unroll") for (int _i = 0; _i < 2; ++_i) \
        __builtin_amdgcn_global_load_lds((const unsigned*)((const char*)(gbase) + (voff)[_i]), (LAS unsigned*)(lds + (bufoff) + ldsw + _i * 8192), 16, 0, 0); } while (0)
#define PG8_LDA(dst, b, h) do { _Pragma("unroll") for (int m = 0; m < 4; ++m) _Pragma("unroll") for (int k = 0; k < 2; ++k) dst[m][k] = *(const LAS f16x8*)(lds + PG8_SA(b, h) + aoff + m * 2048 + k * 1024); } while (0)
#define PG8_LDB(dst, b, h) do { _Pragma("unroll") for (int n = 0; n < 2; ++n) _Pragma("unroll") for (int k = 0; k < 2; ++k) dst[n][k] = *(const LAS f16x8*)(lds + PG8_SB(b, h) + boff + n * 2048 + k * 1024); } while (0)
#define PG8_MMA(ai, bj, At, Bt) do { __builtin_amdgcn_s_setprio(1); _Pragma("unroll") for (int m = 0; m < 4; ++m) _Pragma("unroll") for (int n = 0; n < 2; ++n) _Pragma("unroll") for (int k = 0; k < 2; ++k) \
        acc[ai][bj][m][n] = __builtin_amdgcn_mfma_f32_16x16x32_f16(Bt[n][k], At[m][k], acc[ai][bj][m][n], 0, 0, 0); __builtin_amdgcn_s_setprio(0); } while (0)
#define PG8_WAIT_V(n) asm volatile("s_waitcnt vmcnt(" #n ")" ::: "memory")
#define PG8_WAIT_L(n) asm volatile("s_waitcnt lgkmcnt(" #n ")" ::: "memory")
#define PG8_BAR __builtin_amdgcn_s_barrier()
#define PG8_SCHED __builtin_amdgcn_sched_barrier(0)
    Unit cur, nxt; int ui = 0;
    if (!S.next(0, cur)) return;
    f32x4 acc[2][2][4][2];
#pragma unroll
    for (int a = 0; a < 2; ++a)
#pragma unroll
        for (int b = 0; b < 2; ++b)
#pragma unroll
            for (int m = 0; m < 4; ++m)
#pragma unroll
                for (int n = 0; n < 2; ++n) acc[a][b][m][n] = (f32x4){0.f, 0.f, 0.f, 0.f};
    f16x8 At[4][2], B0[2][2], B1[2][2];
    const char* cA = (const char*)g.A + (size_t)cur.pm * tstepA + (size_t)cur.kb * kstep; const char* cB = (const char*)g.Bt + (size_t)cur.eb * g.bstride * 2 + (size_t)cur.pn * tstepB + (size_t)cur.kb * kstep;
    PG8_STAGE(PG8_SB(0, 0), cB, voffB); PG8_STAGE(PG8_SB(0, 1), cB + hstepB, voffB); PG8_STAGE(PG8_SA(0, 0), cA, voffA); PG8_STAGE(PG8_SA(0, 1), cA + hstepA, voffA);
    if (wr == 1) PG8_BAR;
    PG8_WAIT_V(2); PG8_BAR;
    PG8_STAGE(PG8_SB(1, 0), cB + kstep, voffB); PG8_STAGE(PG8_SA(1, 0), cA + kstep, voffA); PG8_STAGE(PG8_SB(1, 1), cB + hstepB + kstep, voffB);
    PG8_WAIT_V(6); PG8_BAR;
    for (;;) {
        const bool has_next = S.next(ui + 1, nxt);
        const char* nA = has_next ? (const char*)g.A + (size_t)nxt.pm * tstepA + (size_t)nxt.kb * kstep : cA; const char* nB = has_next ? (const char*)g.Bt + (size_t)nxt.eb * g.bstride * 2 + (size_t)nxt.pn * tstepB + (size_t)nxt.kb * kstep : cB;
        const int nt = cur.nt;
        int t = 0;
#pragma unroll 1
        for (int seg = 0; seg < (Epi::MIDK ? 3 : 1); ++seg) {
        const int tend = Epi::MIDK ? (seg == 0 ? (nt < 4 ? nt : 4) : (seg == 1 ? (nt < 8 ? nt : 8) : nt)) : nt;
        for (; t < tend; t += 2) {
            const bool last = (t == nt - 2);
            const char* a1 = cA + (size_t)(t + 1) * kstep;
            const char* a2 = last ? nA : cA + (size_t)(t + 2) * kstep; const char* b2 = last ? nB : cB + (size_t)(t + 2) * kstep;
            const char* a3 = a2 + kstep; const char* b3 = b2 + kstep;
            PG8_LDB(B0, 0, 0); PG8_LDB(B1, 0, 1); PG8_SCHED; PG8_LDA(At, 0, 0); PG8_STAGE(PG8_SA(1, 1), a1 + hstepA, voffA);
            PG8_WAIT_V(8); PG8_WAIT_L(0); PG8_BAR; PG8_MMA(0, 0, At, B0); PG8_MMA(0, 1, At, B1); PG8_BAR; PG8_SCHED;
            PG8_LDA(At, 0, 1); PG8_STAGE(PG8_SB(0, 0), b2, voffB); PG8_STAGE(PG8_SB(0, 1), b2 + hstepB, voffB); PG8_STAGE(PG8_SA(0, 0), a2, voffA);
            PG8_WAIT_V(8); PG8_WAIT_L(0); PG8_BAR; PG8_MMA(1, 0, At, B0); PG8_MMA(1, 1, At, B1); PG8_BAR; PG8_SCHED;
            PG8_LDB(B0, 1, 0); PG8_LDB(B1, 1, 1); PG8_SCHED; PG8_LDA(At, 1, 0); PG8_STAGE(PG8_SA(0, 1), a2 + hstepA, voffA);
            PG8_WAIT_V(8); PG8_WAIT_L(0); PG8_BAR; PG8_MMA(0, 0, At, B0); PG8_MMA(0, 1, At, B1); PG8_BAR; PG8_SCHED;
            PG8_LDA(At, 1, 1); PG8_STAGE(PG8_SB(1, 0), b3, voffB); PG8_STAGE(PG8_SB(1, 1), b3 + hstepB, voffB); PG8_STAGE(PG8_SA(1, 0), a3, voffA);
            PG8_WAIT_V(8); PG8_WAIT_L(0); PG8_BAR; PG8_MMA(1, 0, At, B0); PG8_MMA(1, 1, At, B1); PG8_BAR; PG8_SCHED;
        }
        if constexpr (Epi::MIDK) { if (seg < 2 && cur.part < 0) {
#pragma unroll
                for (int ai = 0; ai < 2; ++ai)
#pragma unroll
                    for (int m = 0; m < 4; ++m) { int row = cur.pm * BM + ai * HALF + wr * 64 + m * 16 + fr; asm volatile("" : "+v"(row));
#pragma unroll
                        for (int bj = 0; bj < 2; ++bj) { const f32x4 v0 = acc[ai][bj][m][0], v1 = acc[ai][bj][m][1];
                            float v[8] = {v0[0], v0[1], v0[2], v0[3], v1[0], v1[1], v1[2], v1[3]};
                            E.mid8(row, cur.pn * BM + bj * HALF + wc * 32 + 8 * fq, v, seg);
                            acc[ai][bj][m][0] = (f32x4){v[0], v[1], v[2], v[3]}; acc[ai][bj][m][1] = (f32x4){v[4], v[5], v[6], v[7]}; }
                        asm volatile("" : "+v"(acc[ai][0][m][0]), "+v"(acc[ai][0][m][1]), "+v"(acc[ai][1][m][0]), "+v"(acc[ai][1][m][1]) :: "memory"); } } }
        }
        if (wr == 0) PG8_BAR;
        {
#pragma unroll
            for (int ai = 0; ai < 2; ++ai)
#pragma unroll
                for (int m = 0; m < 4; ++m) { int row = cur.pm * BM + ai * HALF + wr * 64 + m * 16 + fr; if constexpr (Epi::MIDK) asm volatile("" : "+v"(row));
#pragma unroll
                    for (int bj = 0; bj < 2; ++bj) { const f32x4 v0 = acc[ai][bj][m][0], v1 = acc[ai][bj][m][1];
                        const float v[8] = {v0[0], v0[1], v0[2], v0[3], v1[0], v1[1], v1[2], v1[3]};
                        if (cur.part >= 0) E.emit_part(cur.part, row, cur.pn * BM + bj * HALF + wc * 32 + 8 * fq, v); else E.emit8(row, cur.pn * BM + bj * HALF + wc * 32 + 8 * fq, v); } }
        }
        if (!has_next) break;
#pragma unroll
        for (int a = 0; a < 2; ++a)
#pragma unroll
            for (int b = 0; b < 2; ++b)
#pragma unroll
                for (int m = 0; m < 4; ++m)
#pragma unroll
                    for (int n = 0; n < 2; ++n) acc[a][b][m][n] = (f32x4){0.f, 0.f, 0.f, 0.f};
        cur = nxt; cA = nA; cB = nB; ++ui;
        if (wr == 1) PG8_BAR;
    }
    PG8_WAIT_V(0);
    PG8_BAR;
#undef PG8_SA
#undef PG8_SB
#undef PG8_STAGE
#undef PG8_LDA
#undef PG8_LDB
#undef PG8_MMA
#undef PG8_WAIT_V
#undef PG8_WAIT_L
#undef PG8_BAR
#undef PG8_SCHED
}
}
template <class Epi>
__device__ __forceinline__ void gemm_run(LAS unsigned char* lds, const f16* A, int lda, int K, int nrows, int N, const f16* Bt, size_t bstride, const int* blke, const Epi& E, int vb, int nvb, int tid, int tail_rows = 0, int tailS = 1) {
#if USE_MFMA
    pg8::Gemm g{A, Bt, lda, K, bstride}; pg8::Order S; S.init((nrows - tail_rows) / 256, N / 256, nvb, vb, blke, K / 64); if (tail_rows) S.set_tail(tail_rows / 256, tailS);
    pg8::gemm_phase(lds, g, S, E, tid);
#else
    static_assert(!Epi::MIDK, "the naive GEMM has no mid-K hook");
    if (blke) gemm_naive(lds, A, lda, K, nrows / 128, N / 128, E, BSelMoe{Bt, bstride, blke}, vb, nvb, tid);
    else gemm_naive(lds, A, lda, K, nrows / 128, N / 128, E, BSelOne{Bt}, vb, nvb, tid);
#endif
}

__device__ __forceinline__ void conv_item(const float* S0, const float* S1, int ld, int K, int N, f16* dst, int ldd, int mode, int skipfrom, int skip, LAS float* scr, int item, int lane) {
    const int nblk = N / 32, kb = item / nblk, nb = item % nblk, k0 = 64 * kb, n0 = 32 * nb;
    const int n = n0 + (lane & 31);
    const float* sp;
    if (mode == 0) sp = S0 + n + (n >= skipfrom ? skip : 0);
    else { const int j = n >> 3, i = n & 7; sp = (i < 4 ? S0 : S1) + 4 * j + (i & 3); }
#pragma unroll 8
    for (int i = 0; i < 32; ++i) { const int kk = 2 * i + (lane >> 5); scr[kk * 33 + (lane & 31)] = sp[(size_t)(k0 + kk) * ld]; }
    LDS_WAIT();
    const int c = lane & 7;
#pragma unroll
    for (int j = 0; j < 4; ++j) { const int nn = (lane >> 3) + 8 * j; const LAS float* s = scr + (8 * c) * 33 + nn;
        f16x8 h;
#pragma unroll
        for (int q = 0; q < 8; ++q) h[q] = (f16)s[q * 33];
        *(f16x8*)(dst + (size_t)(n0 + nn) * ldd + k0 + 8 * c) = h; }
    LDS_WAIT();
}
constexpr int FFN_ITEMS = 16 * (NFF2 / 32) + 56 * 32;
__device__ __forceinline__ void conv_layer(unsigned char* ws, int layer, LAS unsigned char* lds, int gw, int ngw, int wave, int lane, int ffn_lo) {
    LAS float* scr = (LAS float*)(lds + wave * 8448);
    unsigned char* W = ws + WS_W;
    const int I_IN = 16 * (NP1 / 32), I_BP = 4 * 32, I_BM = 8 * 32, I_OUT = 16 * 32, I_13 = 16 * (NFF2 / 32), I_2 = 56 * 32;
    const bool moe = (layer & 1); const int fi = layer >> 1;
    const int nexp = moe ? NE : 1;
    const int ncommon = I_IN + 2 * I_BP + I_BM + I_OUT;
    const int total = ncommon + nexp * (I_13 + I_2) - ffn_lo;
    for (int it = gw; it < total; it += ngw) {
        int r = it < ncommon ? it : it + ffn_lo;
        if (r < I_IN) { conv_item(INP(I_WIN) + (size_t)layer * D * NIN, nullptr, NIN, D, NP1, (f16*)(W + WO_IN), D, 0, 3072, 16, scr, r, lane); continue; } r -= I_IN;
        if (r < I_BP) { conv_item(INP(I_WBP) + (size_t)layer * 256 * D, nullptr, D, 256, D, (f16*)(W + WO_BP), D, 0, 1 << 30, 0, scr, r, lane); continue; } r -= I_BP;
        if (r < I_BP) { conv_item(INP(I_WBN) + (size_t)layer * 256 * D, nullptr, D, 256, D, (f16*)(W + WO_BP) + 256, D, 0, 1 << 30, 0, scr, r, lane); continue; } r -= I_BP;
        if (r < I_BM) { conv_item(INP(I_WBM) + (size_t)layer * 512 * D, nullptr, D, 512, D, (f16*)(W + WO_BP) + 512, D, 0, 1 << 30, 0, scr, r, lane); continue; } r -= I_BM;
        if (r < I_OUT) { conv_item(INP(I_WOUT) + (size_t)layer * D * D, nullptr, D, D, D, (f16*)(W + WO_OUT), D, 0, 1 << 30, 0, scr, r, lane); continue; } r -= I_OUT;
        const int e = r / (I_13 + I_2); r -= e * (I_13 + I_2);
        const size_t eo = (size_t)(fi * nexp + e) * D * DFF;
        const float* w1 = (moe ? INP(I_MW1) : INP(I_FW1)) + eo;
        const float* w3 = (moe ? INP(I_MW3) : INP(I_FW3)) + eo;
        const float* w2 = (moe ? INP(I_MW2) : INP(I_FW2)) + eo;
        if (r < I_13) conv_item(w1, w3, DFF, D, NFF2, (f16*)(W + (moe ? WO_13 : WO_13D)) + (size_t)e * NFF2 * D, D, 1, 0, 0, scr, r, lane);
        else conv_item(w2, nullptr, D, DFF, D, (f16*)(W + (moe ? WO_2 : WO_2D)) + (size_t)e * D * DFF, DFF, 0, 1 << 30, 0, scr, r - I_13, lane);
    }
}

__device__ __forceinline__ void conv_seg(int l, int nvb, int& LA, int& a0, int& an, int& LB, int& b0, int& bn) {
    LA = 0; a0 = 0; an = 0; LB = 0; b0 = 0; bn = 0;
    if (nvb != 256) return;
    constexpr int HALF = 9 * NWAVES * 256;
    if (l == 0) { LA = 1; a0 = 0; an = HALF; }
    else if (l == 1) { LA = 1; a0 = HALF; an = HALF; LB = 2; b0 = 0; bn = FFN_ITEMS; }
    else if (l == 2) { LA = 3; a0 = 0; an = HALF; }
    else { LA = 3; a0 = HALF; an = HALF; }
}
__device__ __forceinline__ int ffn_dma_items(int L, int nvb) {
    if (L <= 0 || L >= DEPTH || nvb != 256) return 0;
    const int tot = ((L & 1) ? NE : 1) * FFN_ITEMS, cap = 18 * NWAVES * 256;
    return tot < cap ? tot : cap;
}

__device__ __forceinline__ void ln_stats(const f32x4 (&v)[4], float& mean, float& rstd) {
    float s = 0.f;
#pragma unroll
    for (int j = 0; j < 4; ++j) s += (v[j][0] + v[j][1]) + (v[j][2] + v[j][3]);
    mean = wave_sum(s) * (1.f / D);
    float q = 0.f;
#pragma unroll
    for (int j = 0; j < 4; ++j) { const f32x4 d = v[j] - mean; q += (d[0] * d[0] + d[1] * d[1]) + (d[2] * d[2] + d[3] * d[3]); }
    rstd = 1.f / sqrtf(wave_sum(q) * (1.f / D) + LN_EPS);
}
__device__ __forceinline__ const float* mod_row(unsigned char* ws, LAS unsigned char* lds, int layer, int r) {
    const int rb = r < ML ? r / SEQ : NB;
    return (const float*)(ws + WS_MOD) + (size_t)(layer * 9 + rb) * 6144;
}
__device__ __forceinline__ void load_gate_table(LAS unsigned char* lds, int layer, LAS float* T, int tid) {
    const float* src = INP(I_WIN) + (size_t)layer * D * NIN + 3072;
    for (int i = tid; i < D * 4; i += NTHREADS) { const int k = i >> 2, q = i & 3; const f32x4 w = *(const f32x4*)(src + (size_t)k * NIN + 4 * q);
        T[(4 * q + 0) * D + k] = w[0]; T[(4 * q + 1) * D + k] = w[1]; T[(4 * q + 2) * D + k] = w[2]; T[(4 * q + 3) * D + k] = w[3]; }
    __syncthreads();
}
__device__ __forceinline__ void load_router_table(LAS unsigned char* lds, int mi, LAS float* T, int tid) {
    const float* src = INP(I_RW) + (size_t)mi * D * NE;
    for (int i = tid; i < D * 2; i += NTHREADS) { const int k = i >> 1, q = i & 1; const f32x4 w = *(const f32x4*)(src + (size_t)k * NE + 4 * q);
        T[(4 * q + 0) * D + k] = w[0]; T[(4 * q + 1) * D + k] = w[1]; T[(4 * q + 2) * D + k] = w[2]; T[(4 * q + 3) * D + k] = w[3]; }
    __syncthreads();
}
__device__ __forceinline__ float dot4_rows(const f32x4 (&u)[4], const LAS float* T, int g0, int lane) {
    float p[4];
#pragma unroll
    for (int i = 0; i < 4; ++i) { float s = 0.f;
#pragma unroll
        for (int j = 0; j < 4; ++j) { const f32x4 w = *(const LAS f32x4*)(T + (g0 + i) * D + 256 * j + 4 * lane); s += (u[j][0] * w[0] + u[j][1] * w[1]) + (u[j][2] * w[2] + u[j][3] * w[3]); }
        p[i] = s; }
    const bool b5 = (lane & 32) != 0, b4 = (lane & 16) != 0;
    const float q0 = (b5 ? p[2] : p[0]) + __shfl_xor(b5 ? p[0] : p[2], 32), q1 = (b5 ? p[3] : p[1]) + __shfl_xor(b5 ? p[1] : p[3], 32);
    float s = (b4 ? q1 : q0) + __shfl_xor(b4 ? q0 : q1, 16);
    return row16_sum(s);
}
__device__ __forceinline__ void row_A(unsigned char* ws, LAS unsigned char* lds, int layer, int r, const f32x4 (&x)[4], const LAS float* GT, int lane) {
    float mean, rstd; ln_stats(x, mean, rstd);
    const float* mod = mod_row(ws, lds, layer, r);
    f32x4 u[4];
    f16* up = (f16*)(ws + WS_U16) + (size_t)r * D;
#pragma unroll
    for (int j = 0; j < 4; ++j) { const int k = 256 * j + 4 * lane; const f32x4 sh = *(const f32x4*)(mod + k), sc = *(const f32x4*)(mod + 1024 + k);
        u[j] = (x[j] - mean) * rstd * (sc + 1.f) + sh;
        f16x4 h; h[0] = (f16)u[j][0]; h[1] = (f16)u[j][1]; h[2] = (f16)u[j][2]; h[3] = (f16)u[j][3];
        *(f16x4*)(up + k) = h; }
#pragma unroll 1
    for (int gb = 0; gb < 4; ++gb) { const float s = dot4_rows(u, GT, 4 * gb, lane);
        if ((lane & 15) == 0) ((float*)(ws + WS_MLG))[(size_t)r * 16 + 4 * gb + (lane >> 4)] = s; }
}
__device__ __forceinline__ void row_A_pre(unsigned char* ws, int r, const f32x4 (&x)[4], const f32x4 (&sh)[4], const f32x4 (&sc)[4], const LAS float* GT, int lane) {
    float mean, rstd; ln_stats(x, mean, rstd);
    f32x4 u[4];
    f16* up = (f16*)(ws + WS_U16) + (size_t)r * D;
#pragma unroll
    for (int j = 0; j < 4; ++j) { const int k = 256 * j + 4 * lane;
        u[j] = (x[j] - mean) * rstd * (sc[j] + 1.f) + sh[j];
        f16x4 h; h[0] = (f16)u[j][0]; h[1] = (f16)u[j][1]; h[2] = (f16)u[j][2]; h[3] = (f16)u[j][3];
        *(f16x4*)(up + k) = h; }
#pragma unroll 1
    for (int gb = 0; gb < 4; ++gb) { const float s = dot4_rows(u, GT, 4 * gb, lane);
        if ((lane & 15) == 0) ((float*)(ws + WS_MLG))[(size_t)r * 16 + 4 * gb + (lane >> 4)] = s; }
}
__device__ __forceinline__ void load_row(const float* p, f32x4 (&v)[4], int lane) {
#pragma unroll
    for (int j = 0; j < 4; ++j) v[j] = *(const f32x4*)(p + 256 * j + 4 * lane);
}
__device__ __forceinline__ void load_row_h(const f16* p, f32x4 (&v)[4], int lane) {
#pragma unroll
    for (int j = 0; j < 4; ++j) { const f16x4 h = *(const f16x4*)(p + 256 * j + 4 * lane); v[j] = (f32x4){(float)h[0], (float)h[1], (float)h[2], (float)h[3]}; }
}
__device__ __forceinline__ void store_row_h(f16* p, const f32x4 (&v)[4], int lane) {
#pragma unroll
    for (int j = 0; j < 4; ++j) { f16x4 h; h[0] = (f16)v[j][0]; h[1] = (f16)v[j][1]; h[2] = (f16)v[j][2]; h[3] = (f16)v[j][3]; *(f16x4*)(p + 256 * j + 4 * lane) = h; }
}
template <int layer>
__device__ __forceinline__ void load_x(unsigned char* ws, LAS unsigned char* lds, int r, f32x4 (&v)[4], int lane) {
    if constexpr (layer == 0) load_row(r < ML ? INP(I_X) + (size_t)r * D : INP(I_CTX) + (size_t)(r - ML) * D, v, lane);
    else load_row_h((const f16*)(ws + WS_XS) + (size_t)r * D, v, lane);
}
__device__ __forceinline__ void load_row_sum(const float* p, size_t stride, int n, f32x4 (&v)[4], int lane) {
    load_row(p, v, lane);
    for (int s = 1; s < n; ++s) { f32x4 t[4]; load_row(p + (size_t)s * stride, t, lane);
#pragma unroll
        for (int j = 0; j < 4; ++j) v[j] += t[j]; }
}
__device__ __forceinline__ const float* x_src(unsigned char* ws, LAS unsigned char* lds, int layer, int r) {
    if (layer == 0) return r < ML ? INP(I_X) + (size_t)r * D : INP(I_CTX) + (size_t)(r - ML) * D;
    return (const float*)(ws + WS_XS) + (size_t)r * D;
}

__device__ __forceinline__ void pool_phase(unsigned char* ws, int layer, LAS unsigned char* lds, int vb, int nvb, int tid) {
    LAS float* in = (LAS float*)lds;
    LAS f16* dif16 = (LAS f16*)(lds + 80 * 64 * 4);
    LAS f16* Wt16 = dif16 + 64 * 72;
    const f16* P1 = (const f16*)(ws + WS_P1);
    f16* CAT = (f16*)(ws + WS_CAT);
    const int nrows = (layer == DEPTH - 1) ? ML : MT;
    const int nunits = (nrows / 64) * 4;
    const int lane = tid & 63, w = __builtin_amdgcn_readfirstlane(tid >> 6), gq = lane >> 4, c = lane & 15;
    int gl = -1;
    for (int un = vb; un < nunits; un += nvb) {
        const int ch = un >> 2, g = un & 3, r0 = ch * 64;
        const int seq0 = r0 < ML ? (r0 / SEQ) * SEQ : ML + ((r0 - ML) / CTXL) * CTXL, seqlen = r0 < ML ? SEQ : CTXL;
        const int t0 = r0 - seq0, half = 1 << g;
        __syncthreads();
        for (int i = tid; i < 80 * 8; i += NTHREADS) { const int rr = i >> 3, c8 = (i & 7) * 8; const int t = t0 - 8 + rr;
            f16x8 v; if (t >= 0 && t < seqlen) v = *(const f16x8*)(P1 + (size_t)(seq0 + t) * NP1 + g * 64 + c8); else { for (int q = 0; q < 8; ++q) v[q] = (f16)0.f; }
#pragma unroll
            for (int q = 0; q < 8; ++q) in[rr * 64 + c8 + q] = (float)v[q]; }
        if (g != gl) { const float* pw = INP(I_POOLW) + (size_t)(layer * 4 + g) * 4096;
            for (int i = tid; i < 4096; i += NTHREADS) { const int cc = i >> 6, dd = i & 63; Wt16[dd * 72 + cc] = (f16)pw[i]; } gl = g; }
        __syncthreads();
        { const int tt = tid >> 3, c8 = (tid & 7) * 8, t = t0 + tt; int lo = t - half; if (lo < 0) lo = 0; int hi = t + half; if (hi > seqlen) hi = seqlen;
          const float inv = 1.f / (float)(hi - lo);
          float sacc[8];
#pragma unroll
          for (int q = 0; q < 8; ++q) sacc[q] = 0.f;
          for (int p = lo; p < hi; ++p) { const LAS float* ip = in + (p - t0 + 8) * 64 + c8;
#pragma unroll
              for (int q = 0; q < 8; ++q) sacc[q] += ip[q]; }
          f16x8 dv;
#pragma unroll
          for (int q = 0; q < 8; ++q) dv[q] = (f16)(sacc[q] * inv - in[(tt + 8) * 64 + c8 + q]);
          *(LAS f16x8*)(dif16 + tt * 72 + c8) = dv; }
        __syncthreads();
        { const int tt = w >> 1;
          f16x8 bfr[2];
#pragma unroll
          for (int ks = 0; ks < 2; ++ks) bfr[ks] = *(const LAS f16x8*)(dif16 + (16 * tt + c) * 72 + 32 * ks + 8 * gq);
#pragma unroll
          for (int q = 0; q < 2; ++q) { const int dt = (w & 1) * 2 + q;
              f32x4 acc = (f32x4){0.f, 0.f, 0.f, 0.f};
#pragma unroll
              for (int ks = 0; ks < 2; ++ks) { const f16x8 afr = *(const LAS f16x8*)(Wt16 + (16 * dt + c) * 72 + 32 * ks + 8 * gq);
                  acc = __builtin_amdgcn_mfma_f32_16x16x32_f16(afr, bfr[ks], acc, 0, 0, 0); }
              const f32x4 ps = *(const f32x4*)(INP(I_POOLS) + layer * 256 + g * 64 + 16 * dt + 4 * gq);
              f16x4 h; h[0] = (f16)(acc[0] * ps[0]); h[1] = (f16)(acc[1] * ps[1]); h[2] = (f16)(acc[2] * ps[2]); h[3] = (f16)(acc[3] * ps[3]);
              *(f16x4*)(CAT + (size_t)(r0 + 16 * tt + c) * D + g * 64 + 16 * dt + 4 * gq) = h; } }
    }
    __syncthreads();
}
__device__ __forceinline__ void na_phase(unsigned char* ws, int layer, LAS unsigned char* lds, int gw, int ngw, int wave, int lane) {
    LAS float* qs = (LAS float*)(lds + wave * 2048);
    LAS float* ps = qs + 64;
    const f16* P1 = (const f16*)(ws + WS_P1);
    f16* CAT = (f16*)(ws + WS_CAT);
    const float* rpb = INP(I_RPB) + (size_t)layer * 4 * 15 * 31;
    const int nq = (layer == DEPTH - 1) ? ML : MT;
    for (int item = gw; item < nq * 4; item += ngw) {
        const int tq = item >> 2, h = item & 3;
        qs[lane] = (float)P1[(size_t)tq * NP1 + 256 + h * 64 + lane];
        LDS_WAIT();
        const bool lat = tq < ML;
        const int b = lat ? tq / SEQ : (tq - ML) / CTXL;
        const int pos = tq % SEQ, r = pos >> 6, qc = pos & 63;
        int r0 = r - 4; r0 = r0 < 0 ? 0 : (r0 > 24 ? 24 : r0);
        int cs = qc - 8; cs = cs < 0 ? 0 : (cs > 48 ? 48 : cs);
        const int nloc = lat ? 128 : 0, nk = nloc + 256;
        float sc[6]; int tk[6];
        float mx = -3.0e38f;
#pragma unroll
        for (int i = 0; i < 6; ++i) {
            const int j = lane + 64 * i; sc[i] = -3.0e38f; tk[i] = 0;
            if (j < nk) {
                float bias = 0.f; int tok;
                if (j < nloc) { const int w = j >> 4, kk = j & 15; tok = b * SEQ + (r0 + w) * 64 + cs + kk;
                    int co = cs + kk - qc; co = co < -15 ? -15 : (co > 15 ? 15 : co);
                    bias = rpb[(h * 15 + (r0 + w - r + 7)) * 31 + co + 15]; }
                else tok = ML + b * CTXL + (j - nloc);
                tk[i] = tok;
                const f16* kp = P1 + (size_t)tok * NP1 + 512 + h * 64;
                float s = 0.f;
#pragma unroll
                for (int c = 0; c < 8; ++c) { const f16x8 kv = *(const f16x8*)(kp + 8 * c);
#pragma unroll
                    for (int q = 0; q < 8; ++q) s += qs[8 * c + q] * (float)kv[q]; }
                sc[i] = s + bias; mx = fmaxf(mx, sc[i]);
            }
        }
        mx = wave_max(mx);
        float sum = 0.f;
#pragma unroll
        for (int i = 0; i < 6; ++i) { const int j = lane + 64 * i; if (j < nk) { const float p = __expf(sc[i] - mx); sum += p; ps[j] = p; } }
        sum = wave_sum(sum);
        LDS_WAIT();
        float o = 0.f;
        for (int j = 0; j < nk; ++j) {
            int tok;
            if (j < nloc) tok = b * SEQ + (r0 + (j >> 4)) * 64 + cs + (j & 15); else tok = ML + b * CTXL + (j - nloc);
            o += ps[j] * (float)P1[(size_t)tok * NP1 + 768 + h * 64 + lane];
        }
        CAT[(size_t)tq * D + 256 + h * 64 + lane] = (f16)(o / sum);
        LDS_WAIT();
    }
}
__device__ __forceinline__ void mlprep_phase(unsigned char* ws, LAS unsigned char* lds, int layer, int gw, int ngw, int lane) {
    const f16* P1 = (const f16*)(ws + WS_P1);
    f16* QK = (f16*)(ws + WS_QK);
    const float* cw = INP(I_CONVW) + (size_t)layer * 3 * 1024;
    const float2* ROPE = (const float2*)(ws + WS_ROPE);
    float wq[3][8], wk[3][8];
#pragma unroll
    for (int t = 0; t < 3; ++t) { const f32x4 a0 = *(const f32x4*)(cw + t * 1024 + 8 * lane), a1 = *(const f32x4*)(cw + t * 1024 + 8 * lane + 4), b0 = *(const f32x4*)(cw + t * 1024 + 512 + 8 * lane), b1 = *(const f32x4*)(cw + t * 1024 + 512 + 8 * lane + 4);
#pragma unroll
        for (int j = 0; j < 4; ++j) { wq[t][j] = a0[j]; wq[t][4 + j] = a1[j]; wk[t][j] = b0[j]; wk[t][4 + j] = b1[j]; } }
    const int fi0 = (lane & 3) * 8;
    const bool first = (lane & 4) == 0;
    const int half = (lane >> 3) & 1;
    f16x8 z8; for (int j = 0; j < 8; ++j) z8[j] = (f16)0.f;
    f16x8 q0n = z8, q1n = z8, q2n = z8, k0n = z8, k1n = z8, k2n = z8, vvn = z8;
#define PREP_LOAD(r_) do { const bool lat_ = (r_) < ML; const int s0_ = lat_ ? ((r_) / SEQ) * SEQ : ML + (((r_) - ML) / CTXL) * CTXL, sl_ = lat_ ? SEQ : CTXL, t_ = (r_) - s0_; \
        const f16* p_ = P1 + (size_t)(r_) * NP1 + 1024 + 8 * lane; \
        q0n = t_ > 0 ? *(const f16x8*)(p_ - NP1) : z8; q1n = *(const f16x8*)p_; q2n = t_ + 1 < sl_ ? *(const f16x8*)(p_ + NP1) : z8; \
        k0n = t_ > 0 ? *(const f16x8*)(p_ - NP1 + 512) : z8; k1n = *(const f16x8*)(p_ + 512); k2n = t_ + 1 < sl_ ? *(const f16x8*)(p_ + NP1 + 512) : z8; } while (0)
    if (gw < MT) PREP_LOAD(gw);
    for (int r = gw; r < MT; r += ngw) {
        const bool lat = r < ML;
        const int seq0 = lat ? (r / SEQ) * SEQ : ML + ((r - ML) / CTXL) * CTXL, t = r - seq0;
        const f16x8 q0 = q0n, q1 = q1n, q2 = q2n, k0 = k0n, k1 = k1n, k2 = k2n;
        if (r + ngw < MT) PREP_LOAD(r + ngw);
        float vq[8], vk[8];
#pragma unroll
        for (int j = 0; j < 8; ++j) { vq[j] = silu_(wq[0][j] * (float)q0[j] + wq[1][j] * (float)q1[j] + wq[2][j] * (float)q2[j]);
            vk[j] = silu_(wk[0][j] * (float)k0[j] + wk[1][j] * (float)k1[j] + wk[2][j] * (float)k2[j]) * 0.08838834764831845f; }
        if (lat) {
            const int pp = half ? (t & 63) : (t >> 6);
            const float2* rp = ROPE + pp * 32 + fi0;
#pragma unroll
            for (int j = 0; j < 8; ++j) { const float2 cs = rp[j];
                const float oq = __shfl_xor(vq[j], 4), ok = __shfl_xor(vk[j], 4);
                vq[j] = first ? vq[j] * cs.x - oq * cs.y : oq * cs.y + vq[j] * cs.x;
                vk[j] = first ? vk[j] * cs.x - ok * cs.y : ok * cs.y + vk[j] * cs.x; }
        }
        f16x8 hq, hk;
#pragma unroll
        for (int j = 0; j < 8; ++j) { hq[j] = (f16)vq[j]; hk[j] = (f16)vk[j]; }
        *(f16x8*)(QK + (size_t)r * 1024 + 8 * lane) = hq; *(f16x8*)(QK + (size_t)r * 1024 + 512 + 8 * lane) = hk;
    }
}
__device__ __forceinline__ void mlstm_naive_phase(unsigned char* ws, int layer, LAS unsigned char* lds, int vb, int nvb, int tid) {
    LAS float* qs = (LAS float*)lds;
    LAS float* ks = qs + 32 * 128;
    LAS float* vs = ks + 32 * 128;
    LAS float* gi = vs + 32 * 128;
    LAS float* gf = gi + 32;
    LAS float* part = gf + 32;
    LAS float* partd = part + 1024;
    const f16* P1 = (const f16*)(ws + WS_P1);
    const f16* QK = (const f16*)(ws + WS_QK);
    const float* MLG = (const float*)(ws + WS_MLG);
    float* HFB = (float*)(ws + WS_HFB);
    const float* gb = INP(I_GBIAS) + layer * 16;
    const int dg = tid >> 7, e = tid & 127;
    for (int job = vb; job < 64; job += nvb) {
        const int b = job >> 3, h = (job >> 1) & 3, dir = job & 1;
        float C[32], n[32];
#pragma unroll
        for (int i = 0; i < 32; ++i) { C[i] = 0.f; n[i] = 0.f; }
        for (int s0 = 0; s0 < CTXL + SEQ; s0 += 32) {
            __syncthreads();
            for (int i = tid; i < 32 * 128; i += NTHREADS) { const int s = s0 + (i >> 7), d = i & 127;
                const int tok = s < CTXL ? ML + b * CTXL + (dir ? CTXL - 1 - s : s) : b * SEQ + (dir ? SEQ - 1 - (s - CTXL) : (s - CTXL));
                qs[i] = (float)QK[(size_t)tok * 1024 + h * 128 + d]; ks[i] = (float)QK[(size_t)tok * 1024 + 512 + h * 128 + d];
                vs[i] = (float)P1[(size_t)tok * NP1 + 2048 + h * 128 + d];
                if (d == 0) { gi[i >> 7] = __expf(MLG[(size_t)tok * 16 + dir * 8 + h] + gb[dir * 8 + h]); gf[i >> 7] = sigmoid_(MLG[(size_t)tok * 16 + dir * 8 + 4 + h] + gb[dir * 8 + 4 + h]); } }
            __syncthreads();
            for (int s = 0; s < 32; ++s) {
                const float fi = gf[s], ii = gi[s], ve = vs[s * 128 + e] * ii;
                float pn = 0.f, pd = 0.f;
#pragma unroll
                for (int i = 0; i < 32; ++i) { const float kd = ks[s * 128 + dg * 32 + i], qd = qs[s * 128 + dg * 32 + i];
                    C[i] = fi * C[i] + kd * ve; n[i] = fi * n[i] + ii * kd; pn += qd * C[i]; pd += qd * n[i]; }
                part[((s & 1) * 4 + dg) * 128 + e] = pn; if (e == 0) partd[(s & 1) * 4 + dg] = pd;
                __syncthreads();
                if (dg == 0) { const int sb = (s & 1) * 4;
                    const float num = (part[(sb + 0) * 128 + e] + part[(sb + 1) * 128 + e]) + (part[(sb + 2) * 128 + e] + part[(sb + 3) * 128 + e]);
                    const float den = (partd[sb] + partd[sb + 1]) + (partd[sb + 2] + partd[sb + 3]);
                    const int sg = s0 + s;
                    const int tok = sg < CTXL ? ML + b * CTXL + (dir ? CTXL - 1 - sg : sg) : b * SEQ + (dir ? SEQ - 1 - (sg - CTXL) : (sg - CTXL));
                    HFB[((size_t)dir * MT + tok) * 512 + h * 128 + e] = num / fmaxf(fabsf(den), 1.f); }
            }
        }
    }
    __syncthreads();
}

#define TR_READ2(r0, r1, a0, a1) asm volatile("ds_read_b64_tr_b16 %0, %2\n\tds_read_b64_tr_b16 %1, %3\n\ts_waitcnt lgkmcnt(0)" : "=&v"(r0), "=&v"(r1) : "v"(a0), "v"(a1) : "memory")
__device__ __forceinline__ float scan_sum64(float v, int lane) {
    v += __builtin_bit_cast(float, __builtin_amdgcn_update_dpp(0, __builtin_bit_cast(int, v), 0x111, 0xF, 0xF, true));
    v += __builtin_bit_cast(float, __builtin_amdgcn_update_dpp(0, __builtin_bit_cast(int, v), 0x112, 0xF, 0xF, true));
    v += __builtin_bit_cast(float, __builtin_amdgcn_update_dpp(0, __builtin_bit_cast(int, v), 0x114, 0xF, 0xF, true));
    v += __builtin_bit_cast(float, __builtin_amdgcn_update_dpp(0, __builtin_bit_cast(int, v), 0x118, 0xF, 0xF, true));
    const int vi = __builtin_bit_cast(int, v);
    const float t0 = __builtin_bit_cast(float, __builtin_amdgcn_readlane(vi, 15)), t1 = __builtin_bit_cast(float, __builtin_amdgcn_readlane(vi, 31)), t2 = __builtin_bit_cast(float, __builtin_amdgcn_readlane(vi, 47));
    const int row = lane >> 4;
    return v + (row == 0 ? 0.f : (row == 1 ? t0 : (row == 2 ? t0 + t1 : (t0 + t1) + t2)));
}
__device__ __forceinline__ float scan_max64(float v, int lane) {
    const int ninf = __builtin_bit_cast(int, -3.0e38f);
    v = fmaxf(v, __builtin_bit_cast(float, __builtin_amdgcn_update_dpp(ninf, __builtin_bit_cast(int, v), 0x111, 0xF, 0xF, false)));
    v = fmaxf(v, __builtin_bit_cast(float, __builtin_amdgcn_update_dpp(ninf, __builtin_bit_cast(int, v), 0x112, 0xF, 0xF, false)));
    v = fmaxf(v, __builtin_bit_cast(float, __builtin_amdgcn_update_dpp(ninf, __builtin_bit_cast(int, v), 0x114, 0xF, 0xF, false)));
    v = fmaxf(v, __builtin_bit_cast(float, __builtin_amdgcn_update_dpp(ninf, __builtin_bit_cast(int, v), 0x118, 0xF, 0xF, false)));
    const int vi = __builtin_bit_cast(int, v);
    const float t0 = __builtin_bit_cast(float, __builtin_amdgcn_readlane(vi, 15)), t1 = __builtin_bit_cast(float, __builtin_amdgcn_readlane(vi, 31)), t2 = __builtin_bit_cast(float, __builtin_amdgcn_readlane(vi, 47));
    const int row = lane >> 4;
    return fmaxf(v, row == 0 ? -3.0e38f : (row == 1 ? t0 : (row == 2 ? fmaxf(t0, t1) : fmaxf(fmaxf(t0, t1), t2))));
}
__device__ __forceinline__ float log_sigmoid_(float x) { return x >= 0.f ? -log1pf(__expf(-x)) : x - log1pf(__expf(x)); }
__device__ __forceinline__ int ml_tok(int b, int dir, int ch, int s) {
    if (ch < 2) { const int idx = ch * 128 + s; return ML + b * CTXL + (dir ? CTXL - 1 - idx : idx); }
    const int idx = (ch - 2) * 128 + s; return b * SEQ + (dir ? SEQ - 1 - idx : idx);
}
#define TR_READ6(r0, r1, r2, r3, r4, r5, a, o0, o1, o2, o3, o4, o5) asm volatile( \
    "ds_read_b64_tr_b16 %0, %6 offset:" #o0 "\n\tds_read_b64_tr_b16 %1, %6 offset:" #o1 "\n\tds_read_b64_tr_b16 %2, %6 offset:" #o2 "\n\t" \
    "ds_read_b64_tr_b16 %3, %6 offset:" #o3 "\n\tds_read_b64_tr_b16 %4, %6 offset:" #o4 "\n\tds_read_b64_tr_b16 %5, %6 offset:" #o5 "\n\ts_waitcnt lgkmcnt(0)" \
    : "=&v"(r0), "=&v"(r1), "=&v"(r2), "=&v"(r3), "=&v"(r4), "=&v"(r5) : "v"(a) : "memory")
#define TR_READ8(r0, r1, r2, r3, r4, r5, r6, r7, a, b, o0, o1, p0, p1, p2, p3, p4, p5) asm volatile( \
    "ds_read_b64_tr_b16 %0, %8 offset:" #o0 "\n\tds_read_b64_tr_b16 %1, %8 offset:" #o1 "\n\t" \
    "ds_read_b64_tr_b16 %2, %9 offset:" #p0 "\n\tds_read_b64_tr_b16 %3, %9 offset:" #p1 "\n\tds_read_b64_tr_b16 %4, %9 offset:" #p2 "\n\t" \
    "ds_read_b64_tr_b16 %5, %9 offset:" #p3 "\n\tds_read_b64_tr_b16 %6, %9 offset:" #p4 "\n\tds_read_b64_tr_b16 %7, %9 offset:" #p5 "\n\ts_waitcnt lgkmcnt(0)" \
    : "=&v"(r0), "=&v"(r1), "=&v"(r2), "=&v"(r3), "=&v"(r4), "=&v"(r5), "=&v"(r6), "=&v"(r7) : "v"(a), "v"(b) : "memory")
struct FfnItem { unsigned long long s0, s1; f16* dst; int ld, ldd, k0, n0, mode; };
__device__ __forceinline__ void ffn_item(unsigned char* ws, LAS unsigned char* lds, int L, int it, unsigned long long& s0, unsigned long long& s1, f16*& dst, int& ld, int& ldd, int& k0, int& n0, int& mode) {
    const bool moe = (L & 1); const int fi = L >> 1, nexp = moe ? NE : 1;
    const int e = it / FFN_ITEMS, r = it - e * FFN_ITEMS;
    const size_t eo = (size_t)(fi * nexp + e) * D * DFF;
    unsigned char* W = ws + WS_W;
    if (r < 16 * (NFF2 / 32)) { mode = 1; s0 = (unsigned long long)((moe ? INP(I_MW1) : INP(I_FW1)) + eo); s1 = (unsigned long long)((moe ? INP(I_MW3) : INP(I_FW3)) + eo);
        ld = DFF; ldd = D; k0 = 64 * (r / (NFF2 / 32)); n0 = 32 * (r % (NFF2 / 32)); dst = (f16*)(W + (moe ? WO_13 : WO_13D)) + (size_t)e * NFF2 * D; }
    else { const int r2 = r - 16 * (NFF2 / 32); mode = 0; s0 = (unsigned long long)((moe ? INP(I_MW2) : INP(I_FW2)) + eo); s1 = s0;
        ld = D; ldd = DFF; k0 = 64 * (r2 / 32); n0 = 32 * (r2 % 32); dst = (f16*)(W + (moe ? WO_2 : WO_2D)) + (size_t)e * D * DFF; }
}
__device__ __forceinline__ void ffn_dma_issue(unsigned char* ws, LAS unsigned char* lds, LAS unsigned char* cscr, int L, int it, int lane) {
    unsigned long long s0, s1; f16* dst; int ld, ldd, k0, n0, mode; ffn_item(ws, lds, L, it, s0, s1, dst, ld, ldd, k0, n0, mode);
    const int n = n0 + 4 * (lane & 7);
    const bool useS1 = (mode != 0) && (n & 4);
    const unsigned lo = useS1 ? (unsigned)s1 : (unsigned)s0, hi = useS1 ? (unsigned)(s1 >> 32) : (unsigned)(s0 >> 32);
    const float* sp = (const float*)(const __attribute__((address_space(1))) float*)(((unsigned long long)hi << 32) | lo);
    sp += (mode == 0 ? n : 4 * (n >> 3)) + (size_t)(k0 + (lane >> 3)) * ld;
#pragma unroll
    for (int j = 0; j < 8; ++j) __builtin_amdgcn_global_load_lds((const unsigned*)(sp + (size_t)(8 * j) * ld), (LAS unsigned*)(cscr + j * 1040), 16, 0, 2);
}
__device__ __forceinline__ void ffn_dma_finish(unsigned char* ws, LAS unsigned char* lds, LAS unsigned char* cscr, int L, int it, int lane) {
    unsigned long long s0, s1; f16* dst; int ld, ldd, k0, n0, mode; ffn_item(ws, lds, L, it, s0, s1, dst, ld, ldd, k0, n0, mode);
    const int c8 = lane & 7;
#pragma unroll
    for (int jj = 0; jj < 4; ++jj) { const int nn = (lane >> 3) + 8 * jj; const LAS float* sc = (const LAS float*)(cscr + c8 * 1040) + nn;
        f16x8 h;
#pragma unroll
        for (int q = 0; q < 8; ++q) h[q] = (f16)sc[q * 32];
        *(f16x8*)(dst + (size_t)(n0 + nn) * ldd + k0 + 8 * c8) = h; }
}
struct ConvSeg { int LA, a0, an, LB, b0, bn; };
__device__ __forceinline__ void mlstm_mfma_phase(unsigned char* ws, int layer, LAS unsigned char* lds, int vb, int nvb, int tid, const ConvSeg cs) {
    const int conv_n = cs.an + cs.bn;
    constexpr int KROW = 272, VROW = 112, CROW = 272;
    static_assert(16 * VROW == 1792 && 4 * VROW == 448 && 4 * KROW == 1088, "TR_READ offsets below are written out as literals");
    constexpr int OFF_K = 0, OFF_V = 128 * KROW, OFF_CT = OFF_V + 128 * VROW, OFF_G = OFF_CT + 48 * CROW, GBUF = 2560, OFF_RAW = OFF_G + 2 * GBUF;
    LAS unsigned char* Ks = lds + OFF_K; LAS unsigned char* Vs = lds + OFF_V; LAS unsigned char* CTs = lds + OFF_CT;
    const f16* P1 = (const f16*)(ws + WS_P1);
    const f16* QK = (const f16*)(ws + WS_QK);
    const float* MLG = (const float*)(ws + WS_MLG);
    float* HFB = (float*)(ws + WS_HFB);
    const float* gb = INP(I_GBIAS) + layer * 16;
    const int lane = tid & 63, w = __builtin_amdgcn_readfirstlane(tid >> 6), g = lane >> 4, c = lane & 15, cq = c >> 2, cp = c & 3;
    const int srow = tid >> 2, sq = tid & 3;
    LAS unsigned char* cscr = lds + OFF_RAW + 2 * 2304 * 4 + w * 8320;
    const int cgw = vb * NWAVES + w, cngw = nvb * NWAVES;
    for (int job = vb; job < 256; job += nvb) {
        const int b = job >> 5, h = (job >> 3) & 3, dir = (job >> 2) & 1, eq = job & 3;
        const float gbi = gb[dir * 8 + h], gbf = gb[dir * 8 + 4 + h];
        __syncthreads();
        for (int i = tid; i < 48 * CROW / 16; i += NTHREADS) *(LAS u32x4*)(CTs + 16 * i) = (u32x4){0u, 0u, 0u, 0u};
        if (sq == 0) { unsigned ob = 0x3C00u, zb = 0u; asm volatile("" : "+v"(ob), "+v"(zb));
            *(LAS u32x4*)(Vs + srow * VROW + 64) = (u32x4){ob, zb, zb, zb}; *(LAS u32x4*)(Vs + srow * VROW + 80) = (u32x4){zb, zb, zb, zb}; }
        f32x4 C[3];
#pragma unroll
        for (int et = 0; et < 3; ++et) C[et] = (f32x4){0.f, 0.f, 0.f, 0.f};
        float m = -1e30f;
        { LAS float* raw = (LAS float*)(lds + OFF_RAW);
          for (int i = tid; i < 2304; i += NTHREADS) { const int tk = ml_tok(b, dir, i >> 7, i & 127); raw[i] = MLG[(size_t)tk * 16 + dir * 8 + h]; raw[2304 + i] = MLG[(size_t)tk * 16 + dir * 8 + 4 + h]; } }
        f16x8 kreg[4], vreg, qreg[4];
        { const int tokS = ml_tok(b, dir, 0, srow);
#pragma unroll
          for (int i = 0; i < 4; ++i) kreg[i] = *(const f16x8*)(QK + (size_t)tokS * 1024 + 512 + h * 128 + (4 * i + sq) * 8);
          vreg = *(const f16x8*)(P1 + (size_t)tokS * NP1 + 2048 + h * 128 + eq * 32 + sq * 8);
          const int tokT = ml_tok(b, dir, 0, 16 * w + c);
#pragma unroll
          for (int kd = 0; kd < 4; ++kd) qreg[kd] = *(const f16x8*)(QK + (size_t)tokT * 1024 + h * 128 + 32 * kd + 8 * g);
        }
        __syncthreads();
#define ML_GATES(chn_) do { LAS float* gq = (LAS float*)(lds + OFF_G + ((chn_) & 1) * GBUF); const LAS float* raw = (const LAS float*)(lds + OFF_RAW) + (chn_) * 128; \
            const float ig0 = raw[lane] + gbi, ig1 = raw[lane + 64] + gbi, lf0 = log_sigmoid_(raw[2304 + lane] + gbf), lf1 = log_sigmoid_(raw[2304 + lane + 64] + gbf); \
            const float b0 = scan_sum64(lf0, lane), tot0 = __shfl(b0, 63), b1 = scan_sum64(lf1, lane) + tot0, b_end = __shfl(b1, 63); \
            const float ct0 = ig0 - b0, ct1 = ig1 - b1; \
            const float a0 = scan_max64(ct0, lane), am0 = __shfl(a0, 63), a1 = fmaxf(scan_max64(ct1, lane), am0), amax = __shfl(a1, 63); \
            const float M = fmaxf(m, amax), Mt0 = fmaxf(a0, m), Mt1 = fmaxf(a1, m); \
            gq[lane] = ct0; gq[lane + 64] = ct1; gq[128 + lane] = Mt0; gq[192 + lane] = Mt1; \
            gq[256 + lane] = __expf(-(b0 + Mt0)); gq[320 + lane] = __expf(-(b1 + Mt1)); gq[384 + lane] = __expf(m - Mt0); gq[448 + lane] = __expf(m - Mt1); \
            ((LAS f16*)(gq + 512))[lane] = (f16)__expf(ct0 - M); ((LAS f16*)(gq + 512))[lane + 64] = (f16)__expf(ct1 - M); \
            if (lane == 0) gq[576] = __expf(m - M); \
            m = b_end + M; } while (0)
        if (w == 0) ML_GATES(0);
        for (int ch = 0; ch < 18; ++ch) {
            LAS float* g_ct = (LAS float*)(lds + OFF_G + (ch & 1) * GBUF); LAS float* g_mt = g_ct + 128; LAS float* g_emt = g_ct + 256; LAS float* g_wi = g_ct + 384; LAS f16* g_w16 = (LAS f16*)(g_ct + 512);
#pragma unroll
            for (int i = 0; i < 4; ++i) *(LAS f16x8*)(Ks + srow * KROW + (4 * i + sq) * 16) = kreg[i];
            *(LAS f16x8*)(Vs + srow * VROW + sq * 16) = vreg;
            f16x8 qf[4];
#pragma unroll
            for (int kd = 0; kd < 4; ++kd) qf[kd] = qreg[kd];
            const int tokT = ml_tok(b, dir, ch, 16 * w + c);
            __syncthreads();
            if (conv_n > 0 && ch > 0) { const int itp = (ch - 1) * cngw + cgw; if (itp < conv_n) { asm volatile("s_waitcnt vmcnt(2)" ::: "memory"); ffn_dma_finish(ws, lds, cscr, itp < cs.an ? cs.LA : cs.LB, itp < cs.an ? cs.a0 + itp : cs.b0 + itp - cs.an, lane); } }
            if (ch + 1 < 18) { const int tokS = ml_tok(b, dir, ch + 1, srow);
#pragma unroll
                for (int i = 0; i < 4; ++i) kreg[i] = *(const f16x8*)(QK + (size_t)tokS * 1024 + 512 + h * 128 + (4 * i + sq) * 8);
                vreg = *(const f16x8*)(P1 + (size_t)tokS * NP1 + 2048 + h * 128 + eq * 32 + sq * 8);
                const int tokN = ml_tok(b, dir, ch + 1, 16 * w + c);
#pragma unroll
                for (int kd = 0; kd < 4; ++kd) qreg[kd] = *(const f16x8*)(QK + (size_t)tokN * 1024 + h * 128 + 32 * kd + 8 * g);
            }
            const float decay = g_ct[576];
            f32x4 st[8];
#pragma unroll
            for (int j = 0; j < 8; ++j) { st[j] = (f32x4){0.f, 0.f, 0.f, 0.f};
                if (j <= w) {
#pragma unroll
                    for (int ks = 0; ks < 4; ++ks) { const f16x8 a = *(const LAS f16x8*)(Ks + (16 * j + c) * KROW + (32 * ks + 8 * g) * 2);
                        st[j] = __builtin_amdgcn_mfma_f32_16x16x32_f16(a, qf[ks], st[j], 0, 0, 0); } } }
            const int tl = 16 * w + c; const float mt = g_mt[tl];
            f16x8 pf[4];
#pragma unroll
            for (int ks = 0; ks < 4; ++ks) {
#pragma unroll
                for (int hh = 0; hh < 2; ++hh) { const int j = 2 * ks + hh;
                    if (j <= w) { const f32x4 cv = *(const LAS f32x4*)(g_ct + 16 * j + 4 * g);
#pragma unroll
                        for (int i = 0; i < 4; ++i) { const int sl = 16 * j + 4 * g + i; const float v = (sl <= tl) ? st[j][i] * __expf(cv[i] - mt) : 0.f; pf[ks][4 * hh + i] = (f16)v; } }
                    else {
#pragma unroll
                        for (int i = 0; i < 4; ++i) pf[ks][4 * hh + i] = (f16)0.f; } } }
            if (conv_n > 0) { const int itc = ch * cngw + cgw; if (itc < conv_n) { LDS_WAIT(); ffn_dma_issue(ws, lds, cscr, itc < cs.an ? cs.LA : cs.LB, itc < cs.an ? cs.a0 + itc : cs.b0 + itc - cs.an, lane); } }
            f32x4 o1[3], o2[3];
#pragma unroll
            for (int et = 0; et < 3; ++et) { o1[et] = (f32x4){0.f, 0.f, 0.f, 0.f}; o2[et] = (f32x4){0.f, 0.f, 0.f, 0.f}; }
            const unsigned vs_base = (unsigned)(size_t)Vs, ks_base = (unsigned)(size_t)Ks;
#pragma unroll
            for (int ks = 0; ks < 4; ++ks) if (2 * ks <= w) {
                f16x4 t0, t1, t2, t3, t4, t5;
                const unsigned a0 = vs_base + (32 * ks + 4 * g + cq) * VROW + (4 * cp) * 2;
                TR_READ6(t0, t1, t2, t3, t4, t5, a0, 0, 1792, 32, 1824, 64, 1856);
                o1[0] = __builtin_amdgcn_mfma_f32_16x16x32_f16(__builtin_shufflevector(t0, t1, 0, 1, 2, 3, 4, 5, 6, 7), pf[ks], o1[0], 0, 0, 0);
                o1[1] = __builtin_amdgcn_mfma_f32_16x16x32_f16(__builtin_shufflevector(t2, t3, 0, 1, 2, 3, 4, 5, 6, 7), pf[ks], o1[1], 0, 0, 0);
                o1[2] = __builtin_amdgcn_mfma_f32_16x16x32_f16(__builtin_shufflevector(t4, t5, 0, 1, 2, 3, 4, 5, 6, 7), pf[ks], o1[2], 0, 0, 0); }
#pragma unroll
            for (int kd = 0; kd < 4; ++kd) {
#pragma unroll
                for (int et = 0; et < 3; ++et) { const f16x8 av = *(const LAS f16x8*)(CTs + (16 * et + c) * CROW + (32 * kd + 8 * g) * 2);
                    o2[et] = __builtin_amdgcn_mfma_f32_16x16x32_f16(av, qf[kd], o2[et], 0, 0, 0); } }
            { const float wi = g_wi[tl];
              const float denl = o1[2][0] + wi * o2[2][0];
              const float den = __shfl(denl, c);
              const float inv = 1.f / fmaxf(fabsf(den), g_emt[tl]);
              float* hp = HFB + ((size_t)dir * MT + tokT) * 512 + h * 128 + eq * 32 + 4 * g;
#pragma unroll
              for (int et = 0; et < 2; ++et) *(f32x4*)(hp + 16 * et) = (o1[et] + o2[et] * wi) * inv; }
#pragma unroll
            for (int et = 0; et < 3; ++et) C[et] = C[et] * decay;
#pragma unroll
            for (int ks = 0; ks < 4; ++ks) { f16x4 k0, k1, v0, v1, v2, v3, v4, v5;
                const unsigned ka = ks_base + (32 * ks + 8 * g + cq) * KROW + (16 * w + 4 * cp) * 2;
                const unsigned va = vs_base + (32 * ks + 8 * g + cq) * VROW + (4 * cp) * 2;
                TR_READ8(k0, k1, v0, v1, v2, v3, v4, v5, ka, va, 0, 1088, 0, 448, 32, 480, 64, 512);
                f16x8 kt = __builtin_shufflevector(k0, k1, 0, 1, 2, 3, 4, 5, 6, 7);
                const f16x8 wv = *(const LAS f16x8*)(g_w16 + 32 * ks + 8 * g);
                kt = kt * wv;
                C[0] = __builtin_amdgcn_mfma_f32_16x16x32_f16(kt, __builtin_shufflevector(v0, v1, 0, 1, 2, 3, 4, 5, 6, 7), C[0], 0, 0, 0);
                C[1] = __builtin_amdgcn_mfma_f32_16x16x32_f16(kt, __builtin_shufflevector(v2, v3, 0, 1, 2, 3, 4, 5, 6, 7), C[1], 0, 0, 0);
                C[2] = __builtin_amdgcn_mfma_f32_16x16x32_f16(kt, __builtin_shufflevector(v4, v5, 0, 1, 2, 3, 4, 5, 6, 7), C[2], 0, 0, 0); }
            if (w == 0 && ch + 1 < 18) ML_GATES(ch + 1);
            __syncthreads();
#pragma unroll
            for (int et = 0; et < 3; ++et) { f16x4 cv; cv[0] = (f16)C[et][0]; cv[1] = (f16)C[et][1]; cv[2] = (f16)C[et][2]; cv[3] = (f16)C[et][3];
                *(LAS f16x4*)(CTs + (16 * et + c) * CROW + (16 * w + 4 * g) * 2) = cv; }
        }
        if (conv_n > 0) { const int itp = 17 * cngw + cgw; if (itp < conv_n) { asm volatile("s_waitcnt vmcnt(2)" ::: "memory"); ffn_dma_finish(ws, lds, cscr, itp < cs.an ? cs.LA : cs.LB, itp < cs.an ? cs.a0 + itp : cs.b0 + itp - cs.an, lane); } }
#undef ML_GATES
    }
    __syncthreads();
}

__device__ __forceinline__ void na_mfma_phase(unsigned char* ws, int layer, LAS unsigned char* lds, int vb, int nvb, int tid) {
    constexpr int VROW = 144;
    constexpr int OFF_B = 768 * VROW, OFF_M = OFF_B + 2048;
    LAS unsigned char* Vs = lds; LAS float* Bs = (LAS float*)(lds + OFF_B); LAS float* Ms = (LAS float*)(lds + OFF_M);
    const f16* P1 = (const f16*)(ws + WS_P1);
    f16* CAT = (f16*)(ws + WS_CAT);
    const int lane = tid & 63, w = __builtin_amdgcn_readfirstlane(tid >> 6), g = lane >> 4, c = lane & 15, cq = c >> 2, cp = c & 3;
    const int qt = w & 3, kh = w >> 2;
    int kst = 16 * qt - 8; kst = kst < 0 ? 0 : (kst > 32 ? 32 : kst);
    const int nU = 1024 + ((layer == DEPTH - 1) ? 0 : 128);
    for (int un = vb; un < nU; un += nvb) {
        const bool lat = un < 1024;
        int b, r, h, qblk;
        if (lat) { b = un >> 7; r = (un >> 2) & 31; h = un & 3; qblk = 0; } else { const int u2 = un - 1024; b = u2 >> 4; h = (u2 >> 2) & 3; qblk = u2 & 3; r = 0; }
        int r0 = r - 4; r0 = r0 < 0 ? 0 : (r0 > 24 ? 24 : r0);
        const int qtok = lat ? b * SEQ + r * 64 + 16 * qt + c : ML + b * CTXL + qblk * 64 + 16 * qt + c;
        __syncthreads();
        {
            const int nch = (lat ? 768 : 256) * 8;
            for (int ch = tid; ch < nch; ch += NTHREADS) { const int row = ch >> 3, pc = ch & 7;
                const int tok = lat ? (row < 512 ? b * SEQ + (r0 + (row >> 6)) * 64 + (row & 63) : ML + b * CTXL + row - 512) : ML + b * CTXL + row;
                *(LAS u32x4*)(Vs + row * VROW + pc * 16) = *(const u32x4*)(P1 + (size_t)tok * NP1 + 768 + h * 64 + pc * 8); }
            if (lat) { const float* rp = INP(I_RPB) + (size_t)(layer * 4 + h) * 465; for (int i = tid; i < 465; i += NTHREADS) Bs[i] = rp[i]; }
        }
        f16x8 qf[2];
#pragma unroll
        for (int ks = 0; ks < 2; ++ks) qf[ks] = *(const f16x8*)(P1 + (size_t)qtok * NP1 + 256 + h * 64 + 32 * ks + 8 * g);
        f32x4 st[16];
#pragma unroll
        for (int idx = 0; idx < 16; ++idx) {
            st[idx] = (f32x4){0.f, 0.f, 0.f, 0.f};
            if (idx >= 8 || lat) {
                int tok;
                if (idx < 8) tok = b * SEQ + (r0 + kh * 4 + (idx >> 1)) * 64 + kst + 16 * (idx & 1) + c;
                else tok = ML + b * CTXL + kh * 128 + 16 * (idx - 8) + c;
                const f16* kp = P1 + (size_t)tok * NP1 + 512 + h * 64 + 8 * g;
                const f16x8 k0 = *(const f16x8*)kp, k1 = *(const f16x8*)(kp + 32);
                st[idx] = __builtin_amdgcn_mfma_f32_16x16x32_f16(k0, qf[0], st[idx], 0, 0, 0);
                st[idx] = __builtin_amdgcn_mfma_f32_16x16x32_f16(k1, qf[1], st[idx], 0, 0, 0);
            }
        }
        __syncthreads();
        const int qc = 16 * qt + c; int cs = qc - 8; cs = cs < 0 ? 0 : (cs > 48 ? 48 : cs);
        float mx = -3.0e38f;
#pragma unroll
        for (int idx = 0; idx < 16; ++idx) {
            if (idx < 8) {
                const int wrow = kh * 4 + (idx >> 1);
#pragma unroll
                for (int i = 0; i < 4; ++i) { const int kc = kst + 16 * (idx & 1) + 4 * g + i; const bool ok = lat && kc >= cs && kc < cs + 16;
                    const float bias = ok ? Bs[(r0 + wrow - r + 7) * 31 + kc - qc + 15] : 0.f;
                    st[idx][i] = ok ? st[idx][i] + bias : -1.0e30f; }
            }
#pragma unroll
            for (int i = 0; i < 4; ++i) mx = fmaxf(mx, st[idx][i]);
        }
        mx = fmaxf(mx, __shfl_xor(mx, 16)); mx = fmaxf(mx, __shfl_xor(mx, 32));
        float l = 0.f;
        f16x8 pf[8];
#pragma unroll
        for (int idx = 0; idx < 16; ++idx) {
#pragma unroll
            for (int i = 0; i < 4; ++i) { const float p = __expf(st[idx][i] - mx); l += p; pf[idx >> 1][4 * (idx & 1) + i] = (f16)p; }
        }
        l += __shfl_xor(l, 16); l += __shfl_xor(l, 32);
        f32x4 o[4];
#pragma unroll
        for (int dt = 0; dt < 4; ++dt) o[dt] = (f32x4){0.f, 0.f, 0.f, 0.f};
        const unsigned vs_base = (unsigned)(size_t)Vs;
#pragma unroll
        for (int kk = 0; kk < 8; ++kk) {
            if (kk >= 4 || lat) {
                int rb0, rb1;
                if (kk < 4) { rb0 = (kh * 4 + kk) * 64 + kst; rb1 = rb0 + 16; }
                else { rb0 = (lat ? 512 : 0) + kh * 128 + 16 * (2 * kk - 8); rb1 = rb0 + 16; }
                { f16x4 x0, x1, x2, x3, y0, y1, y2, y3;
                  const unsigned a0 = vs_base + (rb0 + 4 * g + cq) * VROW + (4 * cp) * 2, a1 = vs_base + (rb1 + 4 * g + cq) * VROW + (4 * cp) * 2;
                  asm volatile("ds_read_b64_tr_b16 %0, %8\n\tds_read_b64_tr_b16 %1, %8 offset:32\n\tds_read_b64_tr_b16 %2, %8 offset:64\n\tds_read_b64_tr_b16 %3, %8 offset:96\n\t"
                               "ds_read_b64_tr_b16 %4, %9\n\tds_read_b64_tr_b16 %5, %9 offset:32\n\tds_read_b64_tr_b16 %6, %9 offset:64\n\tds_read_b64_tr_b16 %7, %9 offset:96\n\ts_waitcnt lgkmcnt(0)"
                               : "=&v"(x0), "=&v"(x1), "=&v"(x2), "=&v"(x3), "=&v"(y0), "=&v"(y1), "=&v"(y2), "=&v"(y3) : "v"(a0), "v"(a1) : "memory");
                  o[0] = __builtin_amdgcn_mfma_f32_16x16x32_f16(__builtin_shufflevector(x0, y0, 0, 1, 2, 3, 4, 5, 6, 7), pf[kk], o[0], 0, 0, 0);
                  o[1] = __builtin_amdgcn_mfma_f32_16x16x32_f16(__builtin_shufflevector(x1, y1, 0, 1, 2, 3, 4, 5, 6, 7), pf[kk], o[1], 0, 0, 0);
                  o[2] = __builtin_amdgcn_mfma_f32_16x16x32_f16(__builtin_shufflevector(x2, y2, 0, 1, 2, 3, 4, 5, 6, 7), pf[kk], o[2], 0, 0, 0);
                  o[3] = __builtin_amdgcn_mfma_f32_16x16x32_f16(__builtin_shufflevector(x3, y3, 0, 1, 2, 3, 4, 5, 6, 7), pf[kk], o[3], 0, 0, 0); }
            }
        }
        LAS float* mp = Ms + (qt * 64 + lane) * 18;
        if (kh == 1) { mp[0] = mx; mp[1] = l;
#pragma unroll
            for (int dt = 0; dt < 4; ++dt) *(LAS f32x4*)(mp + 2 + 4 * dt) = o[dt]; }
        __syncthreads();
        if (kh == 0) {
            const float mx2 = mp[0], l2 = mp[1], mxn = fmaxf(mx, mx2), fa = __expf(mx - mxn), fb = __expf(mx2 - mxn);
            const float inv = 1.f / (l * fa + l2 * fb);
            f16* op = CAT + (size_t)qtok * D + 256 + h * 64 + 4 * g;
#pragma unroll
            for (int dt = 0; dt < 4; ++dt) { const f32x4 o2 = *(const LAS f32x4*)(mp + 2 + 4 * dt); const f32x4 v = (o[dt] * fa + o2 * fb) * inv;
                f16x4 hv; hv[0] = (f16)v[0]; hv[1] = (f16)v[1]; hv[2] = (f16)v[2]; hv[3] = (f16)v[3];
                *(f16x4*)(op + 16 * dt) = hv; }
        }
    }
    __syncthreads();
}

__device__ __forceinline__ void mout_phase(unsigned char* ws, LAS unsigned char* lds, int layer, int gw, int ngw, int lane) {
    const f16* P1 = (const f16*)(ws + WS_P1);
    const float* HFB = (const float*)(ws + WS_HFB);
    f16* CAT = (f16*)(ws + WS_CAT);
    const float* nw = INP(I_NORMW) + layer * 512;
    const int nrows = (layer == DEPTH - 1) ? ML : MT;
    const f32x4 nw0 = *(const f32x4*)(nw + 8 * lane), nw1 = *(const f32x4*)(nw + 8 * lane + 4);
    f32x4 a0n, a1n, b0n, b1n; f16x8 ogn;
#define MOUT_LOAD(r_) do { const float* pf = HFB + (size_t)(r_) * 512 + 8 * lane; const float* pb = HFB + ((size_t)MT + (r_)) * 512 + 8 * lane; \
        a0n = *(const f32x4*)pf; a1n = *(const f32x4*)(pf + 4); b0n = *(const f32x4*)pb; b1n = *(const f32x4*)(pb + 4); ogn = *(const f16x8*)(P1 + (size_t)(r_) * NP1 + 2560 + 8 * lane); } while (0)
    if (gw < nrows) MOUT_LOAD(gw);
    for (int r = gw; r < nrows; r += ngw) {
        const f32x4 a0 = a0n, a1 = a1n, b0 = b0n, b1 = b1n; const f16x8 og = ogn;
        if (r + ngw < nrows) MOUT_LOAD(r + ngw);
        float v[8] = {a0[0] + b0[0], a0[1] + b0[1], a0[2] + b0[2], a0[3] + b0[3], a1[0] + b1[0], a1[1] + b1[1], a1[2] + b1[2], a1[3] + b1[3]};
        float s = 0.f;
#pragma unroll
        for (int i = 0; i < 8; ++i) s += v[i];
        s = row16_sum(s);
        const float mean = s * (1.f / 128.f); float q = 0.f;
#pragma unroll
        for (int i = 0; i < 8; ++i) { v[i] -= mean; q += v[i] * v[i]; }
        q = row16_sum(q);
        const float rstd = 1.f / sqrtf(q * (1.f / 128.f) + LN_EPS);
        f16x8 h;
#pragma unroll
        for (int i = 0; i < 8; ++i) h[i] = (f16)((float)og[i] * v[i] * rstd * (i < 4 ? nw0[i] : nw1[i - 4]));
        *(f16x8*)(CAT + (size_t)r * D + 512 + 8 * lane) = h;
    }
#undef MOUT_LOAD
}

__device__ __forceinline__ void moe_tail(int nblk, int& tail_blocks, int& S) {
    const int R = (nblk & 63) * 4;
    tail_blocks = nblk & 63; S = R == 0 ? 1 : (R <= 36 ? 7 : (R <= 64 ? 4 : (R <= 128 ? 2 : 1)));
    if (S == 1) tail_blocks = 0;
}
constexpr int NPH = 13;
#if MK_FUSED
#define GRID_BAR() xcd_barrier(bar)
#else
#define GRID_BAR() do {} while (0)
#endif
template <int layer>
__device__ __forceinline__ void layer_body(const Args& args, LAS unsigned char* lds, const int tid0, const int wave0, const int vb0, const int nvb0,
                                           unsigned char* ws0, unsigned* ctl, const XcdBarrier& bar, const int s_lo, const int s_hi) {
        constexpr bool last = (layer == DEPTH - 1), moe = (layer & 1) != 0;
        constexpr int mi = layer >> 1;
        const int nrows = last ? ML : MT;
#define STEP(p) (layer * NPH + (p))
#if MK_FUSED
#define RUN(p) (((PH_MASK >> (p)) & 1) != 0)
#else
#define RUN(p) (((PH_MASK >> (p)) & 1) && STEP(p) >= s_lo && STEP(p) < s_hi)
#endif
#define NREP(p) (((p) == PROBE_PH && (PROBE_LAYER < 0 || layer == PROBE_LAYER)) ? 1 + PROBE_REP : 1)
#define FRESH_TID() int tid = tid0; asm volatile("" : "+v"(tid)); const int lane = tid & 63; (void)lane; \
    const unsigned long long wsi_ = opaque_u64((unsigned long long)ws0); unsigned char* ws = (unsigned char*)(__attribute__((address_space(1))) unsigned char*)wsi_; const int wave = opaque_u32(wave0), vb = opaque_u32(vb0), nvb = opaque_u32(nvb0); const int gw = vb * NWAVES + wave, ngw = nvb * NWAVES; (void)gw; (void)ngw; \
    f16* U16 = (f16*)(ws + WS_U16); f16* P1 = (f16*)(ws + WS_P1); f16* CAT = (f16*)(ws + WS_CAT); f16* Z16 = (f16*)(ws + WS_Z16); \
    f16* YF = (f16*)(ws + WS_YF); f16* XS = (f16*)(ws + WS_XS); f16* HB16 = (f16*)(ws + WS_P1); f16* AMOE = (f16*)(ws + WS_HFB); unsigned char* W = ws + WS_W; \
    int2* TOKE = (int2*)(ws + WS_TOK + TK_E); float2* TOKP = (float2*)(ws + WS_TOK + TK_P); int2* TOKPOS = (int2*)(ws + WS_TOK + TK_POS); int2* TOKDEST = (int2*)(ws + WS_TOK + TK_DEST); \
    int* BLKE = (int*)(ws + WS_TOK + TK_BLKE); \
    (void)U16; (void)P1; (void)CAT; (void)Z16; (void)YF; (void)XS; (void)HB16; (void)AMOE; (void)W; (void)TOKE; (void)TOKP; (void)TOKPOS; (void)TOKDEST; (void)BLKE
#if MK_FUSED
#define SEAM(p) do { if (!(last && (p) == NPH - 1)) GRID_BAR(); } while (0)
#else
#define SEAM(p) do { } while (0)
#endif

        if (layer == 0 && RUN(0)) { for (int rep_ = 0; rep_ < NREP(0); ++rep_) {
            FRESH_TID();
            {
                LAS float* sv = (LAS float*)(lds + 69632);
                LAS float* red = sv + 9 * 1024;
                for (int i = tid; i < 9 * 1024; i += NTHREADS) { const int r = i >> 10, k = i & 1023; const float c = r < 8 ? INP(I_C)[r * 1024 + k] : INP(I_CCTX)[k]; sv[i] = silu_(c); }
                __syncthreads();
                const int kg = tid >> 7, jj = tid & 127;
                for (int job = vb; job < 4 * 48; job += nvb) {
                    const int l = job / 48, j = (job % 48) * 128 + jj;
                    const float* wp = INP(I_WMOD) + (size_t)l * D * 6144 + j;
                    float acc[9];
#pragma unroll
                    for (int r = 0; r < 9; ++r) acc[r] = 0.f;
                    for (int k = kg * 256; k < kg * 256 + 256; ++k) { const float w = wp[(size_t)k * 6144];
#pragma unroll
                        for (int r = 0; r < 9; ++r) acc[r] += sv[r * 1024 + k] * w; }
#pragma unroll
                    for (int r = 0; r < 9; ++r) red[(kg * 9 + r) * 128 + jj] = acc[r];
                    __syncthreads();
                    for (int i = tid; i < 9 * 128; i += NTHREADS) { const int r = i >> 7, c = i & 127;
                        const float s = (red[(0 * 9 + r) * 128 + c] + red[(1 * 9 + r) * 128 + c]) + (red[(2 * 9 + r) * 128 + c] + red[(3 * 9 + r) * 128 + c]);
                        const int jc = (job % 48) * 128 + c;
                        ((float*)(ws + WS_MOD))[(size_t)(l * 9 + r) * 6144 + jc] = s + INP(I_BMOD)[l * 6144 + jc]; }
                    __syncthreads();
                }
            }
            if (vb == 0) for (int i = tid; i < 2048; i += NTHREADS) { const int p = i >> 5, fi = i & 31; const float inv = exp2f(-(float)fi * (13.287712379549449f / 32.f));
                float sn, cs; sincosf((float)p * inv, &sn, &cs); ((float2*)(ws + WS_ROPE))[i] = make_float2(cs, sn); }
            conv_layer(ws, 0, lds, gw, ngw, wave, lane, 0);
            SEAM(0);
        } }
        if (layer == 0 && RUN(1)) { for (int rep_ = 0; rep_ < NREP(1); ++rep_) {
            FRESH_TID();
            LAS float* GT = (LAS float*)(lds + 73728);
            load_gate_table(lds, 0, GT, tid);
            { f32x4 xn[4], shn[4], scn[4];
#define LOAD_MOD0(r_) do { const float* q_ = mod_row(ws, lds, 0, (r_)); _Pragma("unroll") for (int j = 0; j < 4; ++j) { shn[j] = *(const f32x4*)(q_ + 256 * j + 4 * lane); scn[j] = *(const f32x4*)(q_ + 1024 + 256 * j + 4 * lane); } } while (0)
              if (gw < MT) { load_x<0>(ws, lds, gw, xn, lane); LOAD_MOD0(gw); }
              for (int r = gw; r < MT; r += ngw) { f32x4 x[4], sh[4], sc[4];
#pragma unroll
                  for (int j = 0; j < 4; ++j) { x[j] = xn[j]; sh[j] = shn[j]; sc[j] = scn[j]; }
                  if (r + ngw < MT) { load_x<0>(ws, lds, r + ngw, xn, lane); LOAD_MOD0(r + ngw); }
                  row_A_pre(ws, r, x, sh, sc, GT, lane); } }
            SEAM(1);
        } }
        if (RUN(2)) { for (int rep_ = 0; rep_ < NREP(2); ++rep_) {
            FRESH_TID();
            EpiP1 E{P1};
            gemm_run(lds, U16, D, D, MT, NP1, (const f16*)(W + WO_IN), 0, nullptr, E, vb, nvb, tid);
            SEAM(2);
        } }
        if (RUN(3)) { for (int rep_ = 0; rep_ < NREP(3); ++rep_) {
            FRESH_TID();
            pool_phase(ws, layer, lds, vb, nvb, tid);
#if USE_NA_MFMA
            na_mfma_phase(ws, layer, lds, vb, nvb, tid);
#else
            na_phase(ws, layer, lds, gw, ngw, wave, lane);
#endif
            mlprep_phase(ws, lds, layer, gw, ngw, lane);
            SEAM(3);
        } }
#if USE_MLSTM_MFMA
        if (RUN(4)) { for (int rep_ = 0; rep_ < NREP(4); ++rep_) { FRESH_TID(); ConvSeg cs; conv_seg(layer, nvb, cs.LA, cs.a0, cs.an, cs.LB, cs.b0, cs.bn); mlstm_mfma_phase(ws, layer, lds, vb, nvb, tid, cs); SEAM(4); } }
#else
        if (RUN(4)) { for (int rep_ = 0; rep_ < NREP(4); ++rep_) { FRESH_TID(); mlstm_naive_phase(ws, layer, lds, vb, nvb, tid); SEAM(4); } }
#endif
        if (RUN(5)) { for (int rep_ = 0; rep_ < NREP(5); ++rep_) { FRESH_TID(); mout_phase(ws, lds, layer, gw, ngw, lane); SEAM(5); } }
        if (RUN(6)) { for (int rep_ = 0; rep_ < NREP(6); ++rep_) {
            FRESH_TID();
            { EpiMerge E{P1, Z16, (float*)(ws + WS_YF + YF_PART)}; gemm_run(lds, CAT, D, D, nrows, D, (const f16*)(W + WO_BP), 0, nullptr, E, vb, nvb, tid, last ? 0 : MC, 4); }
            SEAM(6);
        } }
        if (RUN(7)) { for (int rep_ = 0; rep_ < NREP(7); ++rep_) {
            FRESH_TID();
            if constexpr (!last) {
                const float* PZ = (const float*)(ws + WS_YF + YF_PART);
                for (int r = gw; r < MC; r += ngw) { f32x4 z[4]; load_row_sum(PZ + (size_t)r * D, (size_t)MC * D, 4, z, lane); store_row_h(Z16 + (size_t)(ML + r) * D, z, lane); }
                GRID_BAR();
            }
            EpiF32 E{YF, D, (float*)(ws + WS_YF + YF_PART), ML, MC};
            gemm_run(lds, Z16, D, D, nrows, D, (const f16*)(W + WO_OUT), 0, nullptr, E, vb, nvb, tid, last ? 0 : MC, 4);
            SEAM(7);
        } }
        if (RUN(8)) { for (int rep_ = 0; rep_ < NREP(8); ++rep_) {
            FRESH_TID();
            LAS float* RT = (LAS float*)lds;
            LAS int* lcnt = (LAS int*)(lds + 32768);
            LAS int* lrec = lcnt + 128;
            if (moe) { load_router_table(lds, mi, RT, tid); if (tid < 128) lcnt[tid] = 0; __syncthreads(); }
            const float* g1p = INP(I_LN1G) + layer * D; const float* b1p = INP(I_LN1B) + layer * D;
            int slot = wave;
            f32x4 xn[4], yn[4];
            const float* PARTp = (const float*)(ws + WS_YF + YF_PART);
#define LOAD_Y(r_, dst_) do { if ((r_) >= ML) load_row_sum(PARTp + (size_t)((r_) - ML) * D, (size_t)MC * D, 4, dst_, lane); else load_row_h(YF + (size_t)(r_) * D, dst_, lane); } while (0)
            f32x4 lg_[4], lb_[4], mgn[4], mshn[4], mscn[4];
#pragma unroll
            for (int j = 0; j < 4; ++j) { lg_[j] = *(const f32x4*)(g1p + 256 * j + 4 * lane); lb_[j] = *(const f32x4*)(b1p + 256 * j + 4 * lane); }
#define LOAD_MOD(r_) do { const float* m_ = mod_row(ws, lds, layer, (r_)); _Pragma("unroll") for (int j = 0; j < 4; ++j) { mgn[j] = *(const f32x4*)(m_ + 2048 + 256 * j + 4 * lane); mshn[j] = *(const f32x4*)(m_ + 3072 + 256 * j + 4 * lane); mscn[j] = *(const f32x4*)(m_ + 4096 + 256 * j + 4 * lane); } } while (0)
            if (gw < nrows) { load_x<layer>(ws, lds, gw, xn, lane); LOAD_Y(gw, yn); LOAD_MOD(gw); }
            for (int r = gw; r < nrows; r += ngw, slot += NWAVES) {
                f32x4 x[4], y[4], mg[4], msh[4], msc[4];
#pragma unroll
                for (int j = 0; j < 4; ++j) { x[j] = xn[j]; y[j] = yn[j]; mg[j] = mgn[j]; msh[j] = mshn[j]; msc[j] = mscn[j]; }
                if (r + ngw < nrows) { load_x<layer>(ws, lds, r + ngw, xn, lane); LOAD_Y(r + ngw, yn); LOAD_MOD(r + ngw); }
#pragma unroll
                for (int j = 0; j < 4; ++j) x[j] = x[j] * ALPHA + mg[j] * y[j];
                float mean, rstd; ln_stats(x, mean, rstd);
#pragma unroll
                for (int j = 0; j < 4; ++j) x[j] = (x[j] - mean) * rstd * lg_[j] + lb_[j];
                store_row_h(XS + (size_t)r * D, x, lane);
                ln_stats(x, mean, rstd);
                f32x4 u[4];
#pragma unroll
                for (int j = 0; j < 4; ++j) { const int k = 256 * j + 4 * lane; u[j] = (x[j] - mean) * rstd * (msc[j] + 1.f) + msh[j];
                    f16x4 h; h[0] = (f16)u[j][0]; h[1] = (f16)u[j][1]; h[2] = (f16)u[j][2]; h[3] = (f16)u[j][3];
                    *(f16x4*)(U16 + (size_t)r * D + k) = h; }
                if (moe) {
                    float lg[8];
                    { const float s0 = dot4_rows(u, RT, 0, lane), s1 = dot4_rows(u, RT, 4, lane);
#pragma unroll
                      for (int e = 0; e < 4; ++e) { lg[e] = __shfl(s0, 16 * e) + INP(I_RB)[mi * 8 + e]; lg[4 + e] = __shfl(s1, 16 * e) + INP(I_RB)[mi * 8 + 4 + e]; } }
                    int e1 = 0; float l1 = lg[0];
#pragma unroll
                    for (int e = 1; e < 8; ++e) if (lg[e] > l1) { l1 = lg[e]; e1 = e; }
                    int e2 = -1; float l2 = -3.0e38f;
#pragma unroll
                    for (int e = 0; e < 8; ++e) if (e != e1 && lg[e] > l2) { l2 = lg[e]; e2 = e; }
                    const float p2 = __expf(l2 - l1), inv = 1.f / (1.f + p2);
                    if (lane == 0) { const int lp1 = lcnt[wave * 8 + e1], lp2 = lcnt[wave * 8 + e2]; lcnt[wave * 8 + e1] = lp1 + 1; lcnt[wave * 8 + e2] = lp2 + 1;
                        lrec[slot * 4 + 0] = e1; lrec[slot * 4 + 1] = e2; lrec[slot * 4 + 2] = lp1; lrec[slot * 4 + 3] = lp2;
                        TOKE[r] = make_int2(e1, e2); TOKP[r] = make_float2(inv, p2 * inv); }
                }
            }
            if (moe) {
                __syncthreads();
                if (tid < 64) { const int w_ = tid >> 3, e_ = tid & 7; int b_ = 0; for (int q = 0; q < w_; ++q) b_ += lcnt[q * 8 + e_]; lcnt[64 + tid] = b_;
                    if (w_ == 7) ((int*)(ws + WS_TOK + TK_BCNT))[vb * 8 + e_] = b_ + lcnt[56 + e_]; }
                __syncthreads();
                slot = wave;
                for (int r = gw; r < nrows; r += ngw, slot += NWAVES)
                    if (lane == 0) TOKPOS[r] = make_int2(lcnt[64 + wave * 8 + lrec[slot * 4 + 0]] + lrec[slot * 4 + 2], lcnt[64 + wave * 8 + lrec[slot * 4 + 1]] + lrec[slot * 4 + 3]);
            }
            SEAM(8);
        } }
        if (moe && RUN(9)) { for (int rep_ = 0; rep_ < NREP(9); ++rep_) {
            FRESH_TID();
            LAS int* ps = (LAS int*)lds;
            LAS int* bc = ps + 16;
            { const int* BC = (const int*)(ws + WS_TOK + TK_BCNT); for (int i = tid; i < nvb * 8; i += NTHREADS) bc[i] = BC[i]; }
            __syncthreads();
            if (tid < 8) { int tot = 0, mine = 0; for (int q = 0; q < nvb; ++q) { const int c = bc[q * 8 + tid]; mine += (q < vb) ? c : 0; tot += c; } bc[nvb * 8 + tid] = tot; bc[nvb * 8 + 8 + tid] = mine; }
            __syncthreads();
            if (tid == 0) { int acc = 0;
#pragma unroll 1
                for (int e = 0; e < 8; ++e) { ps[e] = acc + bc[nvb * 8 + 8 + e]; const int c = bc[nvb * 8 + e]; acc += ((c + 255) >> 8) * 256; }
                ps[8] = acc; }
            __syncthreads();
            if (vb == 0) { const int nb = ps[8] >> 8; if (tid == 0) BLKE[160] = nb;
                if (tid < nb) { int e = 0;
#pragma unroll 1
                    for (int q = 1; q < 8; ++q) if (tid * 256 >= ps[q]) e = q;
                    BLKE[tid] = e; } }
            { int2 en = make_int2(0, 0), pnx = make_int2(0, 0); u32x4 vn0, vn1;
#define GATHER_LOAD(r_) do { en = TOKE[(r_)]; pnx = TOKPOS[(r_)]; const u32x4* src_ = (const u32x4*)(U16 + (size_t)(r_) * D); vn0 = src_[lane]; vn1 = src_[lane + 64]; } while (0)
              if (gw < nrows) GATHER_LOAD(gw);
              for (int r = gw; r < nrows; r += ngw) {
                const int2 e = en, p = pnx; const u32x4 v0 = vn0, v1 = vn1;
                if (r + ngw < nrows) GATHER_LOAD(r + ngw);
                const int d0 = ps[e.x] + p.x, d1 = ps[e.y] + p.y;
                u32x4* o0 = (u32x4*)(AMOE + (size_t)d0 * D); u32x4* o1 = (u32x4*)(AMOE + (size_t)d1 * D);
                o0[lane] = v0; o0[lane + 64] = v1; o1[lane] = v0; o1[lane + 64] = v1;
                if (lane == 0) TOKDEST[r] = make_int2(d0, d1);
              }
#undef GATHER_LOAD
            }
            SEAM(9);
        } }
        if (RUN(10)) { for (int rep_ = 0; rep_ < NREP(10); ++rep_) {
            FRESH_TID();
            EpiSwiGLU E{HB16};
            const int nr = moe ? __builtin_amdgcn_readfirstlane(BLKE[160]) * 256 : nrows;
            gemm_run(lds, moe ? AMOE : U16, D, D, nr, NFF2, (const f16*)(W + (moe ? WO_13 : WO_13D)), (size_t)NFF2 * D, moe ? BLKE : nullptr, E, vb, nvb, tid);
            SEAM(10);
        } }
        if (RUN(11)) { for (int rep_ = 0; rep_ < NREP(11); ++rep_) {
            FRESH_TID();
            if (moe) {
                const int nblk = __builtin_amdgcn_readfirstlane(BLKE[160]); int tb, S; moe_tail(nblk, tb, S);
                EpiF32 E{YF, D, (float*)(ws + WS_HFB), (nblk - tb) * 256, tb * 256};
                gemm_run(lds, HB16, DFF, DFF, nblk * 256, D, (const f16*)(W + WO_2), (size_t)D * DFF, BLKE, E, vb, nvb, tid, tb * 256, S);
            } else {
                EpiF32 E{YF, D, (float*)(ws + WS_YF + YF_PART), ML, MC};
                gemm_run(lds, HB16, DFF, DFF, nrows, D, (const f16*)(W + WO_2D), (size_t)D * DFF, nullptr, E, vb, nvb, tid, last ? 0 : MC, 7);
            }
            SEAM(11);
        } }
        if (RUN(12)) { for (int rep_ = 0; rep_ < NREP(12); ++rep_) {
            FRESH_TID();
            LAS float* GT = (LAS float*)(lds + 73728);
            if (!last) load_gate_table(lds, layer + 1, GT, tid);
            const float* g2p = INP(I_LN2G) + layer * D; const float* b2p = INP(I_LN2B) + layer * D;
            const float* PARTp = (const float*)(ws + WS_YF + YF_PART);
#define LOAD_F(r_, dst_) do { if ((r_) >= ML) load_row_sum(PARTp + (size_t)((r_) - ML) * D, (size_t)MC * D, 7, dst_, lane); else load_row_h(YF + (size_t)(r_) * D, dst_, lane); } while (0)
            int m_split = 1 << 30, m_S = 1, m_trows = 0;
            if (moe) { const int nblk = __builtin_amdgcn_readfirstlane(BLKE[160]); int tb; moe_tail(nblk, tb, m_S); if (tb) { m_split = (nblk - tb) * 256; m_trows = tb * 256; } }
            const float* MPART = (const float*)(ws + WS_HFB);
#define LOAD_YB(d_, dst_) do { if ((d_) >= m_split) load_row_sum(MPART + (size_t)((d_) - m_split) * D, (size_t)m_trows * D, m_S, dst_, lane); else load_row_h(YF + (size_t)(d_) * D, dst_, lane); } while (0)
            f32x4 xn[4], fn0[4], fn1[4]; float2 pn = make_float2(0.f, 0.f); int2 dnn = make_int2(0, 0);
            f32x4 mgn[4];
#define LOAD_MOD2(r_) do { const float* m_ = mod_row(ws, lds, layer, (r_)); _Pragma("unroll") for (int j = 0; j < 4; ++j) mgn[j] = *(const f32x4*)(m_ + 5120 + 256 * j + 4 * lane); } while (0)
            if (gw < nrows) LOAD_MOD2(gw);
            if (gw < nrows) { load_row_h(XS + (size_t)gw * D, xn, lane);
                if (moe) { const int2 d = TOKDEST[gw]; pn = TOKP[gw]; LOAD_YB(d.x, fn0); LOAD_YB(d.y, fn1); if (gw + ngw < nrows) dnn = TOKDEST[gw + ngw]; }
                else LOAD_F(gw, fn0); }
            for (int r = gw; r < nrows; r += ngw) {
                f32x4 x[4], f[4], mg[4], msh[4], msc[4], lg_[4], lb_[4];
#pragma unroll
                for (int j = 0; j < 4; ++j) { x[j] = xn[j]; f[j] = moe ? fn0[j] * pn.x + fn1[j] * pn.y : fn0[j]; mg[j] = mgn[j]; }
                { const float* q_ = mod_row(ws, lds, last ? layer : layer + 1, r);
#pragma unroll
                  for (int j = 0; j < 4; ++j) { lg_[j] = *(const f32x4*)(g2p + 256 * j + 4 * lane); lb_[j] = *(const f32x4*)(b2p + 256 * j + 4 * lane); msh[j] = *(const f32x4*)(q_ + 256 * j + 4 * lane); msc[j] = *(const f32x4*)(q_ + 1024 + 256 * j + 4 * lane); } }
                if (r + ngw < nrows) { const int rn = r + ngw; LOAD_MOD2(rn); load_row_h(XS + (size_t)rn * D, xn, lane);
                    if (moe) { const int2 d = dnn; pn = TOKP[rn]; LOAD_YB(d.x, fn0); LOAD_YB(d.y, fn1); if (rn + ngw < nrows) dnn = TOKDEST[rn + ngw]; }
                    else LOAD_F(rn, fn0); }
#pragma unroll
                for (int j = 0; j < 4; ++j) x[j] = x[j] * ALPHA + mg[j] * f[j];
                float mean, rstd; ln_stats(x, mean, rstd);
#pragma unroll
                for (int j = 0; j < 4; ++j) { const int k = 256 * j + 4 * lane; x[j] = (x[j] - mean) * rstd * lg_[j] + lb_[j];
                    if (last) *(f32x4*)(args.out + (size_t)r * D + k) = x[j]; }
                if (!last) store_row_h(XS + (size_t)r * D, x, lane);
                if (!last) row_A_pre(ws, r, x, msh, msc, GT, lane);
            }
            if (!last) { __syncthreads(); conv_layer(ws, layer + 1, lds, gw, ngw, wave, lane, ffn_dma_items(layer + 1, nvb)); }
            SEAM(12);
        } }
#undef STEP
#undef RUN
#undef SEAM
}
__global__ void __launch_bounds__(NTHREADS, 2) mega(Args args) {
    extern __shared__ __attribute__((aligned(16))) unsigned char lds_raw[];
    LAS unsigned char* lds = (LAS unsigned char*)lds_raw;
    const int tid0 = threadIdx.x, wave0 = __builtin_amdgcn_readfirstlane(tid0 >> 6);
    const int vb0 = blockIdx.x, nvb0 = gridDim.x;
    unsigned char* ws0 = args.ws;
    unsigned* ctl = (unsigned*)(ws0 + WS_CTL);
    volatile LAS unsigned* MISC = (volatile LAS unsigned*)(lds + TAIL_OFF);
    if (tid0 < 64) MISC[tid0] = 0u;
    if (tid0 < 29) *(LAS unsigned long long*)(lds + PTAB_OFF + 8 * tid0) = (unsigned long long)args.in[tid0];
    __syncthreads();
#if MK_FUSED
    XcdBarrier bar = xcd_barrier_post(ctl + CW_BAR, MISC + 8);
#else
    XcdBarrier bar; bar.bar = ctl + CW_BAR; bar.x = 0; bar.st = MISC + 8;
#endif
    const int s_lo = args.s_lo, s_hi = args.s_hi; (void)s_lo; (void)s_hi;

    layer_body<0>(args, lds, tid0, wave0, vb0, nvb0, ws0, ctl, bar, s_lo, s_hi);
    layer_body<1>(args, lds, tid0, wave0, vb0, nvb0, ws0, ctl, bar, s_lo, s_hi);
    layer_body<2>(args, lds, tid0, wave0, vb0, nvb0, ws0, ctl, bar, s_lo, s_hi);
    layer_body<3>(args, lds, tid0, wave0, vb0, nvb0, ws0, ctl, bar, s_lo, s_hi);
}

static bool step_applicable(int layer, int p) {
    if (p == 0 || p == 1) return layer == 0;
    if (p == 9) return (layer & 1) != 0;
    return true;
}
extern "C" void kernel_launch(void* const* d_in, const int* in_sizes, int n_in, void* d_out, int out_size, void* d_ws, size_t ws_size, hipStream_t stream) {
    static int grid = 0;
    if (grid == 0) {
        if (n_in != 29 || out_size != ML * D || ws_size < WS_END) { fprintf(stderr, "kernel_launch: unexpected sizes (n_in %d out %d ws %zu need %zu)\n", n_in, out_size, ws_size, (size_t)WS_END); grid = -1; return; }
        int dev = 0, cus = 0, per_cu = 0;
        hipGetDevice(&dev); hipDeviceGetAttribute(&cus, hipDeviceAttributeMultiprocessorCount, dev);
        if (hipFuncSetAttribute((const void*)mega, hipFuncAttributeMaxDynamicSharedMemorySize, LDS_BYTES) != hipSuccess) { fprintf(stderr, "kernel_launch: hipFuncSetAttribute failed\n"); grid = -1; return; }
        if (hipOccupancyMaxActiveBlocksPerMultiprocessor(&per_cu, (const void*)mega, NTHREADS, LDS_BYTES) != hipSuccess || per_cu < 1) { fprintf(stderr, "kernel_launch: occupancy query says %d\n", per_cu); }
        (void)hipGetLastError();
        grid = cus > 0 ? cus : 256;
    }
    if (grid < 0) return;
    hipMemsetAsync((char*)d_ws + WS_CTL, 0, CTL_ZERO_BYTES, stream);
    Args a{};
    for (int i = 0; i < 29; ++i) a.in[i] = (const float*)d_in[i];
    a.out = (float*)d_out; a.ws = (unsigned char*)d_ws;
#if MK_FUSED
    a.s_lo = 0; a.s_hi = DEPTH * NPH;
    hipLaunchKernelGGL(mega, dim3(grid), dim3(NTHREADS), LDS_BYTES, stream, a);
#else
    for (int layer = 0; layer < DEPTH; ++layer)
        for (int p = 0; p < NPH; ++p) {
            if (!step_applicable(layer, p)) continue;
            a.s_lo = layer * NPH + p; a.s_hi = a.s_lo + 1;
            hipLaunchKernelGGL(mega, dim3(grid), dim3(NTHREADS), LDS_BYTES, stream, a);
        }
#endif
}
```

```cpp
#include <hip/hip_runtime.h>
#include <cstdio>
#include <cstdint>

#ifndef MK_FUSED
#define MK_FUSED 1
#endif
#ifndef USE_MLSTM_MFMA
#define USE_MLSTM_MFMA 1
#endif
#ifndef USE_NA_MFMA
#define USE_NA_MFMA 1
#endif
#ifndef PROBE_PH
#define PROBE_PH -1
#endif
#ifndef PROBE_LAYER
#define PROBE_LAYER -1
#endif
#ifndef PROBE_REP
#define PROBE_REP 0
#endif
#ifndef PH_MASK
#define PH_MASK 0xFFFF
#endif
#ifndef USE_MFMA
#define USE_MFMA 1
#endif

#define LAS __attribute__((address_space(3)))
typedef _Float16 f16;
typedef _Float16 f16x8 __attribute__((ext_vector_type(8)));
typedef _Float16 f16x4 __attribute__((ext_vector_type(4)));
typedef _Float16 f16x2 __attribute__((ext_vector_type(2)));
typedef float f32x4 __attribute__((ext_vector_type(4)));
typedef float f32x2 __attribute__((ext_vector_type(2)));
typedef unsigned u32x4 __attribute__((ext_vector_type(4)));
typedef unsigned u32x2 __attribute__((ext_vector_type(2)));

constexpr int D = 1024, NB = 8, SEQ = 2048, CTXL = 256, ML = NB * SEQ, MC = NB * CTXL, MT = ML + MC, DEPTH = 4;
constexpr int NIN = 6160, NP1 = 6144, DFF = 3584, NE = 8, NFF2 = 2 * DFF;
constexpr int MOE_MAXROWS = 38912;
constexpr float ALPHA = 1.6817928305074292f;
constexpr float LN_EPS = 1e-6f;
constexpr int NWAVES = 8, NTHREADS = 512;
constexpr int LDS_BYTES = 155648;

constexpr size_t MiB = 1u << 20;
constexpr size_t WS_CTL = 0, CTL_ZERO_BYTES = 1 * MiB;
constexpr size_t WS_MOD = 2 * MiB;
constexpr size_t WS_ROPE = 2 * MiB + 896 * 1024;
constexpr size_t WS_MLG = 3 * MiB;
constexpr size_t WS_TOK = 5 * MiB;
constexpr size_t WS_XS = 8 * MiB;
constexpr size_t WS_U16 = 80 * MiB;
constexpr size_t WS_P1 = 116 * MiB;
constexpr size_t WS_QK = 382 * MiB;
constexpr size_t WS_HFB = 418 * MiB;
constexpr size_t WS_CAT = 494 * MiB;
constexpr size_t WS_YF = 530 * MiB;
constexpr size_t YF_PART = 80 * MiB;
constexpr size_t WS_Z16 = 682 * MiB;
constexpr size_t WS_W = 718 * MiB;
constexpr size_t WO_IN = 0, WO_BP = 12 * MiB, WO_BN = WO_BP + MiB / 2, WO_BM = WO_BN + MiB / 2, WO_OUT = WO_BM + MiB, WO_13 = WO_OUT + 2 * MiB, WO_2 = WO_13 + 112 * MiB;
constexpr size_t WO_13D = 184 * MiB, WO_2D = WO_13D + 14 * MiB;
constexpr size_t WS_END = WS_W + 206 * MiB;
static_assert(WO_2 + 56 * MiB == 184 * MiB && WO_2D + 7 * MiB <= 206 * MiB, "weight map");
constexpr int CW_TMO = 0;
constexpr int CW_BAR = 4096;
constexpr int CW_MOECNT = 16384;
constexpr size_t TK_E = 0, TK_P = 160 * 1024, TK_POS = 320 * 1024, TK_DEST = 480 * 1024, TK_BLKE = 640 * 1024, TK_BCNT = 704 * 1024;

__device__ __forceinline__ float row16_sum(float v) {
    v += __builtin_bit_cast(float, __builtin_amdgcn_update_dpp(0, __builtin_bit_cast(int, v), 0xB1, 0xF, 0xF, true));
    v += __builtin_bit_cast(float, __builtin_amdgcn_update_dpp(0, __builtin_bit_cast(int, v), 0x4E, 0xF, 0xF, true));
    v += __builtin_bit_cast(float, __builtin_amdgcn_update_dpp(0, __builtin_bit_cast(int, v), 0x141, 0xF, 0xF, true));
    v += __builtin_bit_cast(float, __builtin_amdgcn_update_dpp(0, __builtin_bit_cast(int, v), 0x140, 0xF, 0xF, true));
    return v;
}
__device__ __forceinline__ float wave_sum(float v) {
    v = row16_sum(v);
    v += __shfl_xor(v, 16); v += __shfl_xor(v, 32);
    return v;
}
__device__ __forceinline__ float wave_max(float v) {
#pragma unroll
    for (int o = 1; o < 64; o <<= 1) v = fmaxf(v, __shfl_xor(v, o));
    return v;
}
__device__ __forceinline__ float sigmoid_(float x) { return __builtin_amdgcn_rcpf(1.f + __expf(-x)); }
__device__ __forceinline__ float silu_(float x) { return x * __builtin_amdgcn_rcpf(1.f + __expf(-x)); }
#define LDS_WAIT() asm volatile("s_waitcnt lgkmcnt(0)" ::: "memory")
#define VM_WAIT() asm volatile("s_waitcnt vmcnt(0)" ::: "memory")


__device__ __forceinline__ int opaque_u32(int x) { int t = x; asm volatile("" : "+v"(t)); return __builtin_amdgcn_readfirstlane(t); }
__device__ __forceinline__ unsigned long long opaque_u64(unsigned long long x) { unsigned lo = (unsigned)x, hi = (unsigned)(x >> 32); asm volatile("" : "+v"(lo), "+v"(hi));
    return ((unsigned long long)(unsigned)__builtin_amdgcn_readfirstlane(hi) << 32) | (unsigned)__builtin_amdgcn_readfirstlane(lo); }

#define XB_TMO      128
#define XB_XCNT(j)  (256  + 64 * (j))
#define XB_XSUB(j)  (1280 + 64 * (j))
#define XB_XGEN(j)  (2304 + 64 * (j))
#define XB_TOP      3328
#define XB_TOPGEN   3392
#define XCD_BAR_WORDS 3456
#define XB_SPIN_CAP (1u << 22)
__device__ __forceinline__ unsigned xb_ld(unsigned* p)              { return __hip_atomic_load(p, __ATOMIC_RELAXED, __HIP_MEMORY_SCOPE_AGENT); }
__device__ __forceinline__ unsigned xb_add(unsigned* p, unsigned v) { return __hip_atomic_fetch_add(p, v, __ATOMIC_RELAXED, __HIP_MEMORY_SCOPE_AGENT); }
__device__ __forceinline__ unsigned xb_xcc_id() { return (unsigned)__builtin_amdgcn_s_getreg((3 << 11) | 20) & 0xFu; }
#define XB_SPIN(cond, bar) do { unsigned _sp = 0; while (cond) { __builtin_amdgcn_s_sleep(1); \
    if ((++_sp & 255u) == 0u) { if (xb_ld(&(bar)[XB_TMO])) break; if (_sp > XB_SPIN_CAP) { atomicAdd(&(bar)[XB_TMO], 1u); break; } } } } while (0)
struct XcdBarrier { unsigned* bar; unsigned x; volatile LAS unsigned* st; };
__device__ __forceinline__ XcdBarrier xcd_barrier_post(unsigned* bar, volatile LAS unsigned* st) {
    XcdBarrier b; b.bar = bar; b.x = xb_xcc_id(); b.st = st;
    if (threadIdx.x == 0) (void)xb_add(&bar[XB_XCNT(b.x)], 1u);
    return b;
}
__device__ __forceinline__ void xcd_barrier_complete(unsigned* bar, unsigned x, unsigned& nloc, unsigned& nx) {
    const unsigned G = gridDim.x * gridDim.y * gridDim.z;
    unsigned sum, cnt, mine, sp = 0u;
    for (;;) {
        sum = 0u; cnt = 0u; mine = 0u;
#pragma unroll
        for (unsigned j = 0; j < 16; ++j) { const unsigned c = xb_ld(&bar[XB_XCNT(j)]); sum += c; cnt += (c > 0u) ? 1u : 0u; }
        mine = xb_ld(&bar[XB_XCNT(x)]);
        if (sum == G) break;
        __builtin_amdgcn_s_sleep(1);
        if ((++sp & 255u) == 0u) { if (xb_ld(&bar[XB_TMO])) break; if (sp > XB_SPIN_CAP) { atomicAdd(&bar[XB_TMO], 1u); break; } }
    }
    nloc = mine > 0u ? mine : 1u; nx = cnt > 0u ? cnt : 1u;
}
__device__ __forceinline__ void xcd_barrier(const XcdBarrier& b) {
    asm volatile("s_waitcnt vmcnt(0)" ::: "memory");
    __syncthreads();
    if (threadIdx.x == 0) {
        const unsigned long long bi_ = opaque_u64((unsigned long long)b.bar); unsigned* bar = (unsigned*)(__attribute__((address_space(1))) unsigned*)bi_;
        __builtin_amdgcn_s_waitcnt(0);
        unsigned nloc = b.st[0], nx = b.st[1];
        if (nloc == 0u) { xcd_barrier_complete(bar, b.x, nloc, nx); b.st[0] = nloc; b.st[1] = nx; }
        const unsigned old = xb_add(&bar[XB_XSUB(b.x)], 1u);
        const unsigned gen = old / nloc;
        if (old + 1u == (gen + 1u) * nloc) {
            __builtin_amdgcn_fence(__ATOMIC_RELEASE, "agent");
            asm volatile("s_waitcnt vmcnt(0)" ::: "memory");
            const unsigned og = xb_add(&bar[XB_TOP], 1u);
            const unsigned tg = og / nx;
            if (og + 1u == (tg + 1u) * nx) xb_add(&bar[XB_TOPGEN], 1u);
            else XB_SPIN(xb_ld(&bar[XB_TOPGEN]) == tg, bar);
            __builtin_amdgcn_fence(__ATOMIC_ACQUIRE, "agent");
            xb_add(&bar[XB_XGEN(b.x)], 1u);
            asm volatile("s_waitcnt vmcnt(0)" ::: "memory");
        } else {
            XB_SPIN(xb_ld(&bar[XB_XGEN(b.x)]) == gen, bar);
            __builtin_amdgcn_fence(__ATOMIC_ACQUIRE, "agent");
            asm volatile("s_waitcnt vmcnt(0)" ::: "memory");
        }
    }
    __syncthreads();
}

struct Args { const float* in[29]; float* out; unsigned char* ws; int s_lo, s_hi; };
enum { I_X = 0, I_C, I_CTX, I_CCTX, I_WMOD, I_BMOD, I_WIN, I_GBIAS, I_CONVW, I_NORMW, I_POOLW, I_POOLS, I_RPB, I_WBP, I_WBN, I_WBM, I_WOUT,
       I_LN1G, I_LN1B, I_LN2G, I_LN2B, I_FW1, I_FW3, I_FW2, I_RW, I_RB, I_MW1, I_MW3, I_MW2 };


constexpr int TAIL_OFF = LDS_BYTES - 1024, PTAB_OFF = TAIL_OFF + 256;
__device__ __forceinline__ const float* inp_ptr(LAS unsigned char* lds, int i) {
    const LAS unsigned* t = (const LAS unsigned*)(lds + PTAB_OFF);
    const unsigned lo = __builtin_amdgcn_readfirstlane(t[2 * i]), hi = __builtin_amdgcn_readfirstlane(t[2 * i + 1]);
    return (const float*)(const __attribute__((address_space(1))) float*)(((unsigned long long)hi << 32) | lo);
}
#define INP(i) inp_ptr(lds, (i))

__device__ __forceinline__ u32x4 pack8(const float (&v)[8]) {
    f16x8 h;
#pragma unroll
    for (int i = 0; i < 8; ++i) h[i] = (f16)v[i];
    return __builtin_bit_cast(u32x4, h);
}
struct EpiP1 {
    static constexpr bool MIDK = false;
    f16* P1;
    __device__ __forceinline__ void emit_part(int, int, int, const float (&)[8]) const {}
    __device__ __forceinline__ void emit8(int row, int col, const float (&v)[8]) const {
        const float s = (col >= 256 && col < 512) ? 0.125f : 1.f;
        float w[8];
        if (col >= 2560) {
#pragma unroll
            for (int i = 0; i < 8; ++i) w[i] = sigmoid_(v[i]);
        } else {
#pragma unroll
            for (int i = 0; i < 8; ++i) w[i] = v[i] * s;
        }
        *(u32x4*)(P1 + (size_t)row * NP1 + col) = pack8(w);
    }
};
struct EpiMerge {
    static constexpr bool MIDK = true;
    const f16* P1; f16* Z16; f16* PART;
    __device__ __forceinline__ void emit_part(int part, int row, int col, const float (&v)[8]) const {
        const int gi = part < 2 ? part : 2;
        const f16x8 g = *(const f16x8*)(P1 + (size_t)row * NP1 + 3072 + gi * 1024 + col);
        float w[8];
#pragma unroll
        for (int i = 0; i < 8; ++i) w[i] = v[i] * (gi == 0 ? (float)g[i] : fmaxf((float)g[i], 1e-4f));
        *(u32x4*)(PART + ((size_t)part * MC + (row - ML)) * D + col) = pack8(w);
    }
    __device__ __forceinline__ void mid8(int row, int col, float (&v)[8], int which) const {
        const f16* gp = P1 + (size_t)row * NP1 + 3072 + col;
        const f16x8 gnum = *(const f16x8*)(gp + (which == 0 ? 0 : 1024)), gden = *(const f16x8*)(gp + (which == 0 ? 1024 : 2048));
#pragma unroll
        for (int i = 0; i < 8; ++i) { const float num = which == 0 ? (float)gnum[i] : fmaxf((float)gnum[i], 1e-4f); v[i] *= num * __builtin_amdgcn_rcpf(fmaxf((float)gden[i], 1e-4f)); }
    }
    __device__ __forceinline__ void emit8(int row, int col, const float (&v)[8]) const {
        const f16x8 g = *(const f16x8*)(P1 + (size_t)row * NP1 + 3072 + 2048 + col);
        float w[8];
#pragma unroll
        for (int i = 0; i < 8; ++i) w[i] = v[i] * fmaxf((float)g[i], 1e-4f);
        *(u32x4*)(Z16 + (size_t)row * D + col) = pack8(w);
    }
};
struct EpiF32 {
    static constexpr bool MIDK = false;
    f16* C; int ldc; f16* PART; int prow0, prows;
    __device__ __forceinline__ void emit_part(int part, int row, int col, const float (&v)[8]) const {
        *(u32x4*)(PART + ((size_t)part * prows + (row - prow0)) * ldc + col) = pack8(v); }
    __device__ __forceinline__ void emit8(int row, int col, const float (&v)[8]) const {
        *(u32x4*)(C + (size_t)row * ldc + col) = pack8(v);
    }
};
struct EpiSwiGLU {
    static constexpr bool MIDK = false;
    f16* H;
    __device__ __forceinline__ void emit_part(int, int, int, const float (&)[8]) const {}
    __device__ __forceinline__ void emit8(int row, int col, const float (&v)[8]) const {
        f16x4 h;
#pragma unroll
        for (int i = 0; i < 4; ++i) h[i] = (f16)(silu_(v[i]) * v[i + 4]);
        *(f16x4*)(H + (size_t)row * DFF + (col >> 1)) = h;
    }
};

template <class Epi, class BSel>
__device__ __forceinline__ void gemm_naive(LAS unsigned char* lds, const f16* A, int lda, int K, int nMt, int nNt, const Epi& E, const BSel& bsel, int vb, int nvb, int tid) {
    LAS float* As = (LAS float*)lds;
    LAS float* Bs = As + 32 * 132;
    const int ty = tid >> 4, tx = tid & 15, lr = tid >> 2, kc = (tid & 3) * 8;
    for (int tile = vb; tile < nMt * nNt; tile += nvb) {
        const int tm = tile / nNt, tn = tile % nNt;
        const f16* Bt = bsel(tm * 128);
        float acc[4][8];
#pragma unroll
        for (int i = 0; i < 4; ++i)
#pragma unroll
            for (int j = 0; j < 8; ++j) acc[i][j] = 0.f;
        for (int k0 = 0; k0 < K; k0 += 32) {
            const f16x8 av = *(const f16x8*)(A + (size_t)(tm * 128 + lr) * lda + k0 + kc);
            const f16x8 bv = *(const f16x8*)(Bt + (size_t)(tn * 128 + lr) * K + k0 + kc);
            __syncthreads();
#pragma unroll
            for (int i = 0; i < 8; ++i) { As[(kc + i) * 132 + lr] = (float)av[i]; Bs[(kc + i) * 132 + lr] = (float)bv[i]; }
            __syncthreads();
#pragma unroll 8
            for (int kk = 0; kk < 32; ++kk) {
                const f32x4 a = *(const LAS f32x4*)(As + kk * 132 + ty * 4);
                const f32x4 b0 = *(const LAS f32x4*)(Bs + kk * 132 + tx * 8), b1 = *(const LAS f32x4*)(Bs + kk * 132 + tx * 8 + 4);
#pragma unroll
                for (int i = 0; i < 4; ++i) {
#pragma unroll
                    for (int j = 0; j < 4; ++j) { acc[i][j] += a[i] * b0[j]; acc[i][4 + j] += a[i] * b1[j]; }
                }
            }
        }
#pragma unroll
        for (int i = 0; i < 4; ++i) E.emit8(tm * 128 + ty * 4 + i, tn * 128 + tx * 8, acc[i]);
    }
    __syncthreads();
}
struct BSelOne { const f16* Bt; __device__ __forceinline__ const f16* operator()(int) const { return Bt; } };
struct BSelMoe { const f16* Bt; size_t estride; const int* blke; __device__ __forceinline__ const f16* operator()(int row) const { return Bt + (size_t)blke[row >> 8] * estride; } };


namespace pg8 {
constexpr int BM = 256, BK = 64, HALF = 128, HTB = HALF * BK * 2, STAGE_BYTES = 8 * HTB, NXCD = 8, WGM = 8;
__device__ __forceinline__ int lds_byte(int r, int c) { const int st = (r >> 4) * 2 + (c >> 5), rr = r & 15, cc = c & 31, ob = rr * 64 + cc * 2; return st * 1024 + (ob ^ (((ob >> 9) & 1) << 5)); }
__device__ __forceinline__ void stage_rc(int b, int& R, int& C) { const int st = b / 1024, sb = b % 1024, swz = sb ^ (((sb >> 9) & 1) << 5); R = (st >> 1) * 16 + swz / 64; C = (st & 1) * 32 + (swz % 64) / 2; }
__device__ __forceinline__ int perm32(int rho) { const int n = rho >> 4, i = rho & 15; return 8 * (i >> 2) + 4 * n + (i & 3); }
struct Unit { int pm, pn, eb, kb, nt, part; };
struct Gemm { const f16* A; const f16* Bt; int lda, K; size_t bstride; };
struct Order {
    int nM, nN, nwg, G, c, ntile; const int* blke; int tailM, tailS, tail_nt;
    __device__ void init(int nM_, int nN_, int G_, int c_, const int* blke_, int ntile_) { nM = nM_; nN = nN_; nwg = nM * nN; G = G_; c = c_; blke = blke_; ntile = ntile_; tailM = 0; tailS = 1; tail_nt = ntile_; }
    __device__ void set_tail(int tailM_, int tailS_) { tailM = tailM_; tailS = tailS_; tail_nt = ntile / tailS_; }
    __device__ bool next(int i, Unit& u) const {
        const long L = (long)i * G + c;
        if (L >= nwg) { const int q = (int)(L - nwg); if (q >= tailM * nN * tailS) return false;
            const int uu = q / tailS, ks = q - uu * tailS; u.pm = nM + uu / nN; u.pn = uu % nN; u.eb = blke ? __builtin_amdgcn_readfirstlane(blke[u.pm]) : 0; u.kb = ks * tail_nt; u.nt = tail_nt; u.part = ks; return true; }
        int wgid = (int)L; { const int q = nwg / NXCD, r = nwg % NXCD, xcd = wgid % NXCD, off = wgid / NXCD; wgid = (xcd < r ? xcd * (q + 1) : r * (q + 1) + (xcd - r) * q) + off; }
        const int nig = WGM * nN, gid = wgid / nig, fm = gid * WGM, gsz = (nM - fm) < WGM ? (nM - fm) : WGM;
        u.pm = fm + ((wgid % nig) % gsz); u.pn = (wgid % nig) / gsz; u.eb = blke ? __builtin_amdgcn_readfirstlane(blke[u.pm]) : 0; u.kb = 0; u.nt = ntile; u.part = -1; return true;
    }
};
template <class Epi>
__device__ __forceinline__ void gemm_phase(LAS unsigned char* lds, const Gemm g, const Order& S, const Epi& E, int tid) {
    const int wid = __builtin_amdgcn_readfirstlane(tid >> 6), lane = tid & 63, wr = wid >> 2, wc = wid & 3, fr = lane & 15, fq = lane >> 4;
    const int K = g.K;
    unsigned voffA[2], voffB[2];
#pragma unroll
    for (int i = 0; i < 2; ++i) { int R, C; stage_rc(tid * 16 + i * 8192, R, C); const int Rb = (R & ~31) + perm32(R & 31);
        voffA[i] = (unsigned)(R * g.lda + C) * 2u; voffB[i] = (unsigned)(Rb * K + C) * 2u; }
    const size_t kstep = (size_t)(BK * 2);
    const size_t hstepA = (size_t)HALF * g.lda * 2, tstepA = 2 * hstepA, hstepB = (size_t)HALF * K * 2, tstepB = 2 * hstepB;
    const unsigned ldsw = (unsigned)wid * 1024u;
    const int aoff = lds_byte(wr * 64 + fr, fq * 8), boff = lds_byte(wc * 32 + fr, fq * 8);
#define PG8_SA(b, h) (((b) * 2 + (h)) * HTB)
#define PG8_SB(b, h) ((4 + (b) * 2 + (h)) * HTB)
#define PG8_STAGE(bufoff, gbase, voff) do { _Pragma("unroll") for (int _i = 0; _i < 2; ++_i) \
        __builtin_amdgcn_global_load_lds((const unsigned*)((const char*)(gbase) + (voff)[_i]), (LAS unsigned*)(lds + (bufoff) + ldsw + _i * 8192), 16, 0, 0); } while (0)
#define PG8_LDA(dst, b, h) do { _Pragma("unroll") for (int m = 0; m < 4; ++m) _Pragma("unroll") for (int k = 0; k < 2; ++k) dst[m][k] = *(const LAS f16x8*)(lds + PG8_SA(b, h) + aoff + m * 2048 + k * 1024); } while (0)
#define PG8_LDB(dst, b, h) do { _Pragma("unroll") for (int n = 0; n < 2; ++n) _Pragma("unroll") for (int k = 0; k < 2; ++k) dst[n][k] = *(const LAS f16x8*)(lds + PG8_SB(b, h) + boff + n * 2048 + k * 1024); } while (0)
#define PG8_MMA(ai, bj, At, Bt) do { __builtin_amdgcn_s_setprio(1); _Pragma("unroll") for (int m = 0; m < 4; ++m) _Pragma("unroll") for (int n = 0; n < 2; ++n) _Pragma("unroll") for (int k = 0; k < 2; ++k) \
        acc[ai][bj][m][n] = __builtin_amdgcn_mfma_f32_16x16x32_f16(Bt[n][k], At[m][k], acc[ai][bj][m][n], 0, 0, 0); __builtin_amdgcn_s_setprio(0); } while (0)
#define PG8_WAIT_V(n) asm volatile("s_waitcnt vmcnt(" #n ")" ::: "memory")
#define PG8_WAIT_L(n) asm volatile("s_waitcnt lgkmcnt(" #n ")" ::: "memory")
#define PG8_BAR __builtin_amdgcn_s_barrier()
#define PG8_SCHED __builtin_amdgcn_sched_barrier(0)
    Unit cur, nxt; int ui = 0;
    if (!S.next(0, cur)) return;
    f32x4 acc[2][2][4][2];
#pragma unroll
    for (int a = 0; a < 2; ++a)
#pragma unroll
        for (int b = 0; b < 2; ++b)
#pragma unroll
            for (int m = 0; m < 4; ++m)
#pragma unroll
                for (int n = 0; n < 2; ++n) acc[a][b][m][n] = (f32x4){0.f, 0.f, 0.f, 0.f};
    f16x8 At[4][2], B0[2][2], B1[2][2];
    const char* cA = (const char*)g.A + (size_t)cur.pm * tstepA + (size_t)cur.kb * kstep; const char* cB = (const char*)g.Bt + (size_t)cur.eb * g.bstride * 2 + (size_t)cur.pn * tstepB + (size_t)cur.kb * kstep;
    PG8_STAGE(PG8_SB(0, 0), cB, voffB); PG8_STAGE(PG8_SB(0, 1), cB + hstepB, voffB); PG8_STAGE(PG8_SA(0, 0), cA, voffA); PG8_STAGE(PG8_SA(0, 1), cA + hstepA, voffA);
    if (wr == 1) PG8_BAR;
    PG8_WAIT_V(2); PG8_BAR;
    PG8_STAGE(PG8_SB(1, 0), cB + kstep, voffB); PG8_STAGE(PG8_SA(1, 0), cA + kstep, voffA); PG8_STAGE(PG8_SB(1, 1), cB + hstepB + kstep, voffB);
    PG8_WAIT_V(6); PG8_BAR;
    for (;;) {
        const bool has_next = S.next(ui + 1, nxt);
        const char* nA = has_next ? (const char*)g.A + (size_t)nxt.pm * tstepA + (size_t)nxt.kb * kstep : cA; const char* nB = has_next ? (const char*)g.Bt + (size_t)nxt.eb * g.bstride * 2 + (size_t)nxt.pn * tstepB + (size_t)nxt.kb * kstep : cB;
        const int nt = cur.nt;
        int t = 0;
#pragma unroll 1
        for (int seg = 0; seg < (Epi::MIDK ? 3 : 1); ++seg) {
        const int tend = Epi::MIDK ? (seg == 0 ? (nt < 4 ? nt : 4) : (seg == 1 ? (nt < 8 ? nt : 8) : nt)) : nt;
        for (; t < tend; t += 2) {
            const bool last = (t == nt - 2);
            const char* a1 = cA + (size_t)(t + 1) * kstep;
            const char* a2 = last ? nA : cA + (size_t)(t + 2) * kstep; const char* b2 = last ? nB : cB + (size_t)(t + 2) * kstep;
            const char* a3 = a2 + kstep; const char* b3 = b2 + kstep;
            PG8_LDB(B0, 0, 0); PG8_LDB(B1, 0, 1); PG8_SCHED; PG8_LDA(At, 0, 0); PG8_STAGE(PG8_SA(1, 1), a1 + hstepA, voffA);
            PG8_WAIT_V(8); PG8_WAIT_L(0); PG8_BAR; PG8_MMA(0, 0, At, B0); PG8_MMA(0, 1, At, B1); PG8_BAR; PG8_SCHED;
            PG8_LDA(At, 0, 1); PG8_STAGE(PG8_SB(0, 0), b2, voffB); PG8_STAGE(PG8_SB(0, 1), b2 + hstepB, voffB); PG8_STAGE(PG8_SA(0, 0), a2, voffA);
            PG8_WAIT_V(8); PG8_WAIT_L(0); PG8_BAR; PG8_MMA(1, 0, At, B0); PG8_MMA(1, 1, At, B1); PG8_BAR; PG8_SCHED;
            PG8_LDB(B0, 1, 0); PG8_LDB(B1, 1, 1); PG8_SCHED; PG8_LDA(At, 1, 0); PG8_STAGE(PG8_SA(0, 1), a2 + hstepA, voffA);
            PG8_WAIT_V(8); PG8_WAIT_L(0); PG8_BAR; PG8_MMA(0, 0, At, B0); PG8_MMA(0, 1, At, B1); PG8_BAR; PG8_SCHED;
            PG8_LDA(At, 1, 1); PG8_STAGE(PG8_SB(1, 0), b3, voffB); PG8_STAGE(PG8_SB(1, 1), b3 + hstepB, voffB); PG8_STAGE(PG8_SA(1, 0), a3, voffA);
            PG8_WAIT_V(8); PG8_WAIT_L(0); PG8_BAR; PG8_MMA(1, 0, At, B0); PG8_MMA(1, 1, At, B1); PG8_BAR; PG8_SCHED;
        }
        if constexpr (Epi::MIDK) { if (seg < 2 && cur.part < 0) {
#pragma unroll
                for (int ai = 0; ai < 2; ++ai)
#pragma unroll
                    for (int m = 0; m < 4; ++m) { int row = cur.pm * BM + ai * HALF + wr * 64 + m * 16 + fr; asm volatile("" : "+v"(row));
#pragma unroll
                        for (int bj = 0; bj < 2; ++bj) { const f32x4 v0 = acc[ai][bj][m][0], v1 = acc[ai][bj][m][1];
                            float v[8] = {v0[0], v0[1], v0[2], v0[3], v1[0], v1[1], v1[2], v1[3]};
                            E.mid8(row, cur.pn * BM + bj * HALF + wc * 32 + 8 * fq, v, seg);
                            acc[ai][bj][m][0] = (f32x4){v[0], v[1], v[2], v[3]}; acc[ai][bj][m][1] = (f32x4){v[4], v[5], v[6], v[7]}; }
                        asm volatile("" : "+v"(acc[ai][0][m][0]), "+v"(acc[ai][0][m][1]), "+v"(acc[ai][1][m][0]), "+v"(acc[ai][1][m][1]) :: "memory"); } } }
        }
        if (wr == 0) PG8_BAR;
        {
#pragma unroll
            for (int ai = 0; ai < 2; ++ai)
#pragma unroll
                for (int m = 0; m < 4; ++m) { int row = cur.pm * BM + ai * HALF + wr * 64 + m * 16 + fr; if constexpr (Epi::MIDK) asm volatile("" : "+v"(row));
#pragma unroll
                    for (int bj = 0; bj < 2; ++bj) { const f32x4 v0 = acc[ai][bj][m][0], v1 = acc[ai][bj][m][1];
                        const float v[8] = {v0[0], v0[1], v0[2], v0[3], v1[0], v1[1], v1[2], v1[3]};
                        if (cur.part >= 0) E.emit_part(cur.part, row, cur.pn * BM + bj * HALF + wc * 32 + 8 * fq, v); else E.emit8(row, cur.pn * BM + bj * HALF + wc * 32 + 8 * fq, v); } }
        }
        if (!has_next) break;
#pragma unroll
        for (int a = 0; a < 2; ++a)
#pragma unroll
            for (int b = 0; b < 2; ++b)
#pragma unroll
                for (int m = 0; m < 4; ++m)
#pragma unroll
                    for (int n = 0; n < 2; ++n) acc[a][b][m][n] = (f32x4){0.f, 0.f, 0.f, 0.f};
        cur = nxt; cA = nA; cB = nB; ++ui;
        if (wr == 1) PG8_BAR;
    }
    PG8_WAIT_V(0);
    PG8_BAR;
#undef PG8_SA
#undef PG8_SB
#undef PG8_STAGE
#undef PG8_LDA
#undef PG8_LDB
#undef PG8_MMA
#undef PG8_WAIT_V
#undef PG8_WAIT_L
#undef PG8_BAR
#undef PG8_SCHED
}
}
template <class Epi>
__device__ __forceinline__ void gemm_run(LAS unsigned char* lds, const f16* A, int lda, int K, int nrows, int N, const f16* Bt, size_t bstride, const int* blke, const Epi& E, int vb, int nvb, int tid, int tail_rows = 0, int tailS = 1) {
#if USE_MFMA
    pg8::Gemm g{A, Bt, lda, K, bstride}; pg8::Order S; S.init((nrows - tail_rows) / 256, N / 256, nvb, vb, blke, K / 64); if (tail_rows) S.set_tail(tail_rows / 256, tailS);
    pg8::gemm_phase(lds, g, S, E, tid);
#else
    static_assert(!Epi::MIDK, "the naive GEMM has no mid-K hook");
    if (blke) gemm_naive(lds, A, lda, K, nrows / 128, N / 128, E, BSelMoe{Bt, bstride, blke}, vb, nvb, tid);
    else gemm_naive(lds, A, lda, K, nrows / 128, N / 128, E, BSelOne{Bt}, vb, nvb, tid);
#endif
}

__device__ __forceinline__ void conv_item(const float* S0, const float* S1, int ld, int K, int N, f16* dst, int ldd, int mode, int skipfrom, int skip, LAS float* scr, int item, int lane) {
    const int nblk = N / 32, kb = item / nblk, nb = item % nblk, k0 = 64 * kb, n0 = 32 * nb;
    const int n = n0 + (lane & 31);
    const float* sp;
    if (mode == 0) sp = S0 + n + (n >= skipfrom ? skip : 0);
    else { const int j = n >> 3, i = n & 7; sp = (i < 4 ? S0 : S1) + 4 * j + (i & 3); }
#pragma unroll 8
    for (int i = 0; i < 32; ++i) { const int kk = 2 * i + (lane >> 5); scr[kk * 33 + (lane & 31)] = sp[(size_t)(k0 + kk) * ld]; }
    LDS_WAIT();
    const int c = lane & 7;
#pragma unroll
    for (int j = 0; j < 4; ++j) { const int nn = (lane >> 3) + 8 * j; const LAS float* s = scr + (8 * c) * 33 + nn;
        f16x8 h;
#pragma unroll
        for (int q = 0; q < 8; ++q) h[q] = (f16)s[q * 33];
        *(f16x8*)(dst + (size_t)(n0 + nn) * ldd + k0 + 8 * c) = h; }
    LDS_WAIT();
}
constexpr int FFN_ITEMS = 16 * (NFF2 / 32) + 56 * 32;
__device__ __forceinline__ void conv_layer(unsigned char* ws, int layer, LAS unsigned char* lds, int gw, int ngw, int wave, int lane, int ffn_lo) {
    LAS float* scr = (LAS float*)(lds + wave * 8448);
    unsigned char* W = ws + WS_W;
    const int I_IN = 16 * (NP1 / 32), I_BP = 4 * 32, I_BM = 8 * 32, I_OUT = 16 * 32, I_13 = 16 * (NFF2 / 32), I_2 = 56 * 32;
    const bool moe = (layer & 1); const int fi = layer >> 1;
    const int nexp = moe ? NE : 1;
    const int ncommon = I_IN + 2 * I_BP + I_BM + I_OUT;
    const int total = ncommon + nexp * (I_13 + I_2) - ffn_lo;
    for (int it = gw; it < total; it += ngw) {
        int r = it < ncommon ? it : it + ffn_lo;
        if (r < I_IN) { conv_item(INP(I_WIN) + (size_t)layer * D * NIN, nullptr, NIN, D, NP1, (f16*)(W + WO_IN), D, 0, 3072, 16, scr, r, lane); continue; } r -= I_IN;
        if (r < I_BP) { conv_item(INP(I_WBP) + (size_t)layer * 256 * D, nullptr, D, 256, D, (f16*)(W + WO_BP), D, 0, 1 << 30, 0, scr, r, lane); continue; } r -= I_BP;
        if (r < I_BP) { conv_item(INP(I_WBN) + (size_t)layer * 256 * D, nullptr, D, 256, D, (f16*)(W + WO_BP) + 256, D, 0, 1 << 30, 0, scr, r, lane); continue; } r -= I_BP;
        if (r < I_BM) { conv_item(INP(I_WBM) + (size_t)layer * 512 * D, nullptr, D, 512, D, (f16*)(W + WO_BP) + 512, D, 0, 1 << 30, 0, scr, r, lane); continue; } r -= I_BM;
        if (r < I_OUT) { conv_item(INP(I_WOUT) + (size_t)layer * D * D, nullptr, D, D, D, (f16*)(W + WO_OUT), D, 0, 1 << 30, 0, scr, r, lane); continue; } r -= I_OUT;
        const int e = r / (I_13 + I_2); r -= e * (I_13 + I_2);
        const size_t eo = (size_t)(fi * nexp + e) * D * DFF;
        const float* w1 = (moe ? INP(I_MW1) : INP(I_FW1)) + eo;
        const float* w3 = (moe ? INP(I_MW3) : INP(I_FW3)) + eo;
        const float* w2 = (moe ? INP(I_MW2) : INP(I_FW2)) + eo;
        if (r < I_13) conv_item(w1, w3, DFF, D, NFF2, (f16*)(W + (moe ? WO_13 : WO_13D)) + (size_t)e * NFF2 * D, D, 1, 0, 0, scr, r, lane);
        else conv_item(w2, nullptr, D, DFF, D, (f16*)(W + (moe ? WO_2 : WO_2D)) + (size_t)e * D * DFF, DFF, 0, 1 << 30, 0, scr, r - I_13, lane);
    }
}

__device__ __forceinline__ void conv_seg(int l, int nvb, int& LA, int& a0, int& an, int& LB, int& b0, int& bn) {
    LA = 0; a0 = 0; an = 0; LB = 0; b0 = 0; bn = 0;
    if (nvb != 256) return;
    constexpr int HALF = 9 * NWAVES * 256;
    if (l == 0) { LA = 1; a0 = 0; an = HALF; }
    else if (l == 1) { LA = 1; a0 = HALF; an = HALF; LB = 2; b0 = 0; bn = FFN_ITEMS; }
    else if (l == 2) { LA = 3; a0 = 0; an = HALF; }
    else { LA = 3; a0 = HALF; an = HALF; }
}
__device__ __forceinline__ int ffn_dma_items(int L, int nvb) {
    if (L <= 0 || L >= DEPTH || nvb != 256) return 0;
    const int tot = ((L & 1) ? NE : 1) * FFN_ITEMS, cap = 18 * NWAVES * 256;
    return tot < cap ? tot : cap;
}

__device__ __forceinline__ void ln_stats(const f32x4 (&v)[4], float& mean, float& rstd) {
    float s = 0.f;
#pragma unroll
    for (int j = 0; j < 4; ++j) s += (v[j][0] + v[j][1]) + (v[j][2] + v[j][3]);
    mean = wave_sum(s) * (1.f / D);
    float q = 0.f;
#pragma unroll
    for (int j = 0; j < 4; ++j) { const f32x4 d = v[j] - mean; q += (d[0] * d[0] + d[1] * d[1]) + (d[2] * d[2] + d[3] * d[3]); }
    rstd = 1.f / sqrtf(wave_sum(q) * (1.f / D) + LN_EPS);
}
__device__ __forceinline__ const float* mod_row(unsigned char* ws, LAS unsigned char* lds, int layer, int r) {
    const int rb = r < ML ? r / SEQ : NB;
    return (const float*)(ws + WS_MOD) + (size_t)(layer * 9 + rb) * 6144;
}
__device__ __forceinline__ void load_gate_table(LAS unsigned char* lds, int layer, LAS float* T, int tid) {
    const float* src = INP(I_WIN) + (size_t)layer * D * NIN + 3072;
    for (int i = tid; i < D * 4; i += NTHREADS) { const int k = i >> 2, q = i & 3; const f32x4 w = *(const f32x4*)(src + (size_t)k * NIN + 4 * q);
        T[(4 * q + 0) * D + k] = w[0]; T[(4 * q + 1) * D + k] = w[1]; T[(4 * q + 2) * D + k] = w[2]; T[(4 * q + 3) * D + k] = w[3]; }
    __syncthreads();
}
__device__ __forceinline__ void load_router_table(LAS unsigned char* lds, int mi, LAS float* T, int tid) {
    const float* src = INP(I_RW) + (size_t)mi * D * NE;
    for (int i = tid; i < D * 2; i += NTHREADS) { const int k = i >> 1, q = i & 1; const f32x4 w = *(const f32x4*)(src + (size_t)k * NE + 4 * q);
        T[(4 * q + 0) * D + k] = w[0]; T[(4 * q + 1) * D + k] = w[1]; T[(4 * q + 2) * D + k] = w[2]; T[(4 * q + 3) * D + k] = w[3]; }
    __syncthreads();
}
__device__ __forceinline__ float dot4_rows(const f32x4 (&u)[4], const LAS float* T, int g0, int lane) {
    float p[4];
#pragma unroll
    for (int i = 0; i < 4; ++i) { float s = 0.f;
#pragma unroll
        for (int j = 0; j < 4; ++j) { const f32x4 w = *(const LAS f32x4*)(T + (g0 + i) * D + 256 * j + 4 * lane); s += (u[j][0] * w[0] + u[j][1] * w[1]) + (u[j][2] * w[2] + u[j][3] * w[3]); }
        p[i] = s; }
    const bool b5 = (lane & 32) != 0, b4 = (lane & 16) != 0;
    const float q0 = (b5 ? p[2] : p[0]) + __shfl_xor(b5 ? p[0] : p[2], 32), q1 = (b5 ? p[3] : p[1]) + __shfl_xor(b5 ? p[1] : p[3], 32);
    float s = (b4 ? q1 : q0) + __shfl_xor(b4 ? q0 : q1, 16);
    return row16_sum(s);
}
__device__ __forceinline__ void row_A(unsigned char* ws, LAS unsigned char* lds, int layer, int r, const f32x4 (&x)[4], const LAS float* GT, int lane) {
    float mean, rstd; ln_stats(x, mean, rstd);
    const float* mod = mod_row(ws, lds, layer, r);
    f32x4 u[4];
    f16* up = (f16*)(ws + WS_U16) + (size_t)r * D;
#pragma unroll
    for (int j = 0; j < 4; ++j) { const int k = 256 * j + 4 * lane; const f32x4 sh = *(const f32x4*)(mod + k), sc = *(const f32x4*)(mod + 1024 + k);
        u[j] = (x[j] - mean) * rstd * (sc + 1.f) + sh;
        f16x4 h; h[0] = (f16)u[j][0]; h[1] = (f16)u[j][1]; h[2] = (f16)u[j][2]; h[3] = (f16)u[j][3];
        *(f16x4*)(up + k) = h; }
#pragma unroll 1
    for (int gb = 0; gb < 4; ++gb) { const float s = dot4_rows(u, GT, 4 * gb, lane);
        if ((lane & 15) == 0) ((float*)(ws + WS_MLG))[(size_t)r * 16 + 4 * gb + (lane >> 4)] = s; }
}
__device__ __forceinline__ void row_A_pre(unsigned char* ws, int r, const f32x4 (&x)[4], const f32x4 (&sh)[4], const f32x4 (&sc)[4], const LAS float* GT, int lane) {
    float mean, rstd; ln_stats(x, mean, rstd);
    f32x4 u[4];
    f16* up = (f16*)(ws + WS_U16) + (size_t)r * D;
#pragma unroll
    for (int j = 0; j < 4; ++j) { const int k = 256 * j + 4 * lane;
        u[j] = (x[j] - mean) * rstd * (sc[j] + 1.f) + sh[j];
        f16x4 h; h[0] = (f16)u[j][0]; h[1] = (f16)u[j][1]; h[2] = (f16)u[j][2]; h[3] = (f16)u[j][3];
        *(f16x4*)(up + k) = h; }
#pragma unroll 1
    for (int gb = 0; gb < 4; ++gb) { const float s = dot4_rows(u, GT, 4 * gb, lane);
        if ((lane & 15) == 0) ((float*)(ws + WS_MLG))[(size_t)r * 16 + 4 * gb + (lane >> 4)] = s; }
}
__device__ __forceinline__ void load_row(const float* p, f32x4 (&v)[4], int lane) {
#pragma unroll
    for (int j = 0; j < 4; ++j) v[j] = *(const f32x4*)(p + 256 * j + 4 * lane);
}
__device__ __forceinline__ void load_row_h(const f16* p, f32x4 (&v)[4], int lane) {
#pragma unroll
    for (int j = 0; j < 4; ++j) { const f16x4 h = *(const f16x4*)(p + 256 * j + 4 * lane); v[j] = (f32x4){(float)h[0], (float)h[1], (float)h[2], (float)h[3]}; }
}
__device__ __forceinline__ void store_row_h(f16* p, const f32x4 (&v)[4], int lane) {
#pragma unroll
    for (int j = 0; j < 4; ++j) { f16x4 h; h[0] = (f16)v[j][0]; h[1] = (f16)v[j][1]; h[2] = (f16)v[j][2]; h[3] = (f16)v[j][3]; *(f16x4*)(p + 256 * j + 4 * lane) = h; }
}
template <int layer>
__device__ __forceinline__ void load_x(unsigned char* ws, LAS unsigned char* lds, int r, f32x4 (&v)[4], int lane) {
    if constexpr (layer == 0) load_row(r < ML ? INP(I_X) + (size_t)r * D : INP(I_CTX) + (size_t)(r - ML) * D, v, lane);
    else load_row_h((const f16*)(ws + WS_XS) + (size_t)r * D, v, lane);
}
__device__ __forceinline__ void load_row_sum(const f16* p, size_t stride, int n, f32x4 (&v)[4], int lane) {
    load_row_h(p, v, lane);
    for (int s = 1; s < n; ++s) { f32x4 t[4]; load_row_h(p + (size_t)s * stride, t, lane);
#pragma unroll
        for (int j = 0; j < 4; ++j) v[j] += t[j]; }
}
__device__ __forceinline__ const float* x_src(unsigned char* ws, LAS unsigned char* lds, int layer, int r) {
    if (layer == 0) return r < ML ? INP(I_X) + (size_t)r * D : INP(I_CTX) + (size_t)(r - ML) * D;
    return (const float*)(ws + WS_XS) + (size_t)r * D;
}

__device__ __forceinline__ void pool_phase(unsigned char* ws, int layer, LAS unsigned char* lds, int vb, int nvb, int tid) {
    LAS float* in = (LAS float*)lds;
    LAS f16* dif16 = (LAS f16*)(lds + 80 * 64 * 4);
    LAS f16* Wt16 = dif16 + 64 * 72;
    const f16* P1 = (const f16*)(ws + WS_P1);
    f16* CAT = (f16*)(ws + WS_CAT);
    const int nrows = (layer == DEPTH - 1) ? ML : MT;
    const int nunits = (nrows / 64) * 4;
    const int lane = tid & 63, w = __builtin_amdgcn_readfirstlane(tid >> 6), gq = lane >> 4, c = lane & 15;
    int gl = -1;
    for (int un = vb; un < nunits; un += nvb) {
        const int ch = un >> 2, g = un & 3, r0 = ch * 64;
        const int seq0 = r0 < ML ? (r0 / SEQ) * SEQ : ML + ((r0 - ML) / CTXL) * CTXL, seqlen = r0 < ML ? SEQ : CTXL;
        const int t0 = r0 - seq0, half = 1 << g;
        __syncthreads();
        for (int i = tid; i < 80 * 8; i += NTHREADS) { const int rr = i >> 3, c8 = (i & 7) * 8; const int t = t0 - 8 + rr;
            f16x8 v; if (t >= 0 && t < seqlen) v = *(const f16x8*)(P1 + (size_t)(seq0 + t) * NP1 + g * 64 + c8); else { for (int q = 0; q < 8; ++q) v[q] = (f16)0.f; }
#pragma unroll
            for (int q = 0; q < 8; ++q) in[rr * 64 + c8 + q] = (float)v[q]; }
        if (g != gl) { const float* pw = INP(I_POOLW) + (size_t)(layer * 4 + g) * 4096;
            for (int i = tid; i < 4096; i += NTHREADS) { const int cc = i >> 6, dd = i & 63; Wt16[dd * 72 + cc] = (f16)pw[i]; } gl = g; }
        __syncthreads();
        { const int tt = tid >> 3, c8 = (tid & 7) * 8, t = t0 + tt; int lo = t - half; if (lo < 0) lo = 0; int hi = t + half; if (hi > seqlen) hi = seqlen;
          const float inv = 1.f / (float)(hi - lo);
          float sacc[8];
#pragma unroll
          for (int q = 0; q < 8; ++q) sacc[q] = 0.f;
          for (int p = lo; p < hi; ++p) { const LAS float* ip = in + (p - t0 + 8) * 64 + c8;
#pragma unroll
              for (int q = 0; q < 8; ++q) sacc[q] += ip[q]; }
          f16x8 dv;
#pragma unroll
          for (int q = 0; q < 8; ++q) dv[q] = (f16)(sacc[q] * inv - in[(tt + 8) * 64 + c8 + q]);
          *(LAS f16x8*)(dif16 + tt * 72 + c8) = dv; }
        __syncthreads();
        { const int tt = w >> 1;
          f16x8 bfr[2];
#pragma unroll
          for (int ks = 0; ks < 2; ++ks) bfr[ks] = *(const LAS f16x8*)(dif16 + (16 * tt + c) * 72 + 32 * ks + 8 * gq);
#pragma unroll
          for (int q = 0; q < 2; ++q) { const int dt = (w & 1) * 2 + q;
              f32x4 acc = (f32x4){0.f, 0.f, 0.f, 0.f};
#pragma unroll
              for (int ks = 0; ks < 2; ++ks) { const f16x8 afr = *(const LAS f16x8*)(Wt16 + (16 * dt + c) * 72 + 32 * ks + 8 * gq);
                  acc = __builtin_amdgcn_mfma_f32_16x16x32_f16(afr, bfr[ks], acc, 0, 0, 0); }
              const f32x4 ps = *(const f32x4*)(INP(I_POOLS) + layer * 256 + g * 64 + 16 * dt + 4 * gq);
              f16x4 h; h[0] = (f16)(acc[0] * ps[0]); h[1] = (f16)(acc[1] * ps[1]); h[2] = (f16)(acc[2] * ps[2]); h[3] = (f16)(acc[3] * ps[3]);
              *(f16x4*)(CAT + (size_t)(r0 + 16 * tt + c) * D + g * 64 + 16 * dt + 4 * gq) = h; } }
    }
    __syncthreads();
}
__device__ __forceinline__ void na_phase(unsigned char* ws, int layer, LAS unsigned char* lds, int gw, int ngw, int wave, int lane) {
    LAS float* qs = (LAS float*)(lds + wave * 2048);
    LAS float* ps = qs + 64;
    const f16* P1 = (const f16*)(ws + WS_P1);
    f16* CAT = (f16*)(ws + WS_CAT);
    const float* rpb = INP(I_RPB) + (size_t)layer * 4 * 15 * 31;
    const int nq = (layer == DEPTH - 1) ? ML : MT;
    for (int item = gw; item < nq * 4; item += ngw) {
        const int tq = item >> 2, h = item & 3;
        qs[lane] = (float)P1[(size_t)tq * NP1 + 256 + h * 64 + lane];
        LDS_WAIT();
        const bool lat = tq < ML;
        const int b = lat ? tq / SEQ : (tq - ML) / CTXL;
        const int pos = tq % SEQ, r = pos >> 6, qc = pos & 63;
        int r0 = r - 4; r0 = r0 < 0 ? 0 : (r0 > 24 ? 24 : r0);
        int cs = qc - 8; cs = cs < 0 ? 0 : (cs > 48 ? 48 : cs);
        const int nloc = lat ? 128 : 0, nk = nloc + 256;
        float sc[6]; int tk[6];
        float mx = -3.0e38f;
#pragma unroll
        for (int i = 0; i < 6; ++i) {
            const int j = lane + 64 * i; sc[i] = -3.0e38f; tk[i] = 0;
            if (j < nk) {
                float bias = 0.f; int tok;
                if (j < nloc) { const int w = j >> 4, kk = j & 15; tok = b * SEQ + (r0 + w) * 64 + cs + kk;
                    int co = cs + kk - qc; co = co < -15 ? -15 : (co > 15 ? 15 : co);
                    bias = rpb[(h * 15 + (r0 + w - r + 7)) * 31 + co + 15]; }
                else tok = ML + b * CTXL + (j - nloc);
                tk[i] = tok;
                const f16* kp = P1 + (size_t)tok * NP1 + 512 + h * 64;
                float s = 0.f;
#pragma unroll
                for (int c = 0; c < 8; ++c) { const f16x8 kv = *(const f16x8*)(kp + 8 * c);
#pragma unroll
                    for (int q = 0; q < 8; ++q) s += qs[8 * c + q] * (float)kv[q]; }
                sc[i] = s + bias; mx = fmaxf(mx, sc[i]);
            }
        }
        mx = wave_max(mx);
        float sum = 0.f;
#pragma unroll
        for (int i = 0; i < 6; ++i) { const int j = lane + 64 * i; if (j < nk) { const float p = __expf(sc[i] - mx); sum += p; ps[j] = p; } }
        sum = wave_sum(sum);
        LDS_WAIT();
        float o = 0.f;
        for (int j = 0; j < nk; ++j) {
            int tok;
            if (j < nloc) tok = b * SEQ + (r0 + (j >> 4)) * 64 + cs + (j & 15); else tok = ML + b * CTXL + (j - nloc);
            o += ps[j] * (float)P1[(size_t)tok * NP1 + 768 + h * 64 + lane];
        }
        CAT[(size_t)tq * D + 256 + h * 64 + lane] = (f16)(o / sum);
        LDS_WAIT();
    }
}
__device__ __forceinline__ void mlprep_phase(unsigned char* ws, LAS unsigned char* lds, int layer, int gw, int ngw, int lane) {
    const f16* P1 = (const f16*)(ws + WS_P1);
    f16* QK = (f16*)(ws + WS_QK);
    const float* cw = INP(I_CONVW) + (size_t)layer * 3 * 1024;
    const float2* ROPE = (const float2*)(ws + WS_ROPE);
    float wq[3][8], wk[3][8];
#pragma unroll
    for (int t = 0; t < 3; ++t) { const f32x4 a0 = *(const f32x4*)(cw + t * 1024 + 8 * lane), a1 = *(const f32x4*)(cw + t * 1024 + 8 * lane + 4), b0 = *(const f32x4*)(cw + t * 1024 + 512 + 8 * lane), b1 = *(const f32x4*)(cw + t * 1024 + 512 + 8 * lane + 4);
#pragma unroll
        for (int j = 0; j < 4; ++j) { wq[t][j] = a0[j]; wq[t][4 + j] = a1[j]; wk[t][j] = b0[j]; wk[t][4 + j] = b1[j]; } }
    const int fi0 = (lane & 3) * 8;
    const bool first = (lane & 4) == 0;
    const int half = (lane >> 3) & 1;
    f16x8 z8; for (int j = 0; j < 8; ++j) z8[j] = (f16)0.f;
    f16x8 q0n = z8, q1n = z8, q2n = z8, k0n = z8, k1n = z8, k2n = z8, vvn = z8;
#define PREP_LOAD(r_) do { const bool lat_ = (r_) < ML; const int s0_ = lat_ ? ((r_) / SEQ) * SEQ : ML + (((r_) - ML) / CTXL) * CTXL, sl_ = lat_ ? SEQ : CTXL, t_ = (r_) - s0_; \
        const f16* p_ = P1 + (size_t)(r_) * NP1 + 1024 + 8 * lane; \
        q0n = t_ > 0 ? *(const f16x8*)(p_ - NP1) : z8; q1n = *(const f16x8*)p_; q2n = t_ + 1 < sl_ ? *(const f16x8*)(p_ + NP1) : z8; \
        k0n = t_ > 0 ? *(const f16x8*)(p_ - NP1 + 512) : z8; k1n = *(const f16x8*)(p_ + 512); k2n = t_ + 1 < sl_ ? *(const f16x8*)(p_ + NP1 + 512) : z8; } while (0)
    if (gw < MT) PREP_LOAD(gw);
    for (int r = gw; r < MT; r += ngw) {
        const bool lat = r < ML;
        const int seq0 = lat ? (r / SEQ) * SEQ : ML + ((r - ML) / CTXL) * CTXL, t = r - seq0;
        const f16x8 q0 = q0n, q1 = q1n, q2 = q2n, k0 = k0n, k1 = k1n, k2 = k2n;
        if (r + ngw < MT) PREP_LOAD(r + ngw);
        float vq[8], vk[8];
#pragma unroll
        for (int j = 0; j < 8; ++j) { vq[j] = silu_(wq[0][j] * (float)q0[j] + wq[1][j] * (float)q1[j] + wq[2][j] * (float)q2[j]);
            vk[j] = silu_(wk[0][j] * (float)k0[j] + wk[1][j] * (float)k1[j] + wk[2][j] * (float)k2[j]) * 0.08838834764831845f; }
        if (lat) {
            const int pp = half ? (t & 63) : (t >> 6);
            const float2* rp = ROPE + pp * 32 + fi0;
#pragma unroll
            for (int j = 0; j < 8; ++j) { const float2 cs = rp[j];
                const float oq = __shfl_xor(vq[j], 4), ok = __shfl_xor(vk[j], 4);
                vq[j] = first ? vq[j] * cs.x - oq * cs.y : oq * cs.y + vq[j] * cs.x;
                vk[j] = first ? vk[j] * cs.x - ok * cs.y : ok * cs.y + vk[j] * cs.x; }
        }
        f16x8 hq, hk;
#pragma unroll
        for (int j = 0; j < 8; ++j) { hq[j] = (f16)vq[j]; hk[j] = (f16)vk[j]; }
        *(f16x8*)(QK + (size_t)r * 1024 + 8 * lane) = hq; *(f16x8*)(QK + (size_t)r * 1024 + 512 + 8 * lane) = hk;
    }
}
__device__ __forceinline__ void mlstm_naive_phase(unsigned char* ws, int layer, LAS unsigned char* lds, int vb, int nvb, int tid) {
    LAS float* qs = (LAS float*)lds;
    LAS float* ks = qs + 32 * 128;
    LAS float* vs = ks + 32 * 128;
    LAS float* gi = vs + 32 * 128;
    LAS float* gf = gi + 32;
    LAS float* part = gf + 32;
    LAS float* partd = part + 1024;
    const f16* P1 = (const f16*)(ws + WS_P1);
    const f16* QK = (const f16*)(ws + WS_QK);
    const float* MLG = (const float*)(ws + WS_MLG);
    float* HFB = (float*)(ws + WS_HFB);
    const float* gb = INP(I_GBIAS) + layer * 16;
    const int dg = tid >> 7, e = tid & 127;
    for (int job = vb; job < 64; job += nvb) {
        const int b = job >> 3, h = (job >> 1) & 3, dir = job & 1;
        float C[32], n[32];
#pragma unroll
        for (int i = 0; i < 32; ++i) { C[i] = 0.f; n[i] = 0.f; }
        for (int s0 = 0; s0 < CTXL + SEQ; s0 += 32) {
            __syncthreads();
            for (int i = tid; i < 32 * 128; i += NTHREADS) { const int s = s0 + (i >> 7), d = i & 127;
                const int tok = s < CTXL ? ML + b * CTXL + (dir ? CTXL - 1 - s : s) : b * SEQ + (dir ? SEQ - 1 - (s - CTXL) : (s - CTXL));
                qs[i] = (float)QK[(size_t)tok * 1024 + h * 128 + d]; ks[i] = (float)QK[(size_t)tok * 1024 + 512 + h * 128 + d];
                vs[i] = (float)P1[(size_t)tok * NP1 + 2048 + h * 128 + d];
                if (d == 0) { gi[i >> 7] = __expf(MLG[(size_t)tok * 16 + dir * 8 + h] + gb[dir * 8 + h]); gf[i >> 7] = sigmoid_(MLG[(size_t)tok * 16 + dir * 8 + 4 + h] + gb[dir * 8 + 4 + h]); } }
            __syncthreads();
            for (int s = 0; s < 32; ++s) {
                const float fi = gf[s], ii = gi[s], ve = vs[s * 128 + e] * ii;
                float pn = 0.f, pd = 0.f;
#pragma unroll
                for (int i = 0; i < 32; ++i) { const float kd = ks[s * 128 + dg * 32 + i], qd = qs[s * 128 + dg * 32 + i];
                    C[i] = fi * C[i] + kd * ve; n[i] = fi * n[i] + ii * kd; pn += qd * C[i]; pd += qd * n[i]; }
                part[((s & 1) * 4 + dg) * 128 + e] = pn; if (e == 0) partd[(s & 1) * 4 + dg] = pd;
                __syncthreads();
                if (dg == 0) { const int sb = (s & 1) * 4;
                    const float num = (part[(sb + 0) * 128 + e] + part[(sb + 1) * 128 + e]) + (part[(sb + 2) * 128 + e] + part[(sb + 3) * 128 + e]);
                    const float den = (partd[sb] + partd[sb + 1]) + (partd[sb + 2] + partd[sb + 3]);
                    const int sg = s0 + s;
                    const int tok = sg < CTXL ? ML + b * CTXL + (dir ? CTXL - 1 - sg : sg) : b * SEQ + (dir ? SEQ - 1 - (sg - CTXL) : (sg - CTXL));
                    HFB[((size_t)dir * MT + tok) * 512 + h * 128 + e] = num / fmaxf(fabsf(den), 1.f); }
            }
        }
    }
    __syncthreads();
}

#define TR_READ2(r0, r1, a0, a1) asm volatile("ds_read_b64_tr_b16 %0, %2\n\tds_read_b64_tr_b16 %1, %3\n\ts_waitcnt lgkmcnt(0)" : "=&v"(r0), "=&v"(r1) : "v"(a0), "v"(a1) : "memory")
__device__ __forceinline__ float scan_sum64(float v, int lane) {
    v += __builtin_bit_cast(float, __builtin_amdgcn_update_dpp(0, __builtin_bit_cast(int, v), 0x111, 0xF, 0xF, true));
    v += __builtin_bit_cast(float, __builtin_amdgcn_update_dpp(0, __builtin_bit_cast(int, v), 0x112, 0xF, 0xF, true));
    v += __builtin_bit_cast(float, __builtin_amdgcn_update_dpp(0, __builtin_bit_cast(int, v), 0x114, 0xF, 0xF, true));
    v += __builtin_bit_cast(float, __builtin_amdgcn_update_dpp(0, __builtin_bit_cast(int, v), 0x118, 0xF, 0xF, true));
    const int vi = __builtin_bit_cast(int, v);
    const float t0 = __builtin_bit_cast(float, __builtin_amdgcn_readlane(vi, 15)), t1 = __builtin_bit_cast(float, __builtin_amdgcn_readlane(vi, 31)), t2 = __builtin_bit_cast(float, __builtin_amdgcn_readlane(vi, 47));
    const int row = lane >> 4;
    return v + (row == 0 ? 0.f : (row == 1 ? t0 : (row == 2 ? t0 + t1 : (t0 + t1) + t2)));
}
__device__ __forceinline__ float scan_max64(float v, int lane) {
    const int ninf = __builtin_bit_cast(int, -3.0e38f);
    v = fmaxf(v, __builtin_bit_cast(float, __builtin_amdgcn_update_dpp(ninf, __builtin_bit_cast(int, v), 0x111, 0xF, 0xF, false)));
    v = fmaxf(v, __builtin_bit_cast(float, __builtin_amdgcn_update_dpp(ninf, __builtin_bit_cast(int, v), 0x112, 0xF, 0xF, false)));
    v = fmaxf(v, __builtin_bit_cast(float, __builtin_amdgcn_update_dpp(ninf, __builtin_bit_cast(int, v), 0x114, 0xF, 0xF, false)));
    v = fmaxf(v, __builtin_bit_cast(float, __builtin_amdgcn_update_dpp(ninf, __builtin_bit_cast(int, v), 0x118, 0xF, 0xF, false)));
    const int vi = __builtin_bit_cast(int, v);
    const float t0 = __builtin_bit_cast(float, __builtin_amdgcn_readlane(vi, 15)), t1 = __builtin_bit_cast(float, __builtin_amdgcn_readlane(vi, 31)), t2 = __builtin_bit_cast(float, __builtin_amdgcn_readlane(vi, 47));
    const int row = lane >> 4;
    return fmaxf(v, row == 0 ? -3.0e38f : (row == 1 ? t0 : (row == 2 ? fmaxf(t0, t1) : fmaxf(fmaxf(t0, t1), t2))));
}
__device__ __forceinline__ float log_sigmoid_(float x) { return x >= 0.f ? -log1pf(__expf(-x)) : x - log1pf(__expf(x)); }
__device__ __forceinline__ int ml_tok(int b, int dir, int ch, int s) {
    if (ch < 2) { const int idx = ch * 128 + s; return ML + b * CTXL + (dir ? CTXL - 1 - idx : idx); }
    const int idx = (ch - 2) * 128 + s; return b * SEQ + (dir ? SEQ - 1 - idx : idx);
}
#define TR_READ6(r0, r1, r2, r3, r4, r5, a, o0, o1, o2, o3, o4, o5) asm volatile( \
    "ds_read_b64_tr_b16 %0, %6 offset:" #o0 "\n\tds_read_b64_tr_b16 %1, %6 offset:" #o1 "\n\tds_read_b64_tr_b16 %2, %6 offset:" #o2 "\n\t" \
    "ds_read_b64_tr_b16 %3, %6 offset:" #o3 "\n\tds_read_b64_tr_b16 %4, %6 offset:" #o4 "\n\tds_read_b64_tr_b16 %5, %6 offset:" #o5 "\n\ts_waitcnt lgkmcnt(0)" \
    : "=&v"(r0), "=&v"(r1), "=&v"(r2), "=&v"(r3), "=&v"(r4), "=&v"(r5) : "v"(a) : "memory")
#define TR_READ8(r0, r1, r2, r3, r4, r5, r6, r7, a, b, o0, o1, p0, p1, p2, p3, p4, p5) asm volatile( \
    "ds_read_b64_tr_b16 %0, %8 offset:" #o0 "\n\tds_read_b64_tr_b16 %1, %8 offset:" #o1 "\n\t" \
    "ds_read_b64_tr_b16 %2, %9 offset:" #p0 "\n\tds_read_b64_tr_b16 %3, %9 offset:" #p1 "\n\tds_read_b64_tr_b16 %4, %9 offset:" #p2 "\n\t" \
    "ds_read_b64_tr_b16 %5, %9 offset:" #p3 "\n\tds_read_b64_tr_b16 %6, %9 offset:" #p4 "\n\tds_read_b64_tr_b16 %7, %9 offset:" #p5 "\n\ts_waitcnt lgkmcnt(0)" \
    : "=&v"(r0), "=&v"(r1), "=&v"(r2), "=&v"(r3), "=&v"(r4), "=&v"(r5), "=&v"(r6), "=&v"(r7) : "v"(a), "v"(b) : "memory")
struct FfnItem { unsigned long long s0, s1; f16* dst; int ld, ldd, k0, n0, mode; };
__device__ __forceinline__ void ffn_item(unsigned char* ws, LAS unsigned char* lds, int L, int it, unsigned long long& s0, unsigned long long& s1, f16*& dst, int& ld, int& ldd, int& k0, int& n0, int& mode) {
    const bool moe = (L & 1); const int fi = L >> 1, nexp = moe ? NE : 1;
    const int e = it / FFN_ITEMS, r = it - e * FFN_ITEMS;
    const size_t eo = (size_t)(fi * nexp + e) * D * DFF;
    unsigned char* W = ws + WS_W;
    if (r < 16 * (NFF2 / 32)) { mode = 1; s0 = (unsigned long long)((moe ? INP(I_MW1) : INP(I_FW1)) + eo); s1 = (unsigned long long)((moe ? INP(I_MW3) : INP(I_FW3)) + eo);
        ld = DFF; ldd = D; k0 = 64 * (r / (NFF2 / 32)); n0 = 32 * (r % (NFF2 / 32)); dst = (f16*)(W + (moe ? WO_13 : WO_13D)) + (size_t)e * NFF2 * D; }
    else { const int r2 = r - 16 * (NFF2 / 32); mode = 0; s0 = (unsigned long long)((moe ? INP(I_MW2) : INP(I_FW2)) + eo); s1 = s0;
        ld = D; ldd = DFF; k0 = 64 * (r2 / 32); n0 = 32 * (r2 % 32); dst = (f16*)(W + (moe ? WO_2 : WO_2D)) + (size_t)e * D * DFF; }
}
__device__ __forceinline__ void ffn_dma_issue(unsigned char* ws, LAS unsigned char* lds, LAS unsigned char* cscr, int L, int it, int lane) {
    unsigned long long s0, s1; f16* dst; int ld, ldd, k0, n0, mode; ffn_item(ws, lds, L, it, s0, s1, dst, ld, ldd, k0, n0, mode);
    const int n = n0 + 4 * (lane & 7);
    const bool useS1 = (mode != 0) && (n & 4);
    const unsigned lo = useS1 ? (unsigned)s1 : (unsigned)s0, hi = useS1 ? (unsigned)(s1 >> 32) : (unsigned)(s0 >> 32);
    const float* sp = (const float*)(const __attribute__((address_space(1))) float*)(((unsigned long long)hi << 32) | lo);
    sp += (mode == 0 ? n : 4 * (n >> 3)) + (size_t)(k0 + (lane >> 3)) * ld;
#pragma unroll
    for (int j = 0; j < 8; ++j) __builtin_amdgcn_global_load_lds((const unsigned*)(sp + (size_t)(8 * j) * ld), (LAS unsigned*)(cscr + j * 1040), 16, 0, 2);
}
__device__ __forceinline__ void ffn_dma_finish(unsigned char* ws, LAS unsigned char* lds, LAS unsigned char* cscr, int L, int it, int lane) {
    unsigned long long s0, s1; f16* dst; int ld, ldd, k0, n0, mode; ffn_item(ws, lds, L, it, s0, s1, dst, ld, ldd, k0, n0, mode);
    const int c8 = lane & 7;
#pragma unroll
    for (int jj = 0; jj < 4; ++jj) { const int nn = (lane >> 3) + 8 * jj; const LAS float* sc = (const LAS float*)(cscr + c8 * 1040) + nn;
        f16x8 h;
#pragma unroll
        for (int q = 0; q < 8; ++q) h[q] = (f16)sc[q * 32];
        *(f16x8*)(dst + (size_t)(n0 + nn) * ldd + k0 + 8 * c8) = h; }
}
struct ConvSeg { int LA, a0, an, LB, b0, bn; };
__device__ __forceinline__ void mlstm_mfma_phase(unsigned char* ws, int layer, LAS unsigned char* lds, int vb, int nvb, int tid, const ConvSeg cs) {
    const int conv_n = cs.an + cs.bn;
    constexpr int KROW = 272, VROW = 112, CROW = 272;
    static_assert(16 * VROW == 1792 && 4 * VROW == 448 && 4 * KROW == 1088, "TR_READ offsets below are written out as literals");
    constexpr int OFF_K = 0, OFF_V = 128 * KROW, OFF_CT = OFF_V + 128 * VROW, OFF_G = OFF_CT + 48 * CROW, GBUF = 2560, OFF_RAW = OFF_G + 2 * GBUF;
    LAS unsigned char* Ks = lds + OFF_K; LAS unsigned char* Vs = lds + OFF_V; LAS unsigned char* CTs = lds + OFF_CT;
    const f16* P1 = (const f16*)(ws + WS_P1);
    const f16* QK = (const f16*)(ws + WS_QK);
    const float* MLG = (const float*)(ws + WS_MLG);
    float* HFB = (float*)(ws + WS_HFB);
    const float* gb = INP(I_GBIAS) + layer * 16;
    const int lane = tid & 63, w = __builtin_amdgcn_readfirstlane(tid >> 6), g = lane >> 4, c = lane & 15, cq = c >> 2, cp = c & 3;
    const int srow = tid >> 2, sq = tid & 3;
    LAS unsigned char* cscr = lds + OFF_RAW + 2 * 2304 * 4 + w * 8320;
    const int cgw = vb * NWAVES + w, cngw = nvb * NWAVES;
    for (int job = vb; job < 256; job += nvb) {
        const int b = job >> 5, h = (job >> 3) & 3, dir = (job >> 2) & 1, eq = job & 3;
        const float gbi = gb[dir * 8 + h], gbf = gb[dir * 8 + 4 + h];
        __syncthreads();
        for (int i = tid; i < 48 * CROW / 16; i += NTHREADS) *(LAS u32x4*)(CTs + 16 * i) = (u32x4){0u, 0u, 0u, 0u};
        if (sq == 0) { unsigned ob = 0x3C00u, zb = 0u; asm volatile("" : "+v"(ob), "+v"(zb));
            *(LAS u32x4*)(Vs + srow * VROW + 64) = (u32x4){ob, zb, zb, zb}; *(LAS u32x4*)(Vs + srow * VROW + 80) = (u32x4){zb, zb, zb, zb}; }
        f32x4 C[3];
#pragma unroll
        for (int et = 0; et < 3; ++et) C[et] = (f32x4){0.f, 0.f, 0.f, 0.f};
        float m = -1e30f;
        { LAS float* raw = (LAS float*)(lds + OFF_RAW);
          for (int i = tid; i < 2304; i += NTHREADS) { const int tk = ml_tok(b, dir, i >> 7, i & 127); raw[i] = MLG[(size_t)tk * 16 + dir * 8 + h]; raw[2304 + i] = MLG[(size_t)tk * 16 + dir * 8 + 4 + h]; } }
        f16x8 kreg[4], vreg, qreg[4];
        { const int tokS = ml_tok(b, dir, 0, srow);
#pragma unroll
          for (int i = 0; i < 4; ++i) kreg[i] = *(const f16x8*)(QK + (size_t)tokS * 1024 + 512 + h * 128 + (4 * i + sq) * 8);
          vreg = *(const f16x8*)(P1 + (size_t)tokS * NP1 + 2048 + h * 128 + eq * 32 + sq * 8);
          const int tokT = ml_tok(b, dir, 0, 16 * w + c);
#pragma unroll
          for (int kd = 0; kd < 4; ++kd) qreg[kd] = *(const f16x8*)(QK + (size_t)tokT * 1024 + h * 128 + 32 * kd + 8 * g);
        }
        __syncthreads();
#define ML_GATES(chn_) do { LAS float* gq = (LAS float*)(lds + OFF_G + ((chn_) & 1) * GBUF); const LAS float* raw = (const LAS float*)(lds + OFF_RAW) + (chn_) * 128; \
            const float ig0 = raw[lane] + gbi, ig1 = raw[lane + 64] + gbi, lf0 = log_sigmoid_(raw[2304 + lane] + gbf), lf1 = log_sigmoid_(raw[2304 + lane + 64] + gbf); \
            const float b0 = scan_sum64(lf0, lane), tot0 = __shfl(b0, 63), b1 = scan_sum64(lf1, lane) + tot0, b_end = __shfl(b1, 63); \
            const float ct0 = ig0 - b0, ct1 = ig1 - b1; \
            const float a0 = scan_max64(ct0, lane), am0 = __shfl(a0, 63), a1 = fmaxf(scan_max64(ct1, lane), am0), amax = __shfl(a1, 63); \
            const float M = fmaxf(m, amax), Mt0 = fmaxf(a0, m), Mt1 = fmaxf(a1, m); \
            gq[lane] = ct0; gq[lane + 64] = ct1; gq[128 + lane] = Mt0; gq[192 + lane] = Mt1; \
            gq[256 + lane] = __expf(-(b0 + Mt0)); gq[320 + lane] = __expf(-(b1 + Mt1)); gq[384 + lane] = __expf(m - Mt0); gq[448 + lane] = __expf(m - Mt1); \
            ((LAS f16*)(gq + 512))[lane] = (f16)__expf(ct0 - M); ((LAS f16*)(gq + 512))[lane + 64] = (f16)__expf(ct1 - M); \
            if (lane == 0) gq[576] = __expf(m - M); \
            m = b_end + M; } while (0)
        if (w == 0) ML_GATES(0);
        for (int ch = 0; ch < 18; ++ch) {
            LAS float* g_ct = (LAS float*)(lds + OFF_G + (ch & 1) * GBUF); LAS float* g_mt = g_ct + 128; LAS float* g_emt = g_ct + 256; LAS float* g_wi = g_ct + 384; LAS f16* g_w16 = (LAS f16*)(g_ct + 512);
#pragma unroll
            for (int i = 0; i < 4; ++i) *(LAS f16x8*)(Ks + srow * KROW + (4 * i + sq) * 16) = kreg[i];
            *(LAS f16x8*)(Vs + srow * VROW + sq * 16) = vreg;
            f16x8 qf[4];
#pragma unroll
            for (int kd = 0; kd < 4; ++kd) qf[kd] = qreg[kd];
            const int tokT = ml_tok(b, dir, ch, 16 * w + c);
            __syncthreads();
            if (conv_n > 0 && ch > 0) { const int itp = (ch - 1) * cngw + cgw; if (itp < conv_n) { asm volatile("s_waitcnt vmcnt(2)" ::: "memory"); ffn_dma_finish(ws, lds, cscr, itp < cs.an ? cs.LA : cs.LB, itp < cs.an ? cs.a0 + itp : cs.b0 + itp - cs.an, lane); } }
            if (ch + 1 < 18) { const int tokS = ml_tok(b, dir, ch + 1, srow);
#pragma unroll
                for (int i = 0; i < 4; ++i) kreg[i] = *(const f16x8*)(QK + (size_t)tokS * 1024 + 512 + h * 128 + (4 * i + sq) * 8);
                vreg = *(const f16x8*)(P1 + (size_t)tokS * NP1 + 2048 + h * 128 + eq * 32 + sq * 8);
                const int tokN = ml_tok(b, dir, ch + 1, 16 * w + c);
#pragma unroll
                for (int kd = 0; kd < 4; ++kd) qreg[kd] = *(const f16x8*)(QK + (size_t)tokN * 1024 + h * 128 + 32 * kd + 8 * g);
            }
            const float decay = g_ct[576];
            f32x4 st[8];
#pragma unroll
            for (int j = 0; j < 8; ++j) { st[j] = (f32x4){0.f, 0.f, 0.f, 0.f};
                if (j <= w) {
#pragma unroll
                    for (int ks = 0; ks < 4; ++ks) { const f16x8 a = *(const LAS f16x8*)(Ks + (16 * j + c) * KROW + (32 * ks + 8 * g) * 2);
                        st[j] = __builtin_amdgcn_mfma_f32_16x16x32_f16(a, qf[ks], st[j], 0, 0, 0); } } }
            const int tl = 16 * w + c; const float mt = g_mt[tl];
            f16x8 pf[4];
#pragma unroll
            for (int ks = 0; ks < 4; ++ks) {
#pragma unroll
                for (int hh = 0; hh < 2; ++hh) { const int j = 2 * ks + hh;
                    if (j <= w) { const f32x4 cv = *(const LAS f32x4*)(g_ct + 16 * j + 4 * g);
#pragma unroll
                        for (int i = 0; i < 4; ++i) { const int sl = 16 * j + 4 * g + i; const float v = (sl <= tl) ? st[j][i] * __expf(cv[i] - mt) : 0.f; pf[ks][4 * hh + i] = (f16)v; } }
                    else {
#pragma unroll
                        for (int i = 0; i < 4; ++i) pf[ks][4 * hh + i] = (f16)0.f; } } }
            if (conv_n > 0) { const int itc = ch * cngw + cgw; if (itc < conv_n) { LDS_WAIT(); ffn_dma_issue(ws, lds, cscr, itc < cs.an ? cs.LA : cs.LB, itc < cs.an ? cs.a0 + itc : cs.b0 + itc - cs.an, lane); } }
            f32x4 o1[3], o2[3];
#pragma unroll
            for (int et = 0; et < 3; ++et) { o1[et] = (f32x4){0.f, 0.f, 0.f, 0.f}; o2[et] = (f32x4){0.f, 0.f, 0.f, 0.f}; }
            const unsigned vs_base = (unsigned)(size_t)Vs, ks_base = (unsigned)(size_t)Ks;
#pragma unroll
            for (int ks = 0; ks < 4; ++ks) if (2 * ks <= w) {
                f16x4 t0, t1, t2, t3, t4, t5;
                const unsigned a0 = vs_base + (32 * ks + 4 * g + cq) * VROW + (4 * cp) * 2;
                TR_READ6(t0, t1, t2, t3, t4, t5, a0, 0, 1792, 32, 1824, 64, 1856);
                o1[0] = __builtin_amdgcn_mfma_f32_16x16x32_f16(__builtin_shufflevector(t0, t1, 0, 1, 2, 3, 4, 5, 6, 7), pf[ks], o1[0], 0, 0, 0);
                o1[1] = __builtin_amdgcn_mfma_f32_16x16x32_f16(__builtin_shufflevector(t2, t3, 0, 1, 2, 3, 4, 5, 6, 7), pf[ks], o1[1], 0, 0, 0);
                o1[2] = __builtin_amdgcn_mfma_f32_16x16x32_f16(__builtin_shufflevector(t4, t5, 0, 1, 2, 3, 4, 5, 6, 7), pf[ks], o1[2], 0, 0, 0); }
#pragma unroll
            for (int kd = 0; kd < 4; ++kd) {
#pragma unroll
                for (int et = 0; et < 3; ++et) { const f16x8 av = *(const LAS f16x8*)(CTs + (16 * et + c) * CROW + (32 * kd + 8 * g) * 2);
                    o2[et] = __builtin_amdgcn_mfma_f32_16x16x32_f16(av, qf[kd], o2[et], 0, 0, 0); } }
            { const float wi = g_wi[tl];
              const float denl = o1[2][0] + wi * o2[2][0];
              const float den = __shfl(denl, c);
              const float inv = 1.f / fmaxf(fabsf(den), g_emt[tl]);
              float* hp = HFB + ((size_t)dir * MT + tokT) * 512 + h * 128 + eq * 32 + 4 * g;
#pragma unroll
              for (int et = 0; et < 2; ++et) *(f32x4*)(hp + 16 * et) = (o1[et] + o2[et] * wi) * inv; }
#pragma unroll
            for (int et = 0; et < 3; ++et) C[et] = C[et] * decay;
#pragma unroll
            for (int ks = 0; ks < 4; ++ks) { f16x4 k0, k1, v0, v1, v2, v3, v4, v5;
                const unsigned ka = ks_base + (32 * ks + 8 * g + cq) * KROW + (16 * w + 4 * cp) * 2;
                const unsigned va = vs_base + (32 * ks + 8 * g + cq) * VROW + (4 * cp) * 2;
                TR_READ8(k0, k1, v0, v1, v2, v3, v4, v5, ka, va, 0, 1088, 0, 448, 32, 480, 64, 512);
                f16x8 kt = __builtin_shufflevector(k0, k1, 0, 1, 2, 3, 4, 5, 6, 7);
                const f16x8 wv = *(const LAS f16x8*)(g_w16 + 32 * ks + 8 * g);
                kt = kt * wv;
                C[0] = __builtin_amdgcn_mfma_f32_16x16x32_f16(kt, __builtin_shufflevector(v0, v1, 0, 1, 2, 3, 4, 5, 6, 7), C[0], 0, 0, 0);
                C[1] = __builtin_amdgcn_mfma_f32_16x16x32_f16(kt, __builtin_shufflevector(v2, v3, 0, 1, 2, 3, 4, 5, 6, 7), C[1], 0, 0, 0);
                C[2] = __builtin_amdgcn_mfma_f32_16x16x32_f16(kt, __builtin_shufflevector(v4, v5, 0, 1, 2, 3, 4, 5, 6, 7), C[2], 0, 0, 0); }
            if (w == 0 && ch + 1 < 18) ML_GATES(ch + 1);
            __syncthreads();
#pragma unroll
            for (int et = 0; et < 3; ++et) { f16x4 cv; cv[0] = (f16)C[et][0]; cv[1] = (f16)C[et][1]; cv[2] = (f16)C[et][2]; cv[3] = (f16)C[et][3];
                *(LAS f16x4*)(CTs + (16 * et + c) * CROW + (16 * w + 4 * g) * 2) = cv; }
        }
        if (conv_n > 0) { const int itp = 17 * cngw + cgw; if (itp < conv_n) { asm volatile("s_waitcnt vmcnt(2)" ::: "memory"); ffn_dma_finish(ws, lds, cscr, itp < cs.an ? cs.LA : cs.LB, itp < cs.an ? cs.a0 + itp : cs.b0 + itp - cs.an, lane); } }
#undef ML_GATES
    }
    __syncthreads();
}

__device__ __forceinline__ void na_mfma_phase(unsigned char* ws, int layer, LAS unsigned char* lds, int vb, int nvb, int tid) {
    constexpr int VROW = 144;
    constexpr int OFF_B = 768 * VROW, OFF_M = OFF_B + 2048;
    LAS unsigned char* Vs = lds; LAS float* Bs = (LAS float*)(lds + OFF_B); LAS float* Ms = (LAS float*)(lds + OFF_M);
    const f16* P1 = (const f16*)(ws + WS_P1);
    f16* CAT = (f16*)(ws + WS_CAT);
    const int lane = tid & 63, w = __builtin_amdgcn_readfirstlane(tid >> 6), g = lane >> 4, c = lane & 15, cq = c >> 2, cp = c & 3;
    const int qt = w & 3, kh = w >> 2;
    int kst = 16 * qt - 8; kst = kst < 0 ? 0 : (kst > 32 ? 32 : kst);
    const int nU = 1024 + ((layer == DEPTH - 1) ? 0 : 128);
    for (int un = vb; un < nU; un += nvb) {
        const bool lat = un < 1024;
        int b, r, h, qblk;
        if (lat) { b = un >> 7; r = (un >> 2) & 31; h = un & 3; qblk = 0; } else { const int u2 = un - 1024; b = u2 >> 4; h = (u2 >> 2) & 3; qblk = u2 & 3; r = 0; }
        int r0 = r - 4; r0 = r0 < 0 ? 0 : (r0 > 24 ? 24 : r0);
        const int qtok = lat ? b * SEQ + r * 64 + 16 * qt + c : ML + b * CTXL + qblk * 64 + 16 * qt + c;
        __syncthreads();
        {
            const int nch = (lat ? 768 : 256) * 8;
            for (int ch = tid; ch < nch; ch += NTHREADS) { const int row = ch >> 3, pc = ch & 7;
                const int tok = lat ? (row < 512 ? b * SEQ + (r0 + (row >> 6)) * 64 + (row & 63) : ML + b * CTXL + row - 512) : ML + b * CTXL + row;
                *(LAS u32x4*)(Vs + row * VROW + pc * 16) = *(const u32x4*)(P1 + (size_t)tok * NP1 + 768 + h * 64 + pc * 8); }
            if (lat) { const float* rp = INP(I_RPB) + (size_t)(layer * 4 + h) * 465; for (int i = tid; i < 465; i += NTHREADS) Bs[i] = rp[i]; }
        }
        f16x8 qf[2];
#pragma unroll
        for (int ks = 0; ks < 2; ++ks) qf[ks] = *(const f16x8*)(P1 + (size_t)qtok * NP1 + 256 + h * 64 + 32 * ks + 8 * g);
        f32x4 st[16];
#pragma unroll
        for (int idx = 0; idx < 16; ++idx) {
            st[idx] = (f32x4){0.f, 0.f, 0.f, 0.f};
            if (idx >= 8 || lat) {
                int tok;
                if (idx < 8) tok = b * SEQ + (r0 + kh * 4 + (idx >> 1)) * 64 + kst + 16 * (idx & 1) + c;
                else tok = ML + b * CTXL + kh * 128 + 16 * (idx - 8) + c;
                const f16* kp = P1 + (size_t)tok * NP1 + 512 + h * 64 + 8 * g;
                const f16x8 k0 = *(const f16x8*)kp, k1 = *(const f16x8*)(kp + 32);
                st[idx] = __builtin_amdgcn_mfma_f32_16x16x32_f16(k0, qf[0], st[idx], 0, 0, 0);
                st[idx] = __builtin_amdgcn_mfma_f32_16x16x32_f16(k1, qf[1], st[idx], 0, 0, 0);
            }
        }
        __syncthreads();
        const int qc = 16 * qt + c; int cs = qc - 8; cs = cs < 0 ? 0 : (cs > 48 ? 48 : cs);
        float mx = -3.0e38f;
#pragma unroll
        for (int idx = 0; idx < 16; ++idx) {
            if (idx < 8) {
                const int wrow = kh * 4 + (idx >> 1);
#pragma unroll
                for (int i = 0; i < 4; ++i) { const int kc = kst + 16 * (idx & 1) + 4 * g + i; const bool ok = lat && kc >= cs && kc < cs + 16;
                    const float bias = ok ? Bs[(r0 + wrow - r + 7) * 31 + kc - qc + 15] : 0.f;
                    st[idx][i] = ok ? st[idx][i] + bias : -1.0e30f; }
            }
#pragma unroll
            for (int i = 0; i < 4; ++i) mx = fmaxf(mx, st[idx][i]);
        }
        mx = fmaxf(mx, __shfl_xor(mx, 16)); mx = fmaxf(mx, __shfl_xor(mx, 32));
        float l = 0.f;
        f16x8 pf[8];
#pragma unroll
        for (int idx = 0; idx < 16; ++idx) {
#pragma unroll
            for (int i = 0; i < 4; ++i) { const float p = __expf(st[idx][i] - mx); l += p; pf[idx >> 1][4 * (idx & 1) + i] = (f16)p; }
        }
        l += __shfl_xor(l, 16); l += __shfl_xor(l, 32);
        f32x4 o[4];
#pragma unroll
        for (int dt = 0; dt < 4; ++dt) o[dt] = (f32x4){0.f, 0.f, 0.f, 0.f};
        const unsigned vs_base = (unsigned)(size_t)Vs;
#pragma unroll
        for (int kk = 0; kk < 8; ++kk) {
            if (kk >= 4 || lat) {
                int rb0, rb1;
                if (kk < 4) { rb0 = (kh * 4 + kk) * 64 + kst; rb1 = rb0 + 16; }
                else { rb0 = (lat ? 512 : 0) + kh * 128 + 16 * (2 * kk - 8); rb1 = rb0 + 16; }
                { f16x4 x0, x1, x2, x3, y0, y1, y2, y3;
                  const unsigned a0 = vs_base + (rb0 + 4 * g + cq) * VROW + (4 * cp) * 2, a1 = vs_base + (rb1 + 4 * g + cq) * VROW + (4 * cp) * 2;
                  asm volatile("ds_read_b64_tr_b16 %0, %8\n\tds_read_b64_tr_b16 %1, %8 offset:32\n\tds_read_b64_tr_b16 %2, %8 offset:64\n\tds_read_b64_tr_b16 %3, %8 offset:96\n\t"
                               "ds_read_b64_tr_b16 %4, %9\n\tds_read_b64_tr_b16 %5, %9 offset:32\n\tds_read_b64_tr_b16 %6, %9 offset:64\n\tds_read_b64_tr_b16 %7, %9 offset:96\n\ts_waitcnt lgkmcnt(0)"
                               : "=&v"(x0), "=&v"(x1), "=&v"(x2), "=&v"(x3), "=&v"(y0), "=&v"(y1), "=&v"(y2), "=&v"(y3) : "v"(a0), "v"(a1) : "memory");
                  o[0] = __builtin_amdgcn_mfma_f32_16x16x32_f16(__builtin_shufflevector(x0, y0, 0, 1, 2, 3, 4, 5, 6, 7), pf[kk], o[0], 0, 0, 0);
                  o[1] = __builtin_amdgcn_mfma_f32_16x16x32_f16(__builtin_shufflevector(x1, y1, 0, 1, 2, 3, 4, 5, 6, 7), pf[kk], o[1], 0, 0, 0);
                  o[2] = __builtin_amdgcn_mfma_f32_16x16x32_f16(__builtin_shufflevector(x2, y2, 0, 1, 2, 3, 4, 5, 6, 7), pf[kk], o[2], 0, 0, 0);
                  o[3] = __builtin_amdgcn_mfma_f32_16x16x32_f16(__builtin_shufflevector(x3, y3, 0, 1, 2, 3, 4, 5, 6, 7), pf[kk], o[3], 0, 0, 0); }
            }
        }
        LAS float* mp = Ms + (qt * 64 + lane) * 18;
        if (kh == 1) { mp[0] = mx; mp[1] = l;
#pragma unroll
            for (int dt = 0; dt < 4; ++dt) *(LAS f32x4*)(mp + 2 + 4 * dt) = o[dt]; }
        __syncthreads();
        if (kh == 0) {
            const float mx2 = mp[0], l2 = mp[1], mxn = fmaxf(mx, mx2), fa = __expf(mx - mxn), fb = __expf(mx2 - mxn);
            const float inv = 1.f / (l * fa + l2 * fb);
            f16* op = CAT + (size_t)qtok * D + 256 + h * 64 + 4 * g;
#pragma unroll
            for (int dt = 0; dt < 4; ++dt) { const f32x4 o2 = *(const LAS f32x4*)(mp + 2 + 4 * dt); const f32x4 v = (o[dt] * fa + o2 * fb) * inv;
                f16x4 hv; hv[0] = (f16)v[0]; hv[1] = (f16)v[1]; hv[2] = (f16)v[2]; hv[3] = (f16)v[3];
                *(f16x4*)(op + 16 * dt) = hv; }
        }
    }
    __syncthreads();
}

__device__ __forceinline__ void mout_phase(unsigned char* ws, LAS unsigned char* lds, int layer, int gw, int ngw, int lane) {
    const f16* P1 = (const f16*)(ws + WS_P1);
    const float* HFB = (const float*)(ws + WS_HFB);
    f16* CAT = (f16*)(ws + WS_CAT);
    const float* nw = INP(I_NORMW) + layer * 512;
    const int nrows = (layer == DEPTH - 1) ? ML : MT;
    const f32x4 nw0 = *(const f32x4*)(nw + 8 * lane), nw1 = *(const f32x4*)(nw + 8 * lane + 4);
    f32x4 a0n, a1n, b0n, b1n; f16x8 ogn;
#define MOUT_LOAD(r_) do { const float* pf = HFB + (size_t)(r_) * 512 + 8 * lane; const float* pb = HFB + ((size_t)MT + (r_)) * 512 + 8 * lane; \
        a0n = *(const f32x4*)pf; a1n = *(const f32x4*)(pf + 4); b0n = *(const f32x4*)pb; b1n = *(const f32x4*)(pb + 4); ogn = *(const f16x8*)(P1 + (size_t)(r_) * NP1 + 2560 + 8 * lane); } while (0)
    if (gw < nrows) MOUT_LOAD(gw);
    for (int r = gw; r < nrows; r += ngw) {
        const f32x4 a0 = a0n, a1 = a1n, b0 = b0n, b1 = b1n; const f16x8 og = ogn;
        if (r + ngw < nrows) MOUT_LOAD(r + ngw);
        float v[8] = {a0[0] + b0[0], a0[1] + b0[1], a0[2] + b0[2], a0[3] + b0[3], a1[0] + b1[0], a1[1] + b1[1], a1[2] + b1[2], a1[3] + b1[3]};
        float s = 0.f;
#pragma unroll
        for (int i = 0; i < 8; ++i) s += v[i];
        s = row16_sum(s);
        const float mean = s * (1.f / 128.f); float q = 0.f;
#pragma unroll
        for (int i = 0; i < 8; ++i) { v[i] -= mean; q += v[i] * v[i]; }
        q = row16_sum(q);
        const float rstd = 1.f / sqrtf(q * (1.f / 128.f) + LN_EPS);
        f16x8 h;
#pragma unroll
        for (int i = 0; i < 8; ++i) h[i] = (f16)((float)og[i] * v[i] * rstd * (i < 4 ? nw0[i] : nw1[i - 4]));
        *(f16x8*)(CAT + (size_t)r * D + 512 + 8 * lane) = h;
    }
#undef MOUT_LOAD
}

__device__ __forceinline__ void moe_tail(int nblk, int& tail_blocks, int& S) {
    const int R = (nblk & 63) * 4;
    tail_blocks = nblk & 63; S = R == 0 ? 1 : (R <= 36 ? 7 : (R <= 64 ? 4 : (R <= 128 ? 2 : 1)));
    if (S == 1) tail_blocks = 0;
}
constexpr int NPH = 13;
#if MK_FUSED
#define GRID_BAR() xcd_barrier(bar)
#else
#define GRID_BAR() do {} while (0)
#endif
template <int layer>
__device__ __forceinline__ void layer_body(const Args& args, LAS unsigned char* lds, const int tid0, const int wave0, const int vb0, const int nvb0,
                                           unsigned char* ws0, unsigned* ctl, const XcdBarrier& bar, const int s_lo, const int s_hi) {
        constexpr bool last = (layer == DEPTH - 1), moe = (layer & 1) != 0;
        constexpr int mi = layer >> 1;
        const int nrows = last ? ML : MT;
#define STEP(p) (layer * NPH + (p))
#if MK_FUSED
#define RUN(p) (((PH_MASK >> (p)) & 1) != 0)
#else
#define RUN(p) (((PH_MASK >> (p)) & 1) && STEP(p) >= s_lo && STEP(p) < s_hi)
#endif
#define NREP(p) (((p) == PROBE_PH && (PROBE_LAYER < 0 || layer == PROBE_LAYER)) ? 1 + PROBE_REP : 1)
#define FRESH_TID() int tid = tid0; asm volatile("" : "+v"(tid)); const int lane = tid & 63; (void)lane; \
    const unsigned long long wsi_ = opaque_u64((unsigned long long)ws0); unsigned char* ws = (unsigned char*)(__attribute__((address_space(1))) unsigned char*)wsi_; const int wave = opaque_u32(wave0), vb = opaque_u32(vb0), nvb = opaque_u32(nvb0); const int gw = vb * NWAVES + wave, ngw = nvb * NWAVES; (void)gw; (void)ngw; \
    f16* U16 = (f16*)(ws + WS_U16); f16* P1 = (f16*)(ws + WS_P1); f16* CAT = (f16*)(ws + WS_CAT); f16* Z16 = (f16*)(ws + WS_Z16); \
    f16* YF = (f16*)(ws + WS_YF); f16* XS = (f16*)(ws + WS_XS); f16* HB16 = (f16*)(ws + WS_P1); f16* AMOE = (f16*)(ws + WS_HFB); unsigned char* W = ws + WS_W; \
    int2* TOKE = (int2*)(ws + WS_TOK + TK_E); float2* TOKP = (float2*)(ws + WS_TOK + TK_P); int2* TOKPOS = (int2*)(ws + WS_TOK + TK_POS); int2* TOKDEST = (int2*)(ws + WS_TOK + TK_DEST); \
    int* BLKE = (int*)(ws + WS_TOK + TK_BLKE); \
    (void)U16; (void)P1; (void)CAT; (void)Z16; (void)YF; (void)XS; (void)HB16; (void)AMOE; (void)W; (void)TOKE; (void)TOKP; (void)TOKPOS; (void)TOKDEST; (void)BLKE
#if MK_FUSED
#define SEAM(p) do { if (!(last && (p) == NPH - 1)) GRID_BAR(); } while (0)
#else
#define SEAM(p) do { } while (0)
#endif

        if (layer == 0 && RUN(0)) { for (int rep_ = 0; rep_ < NREP(0); ++rep_) {
            FRESH_TID();
            {
                LAS float* sv = (LAS float*)(lds + 69632);
                LAS float* red = sv + 9 * 1024;
                for (int i = tid; i < 9 * 1024; i += NTHREADS) { const int r = i >> 10, k = i & 1023; const float c = r < 8 ? INP(I_C)[r * 1024 + k] : INP(I_CCTX)[k]; sv[i] = silu_(c); }
                __syncthreads();
                const int kg = tid >> 7, jj = tid & 127;
                for (int job = vb; job < 4 * 48; job += nvb) {
                    const int l = job / 48, j = (job % 48) * 128 + jj;
                    const float* wp = INP(I_WMOD) + (size_t)l * D * 6144 + j;
                    float acc[9];
#pragma unroll
                    for (int r = 0; r < 9; ++r) acc[r] = 0.f;
                    for (int k = kg * 256; k < kg * 256 + 256; ++k) { const float w = wp[(size_t)k * 6144];
#pragma unroll
                        for (int r = 0; r < 9; ++r) acc[r] += sv[r * 1024 + k] * w; }
#pragma unroll
                    for (int r = 0; r < 9; ++r) red[(kg * 9 + r) * 128 + jj] = acc[r];
                    __syncthreads();
                    for (int i = tid; i < 9 * 128; i += NTHREADS) { const int r = i >> 7, c = i & 127;
                        const float s = (red[(0 * 9 + r) * 128 + c] + red[(1 * 9 + r) * 128 + c]) + (red[(2 * 9 + r) * 128 + c] + red[(3 * 9 + r) * 128 + c]);
                        const int jc = (job % 48) * 128 + c;
                        ((float*)(ws + WS_MOD))[(size_t)(l * 9 + r) * 6144 + jc] = s + INP(I_BMOD)[l * 6144 + jc]; }
                    __syncthreads();
                }
            }
            if (vb == 0) for (int i = tid; i < 2048; i += NTHREADS) { const int p = i >> 5, fi = i & 31; const float inv = exp2f(-(float)fi * (13.287712379549449f / 32.f));
                float sn, cs; sincosf((float)p * inv, &sn, &cs); ((float2*)(ws + WS_ROPE))[i] = make_float2(cs, sn); }
            conv_layer(ws, 0, lds, gw, ngw, wave, lane, 0);
            SEAM(0);
        } }
        if (layer == 0 && RUN(1)) { for (int rep_ = 0; rep_ < NREP(1); ++rep_) {
            FRESH_TID();
            LAS float* GT = (LAS float*)(lds + 73728);
            load_gate_table(lds, 0, GT, tid);
            { f32x4 xn[4], shn[4], scn[4];
#define LOAD_MOD0(r_) do { const float* q_ = mod_row(ws, lds, 0, (r_)); _Pragma("unroll") for (int j = 0; j < 4; ++j) { shn[j] = *(const f32x4*)(q_ + 256 * j + 4 * lane); scn[j] = *(const f32x4*)(q_ + 1024 + 256 * j + 4 * lane); } } while (0)
              if (gw < MT) { load_x<0>(ws, lds, gw, xn, lane); LOAD_MOD0(gw); }
              for (int r = gw; r < MT; r += ngw) { f32x4 x[4], sh[4], sc[4];
#pragma unroll
                  for (int j = 0; j < 4; ++j) { x[j] = xn[j]; sh[j] = shn[j]; sc[j] = scn[j]; }
                  if (r + ngw < MT) { load_x<0>(ws, lds, r + ngw, xn, lane); LOAD_MOD0(r + ngw); }
                  row_A_pre(ws, r, x, sh, sc, GT, lane); } }
            SEAM(1);
        } }
        if (RUN(2)) { for (int rep_ = 0; rep_ < NREP(2); ++rep_) {
            FRESH_TID();
            EpiP1 E{P1};
            gemm_run(lds, U16, D, D, MT, NP1, (const f16*)(W + WO_IN), 0, nullptr, E, vb, nvb, tid);
            SEAM(2);
        } }
        if (RUN(3)) { for (int rep_ = 0; rep_ < NREP(3); ++rep_) {
            FRESH_TID();
            pool_phase(ws, layer, lds, vb, nvb, tid);
#if USE_NA_MFMA
            na_mfma_phase(ws, layer, lds, vb, nvb, tid);
#else
            na_phase(ws, layer, lds, gw, ngw, wave, lane);
#endif
            mlprep_phase(ws, lds, layer, gw, ngw, lane);
            SEAM(3);
        } }
#if USE_MLSTM_MFMA
        if (RUN(4)) { for (int rep_ = 0; rep_ < NREP(4); ++rep_) { FRESH_TID(); ConvSeg cs; conv_seg(layer, nvb, cs.LA, cs.a0, cs.an, cs.LB, cs.b0, cs.bn); mlstm_mfma_phase(ws, layer, lds, vb, nvb, tid, cs); SEAM(4); } }
#else
        if (RUN(4)) { for (int rep_ = 0; rep_ < NREP(4); ++rep_) { FRESH_TID(); mlstm_naive_phase(ws, layer, lds, vb, nvb, tid); SEAM(4); } }
#endif
        if (RUN(5)) { for (int rep_ = 0; rep_ < NREP(5); ++rep_) { FRESH_TID(); mout_phase(ws, lds, layer, gw, ngw, lane); SEAM(5); } }
        if (RUN(6)) { for (int rep_ = 0; rep_ < NREP(6); ++rep_) {
            FRESH_TID();
            { EpiMerge E{P1, Z16, (f16*)(ws + WS_YF + YF_PART)}; gemm_run(lds, CAT, D, D, nrows, D, (const f16*)(W + WO_BP), 0, nullptr, E, vb, nvb, tid, last ? 0 : MC, 4); }
            SEAM(6);
        } }
        if (RUN(7)) { for (int rep_ = 0; rep_ < NREP(7); ++rep_) {
            FRESH_TID();
            if constexpr (!last) {
                const f16* PZ = (const f16*)(ws + WS_YF + YF_PART);
                for (int r = gw; r < MC; r += ngw) { f32x4 z[4]; load_row_sum(PZ + (size_t)r * D, (size_t)MC * D, 4, z, lane); store_row_h(Z16 + (size_t)(ML + r) * D, z, lane); }
                GRID_BAR();
            }
            EpiF32 E{YF, D, (f16*)(ws + WS_YF + YF_PART), ML, MC};
            gemm_run(lds, Z16, D, D, nrows, D, (const f16*)(W + WO_OUT), 0, nullptr, E, vb, nvb, tid, last ? 0 : MC, 4);
            SEAM(7);
        } }
        if (RUN(8)) { for (int rep_ = 0; rep_ < NREP(8); ++rep_) {
            FRESH_TID();
            LAS float* RT = (LAS float*)lds;
            LAS int* lcnt = (LAS int*)(lds + 32768);
            LAS int* lrec = lcnt + 128;
            if (moe) { load_router_table(lds, mi, RT, tid); if (tid < 128) lcnt[tid] = 0; __syncthreads(); }
            const float* g1p = INP(I_LN1G) + layer * D; const float* b1p = INP(I_LN1B) + layer * D;
            int slot = wave;
            f32x4 xn[4], yn[4];
            const f16* PARTp = (const f16*)(ws + WS_YF + YF_PART);
#define LOAD_Y(r_, dst_) do { if ((r_) >= ML) load_row_sum(PARTp + (size_t)((r_) - ML) * D, (size_t)MC * D, 4, dst_, lane); else load_row_h(YF + (size_t)(r_) * D, dst_, lane); } while (0)
            f32x4 lg_[4], lb_[4], mgn[4], mshn[4], mscn[4];
#pragma unroll
            for (int j = 0; j < 4; ++j) { lg_[j] = *(const f32x4*)(g1p + 256 * j + 4 * lane); lb_[j] = *(const f32x4*)(b1p + 256 * j + 4 * lane); }
#define LOAD_MOD(r_) do { const float* m_ = mod_row(ws, lds, layer, (r_)); _Pragma("unroll") for (int j = 0; j < 4; ++j) { mgn[j] = *(const f32x4*)(m_ + 2048 + 256 * j + 4 * lane); mshn[j] = *(const f32x4*)(m_ + 3072 + 256 * j + 4 * lane); mscn[j] = *(const f32x4*)(m_ + 4096 + 256 * j + 4 * lane); } } while (0)
            if (gw < nrows) { load_x<layer>(ws, lds, gw, xn, lane); LOAD_Y(gw, yn); LOAD_MOD(gw); }
            for (int r = gw; r < nrows; r += ngw, slot += NWAVES) {
                f32x4 x[4], y[4], mg[4], msh[4], msc[4];
#pragma unroll
                for (int j = 0; j < 4; ++j) { x[j] = xn[j]; y[j] = yn[j]; mg[j] = mgn[j]; msh[j] = mshn[j]; msc[j] = mscn[j]; }
                if (r + ngw < nrows) { load_x<layer>(ws, lds, r + ngw, xn, lane); LOAD_Y(r + ngw, yn); LOAD_MOD(r + ngw); }
#pragma unroll
                for (int j = 0; j < 4; ++j) x[j] = x[j] * ALPHA + mg[j] * y[j];
                float mean, rstd; ln_stats(x, mean, rstd);
#pragma unroll
                for (int j = 0; j < 4; ++j) x[j] = (x[j] - mean) * rstd * lg_[j] + lb_[j];
                store_row_h(XS + (size_t)r * D, x, lane);
                ln_stats(x, mean, rstd);
                f32x4 u[4];
#pragma unroll
                for (int j = 0; j < 4; ++j) { const int k = 256 * j + 4 * lane; u[j] = (x[j] - mean) * rstd * (msc[j] + 1.f) + msh[j];
                    f16x4 h; h[0] = (f16)u[j][0]; h[1] = (f16)u[j][1]; h[2] = (f16)u[j][2]; h[3] = (f16)u[j][3];
                    *(f16x4*)(U16 + (size_t)r * D + k) = h; }
                if (moe) {
                    float lg[8];
                    { const float s0 = dot4_rows(u, RT, 0, lane), s1 = dot4_rows(u, RT, 4, lane);
#pragma unroll
                      for (int e = 0; e < 4; ++e) { lg[e] = __shfl(s0, 16 * e) + INP(I_RB)[mi * 8 + e]; lg[4 + e] = __shfl(s1, 16 * e) + INP(I_RB)[mi * 8 + 4 + e]; } }
                    int e1 = 0; float l1 = lg[0];
#pragma unroll
                    for (int e = 1; e < 8; ++e) if (lg[e] > l1) { l1 = lg[e]; e1 = e; }
                    int e2 = -1; float l2 = -3.0e38f;
#pragma unroll
                    for (int e = 0; e < 8; ++e) if (e != e1 && lg[e] > l2) { l2 = lg[e]; e2 = e; }
                    const float p2 = __expf(l2 - l1), inv = 1.f / (1.f + p2);
                    if (lane == 0) { const int lp1 = lcnt[wave * 8 + e1], lp2 = lcnt[wave * 8 + e2]; lcnt[wave * 8 + e1] = lp1 + 1; lcnt[wave * 8 + e2] = lp2 + 1;
                        lrec[slot * 4 + 0] = e1; lrec[slot * 4 + 1] = e2; lrec[slot * 4 + 2] = lp1; lrec[slot * 4 + 3] = lp2;
                        TOKE[r] = make_int2(e1, e2); TOKP[r] = make_float2(inv, p2 * inv); }
                }
            }
            if (moe) {
                __syncthreads();
                if (tid < 64) { const int w_ = tid >> 3, e_ = tid & 7; int b_ = 0; for (int q = 0; q < w_; ++q) b_ += lcnt[q * 8 + e_]; lcnt[64 + tid] = b_;
                    if (w_ == 7) ((int*)(ws + WS_TOK + TK_BCNT))[vb * 8 + e_] = b_ + lcnt[56 + e_]; }
                __syncthreads();
                slot = wave;
                for (int r = gw; r < nrows; r += ngw, slot += NWAVES)
                    if (lane == 0) TOKPOS[r] = make_int2(lcnt[64 + wave * 8 + lrec[slot * 4 + 0]] + lrec[slot * 4 + 2], lcnt[64 + wave * 8 + lrec[slot * 4 + 1]] + lrec[slot * 4 + 3]);
            }
            SEAM(8);
        } }
        if (moe && RUN(9)) { for (int rep_ = 0; rep_ < NREP(9); ++rep_) {
            FRESH_TID();
            LAS int* ps = (LAS int*)lds;
            LAS int* bc = ps + 16;
            { const int* BC = (const int*)(ws + WS_TOK + TK_BCNT); for (int i = tid; i < nvb * 8; i += NTHREADS) bc[i] = BC[i]; }
            __syncthreads();
            if (tid < 8) { int tot = 0, mine = 0; for (int q = 0; q < nvb; ++q) { const int c = bc[q * 8 + tid]; mine += (q < vb) ? c : 0; tot += c; } bc[nvb * 8 + tid] = tot; bc[nvb * 8 + 8 + tid] = mine; }
            __syncthreads();
            if (tid == 0) { int acc = 0;
#pragma unroll 1
                for (int e = 0; e < 8; ++e) { ps[e] = acc + bc[nvb * 8 + 8 + e]; const int c = bc[nvb * 8 + e]; acc += ((c + 255) >> 8) * 256; }
                ps[8] = acc; }
            __syncthreads();
            if (vb == 0) { const int nb = ps[8] >> 8; if (tid == 0) BLKE[160] = nb;
                if (tid < nb) { int e = 0;
#pragma unroll 1
                    for (int q = 1; q < 8; ++q) if (tid * 256 >= ps[q]) e = q;
                    BLKE[tid] = e; } }
            { int2 en = make_int2(0, 0), pnx = make_int2(0, 0); u32x4 vn0, vn1;
#define GATHER_LOAD(r_) do { en = TOKE[(r_)]; pnx = TOKPOS[(r_)]; const u32x4* src_ = (const u32x4*)(U16 + (size_t)(r_) * D); vn0 = src_[lane]; vn1 = src_[lane + 64]; } while (0)
              if (gw < nrows) GATHER_LOAD(gw);
              for (int r = gw; r < nrows; r += ngw) {
                const int2 e = en, p = pnx; const u32x4 v0 = vn0, v1 = vn1;
                if (r + ngw < nrows) GATHER_LOAD(r + ngw);
                const int d0 = ps[e.x] + p.x, d1 = ps[e.y] + p.y;
                u32x4* o0 = (u32x4*)(AMOE + (size_t)d0 * D); u32x4* o1 = (u32x4*)(AMOE + (size_t)d1 * D);
                o0[lane] = v0; o0[lane + 64] = v1; o1[lane] = v0; o1[lane + 64] = v1;
                if (lane == 0) TOKDEST[r] = make_int2(d0, d1);
              }
#undef GATHER_LOAD
            }
            SEAM(9);
        } }
        if (RUN(10)) { for (int rep_ = 0; rep_ < NREP(10); ++rep_) {
            FRESH_TID();
            EpiSwiGLU E{HB16};
            const int nr = moe ? __builtin_amdgcn_readfirstlane(BLKE[160]) * 256 : nrows;
            gemm_run(lds, moe ? AMOE : U16, D, D, nr, NFF2, (const f16*)(W + (moe ? WO_13 : WO_13D)), (size_t)NFF2 * D, moe ? BLKE : nullptr, E, vb, nvb, tid);
            SEAM(10);
        } }
        if (RUN(11)) { for (int rep_ = 0; rep_ < NREP(11); ++rep_) {
            FRESH_TID();
            if (moe) {
                const int nblk = __builtin_amdgcn_readfirstlane(BLKE[160]); int tb, S; moe_tail(nblk, tb, S);
                EpiF32 E{YF, D, (f16*)(ws + WS_HFB), (nblk - tb) * 256, tb * 256};
                gemm_run(lds, HB16, DFF, DFF, nblk * 256, D, (const f16*)(W + WO_2), (size_t)D * DFF, BLKE, E, vb, nvb, tid, tb * 256, S);
            } else {
                EpiF32 E{YF, D, (f16*)(ws + WS_YF + YF_PART), ML, MC};
                gemm_run(lds, HB16, DFF, DFF, nrows, D, (const f16*)(W + WO_2D), (size_t)D * DFF, nullptr, E, vb, nvb, tid, last ? 0 : MC, 7);
            }
            SEAM(11);
        } }
        if (RUN(12)) { for (int rep_ = 0; rep_ < NREP(12); ++rep_) {
            FRESH_TID();
            LAS float* GT = (LAS float*)(lds + 73728);
            if (!last) load_gate_table(lds, layer + 1, GT, tid);
            const float* g2p = INP(I_LN2G) + layer * D; const float* b2p = INP(I_LN2B) + layer * D;
            const f16* PARTp = (const f16*)(ws + WS_YF + YF_PART);
#define LOAD_F(r_, dst_) do { if ((r_) >= ML) load_row_sum(PARTp + (size_t)((r_) - ML) * D, (size_t)MC * D, 7, dst_, lane); else load_row_h(YF + (size_t)(r_) * D, dst_, lane); } while (0)
            int m_split = 1 << 30, m_S = 1, m_trows = 0;
            if (moe) { const int nblk = __builtin_amdgcn_readfirstlane(BLKE[160]); int tb; moe_tail(nblk, tb, m_S); if (tb) { m_split = (nblk - tb) * 256; m_trows = tb * 256; } }
            const f16* MPART = (const f16*)(ws + WS_HFB);
#define LOAD_YB(d_, dst_) do { if ((d_) >= m_split) load_row_sum(MPART + (size_t)((d_) - m_split) * D, (size_t)m_trows * D, m_S, dst_, lane); else load_row_h(YF + (size_t)(d_) * D, dst_, lane); } while (0)
            f32x4 xn[4], fn0[4], fn1[4]; float2 pn = make_float2(0.f, 0.f); int2 dnn = make_int2(0, 0);
            f32x4 mgn[4];
#define LOAD_MOD2(r_) do { const float* m_ = mod_row(ws, lds, layer, (r_)); _Pragma("unroll") for (int j = 0; j < 4; ++j) mgn[j] = *(const f32x4*)(m_ + 5120 + 256 * j + 4 * lane); } while (0)
            if (gw < nrows) LOAD_MOD2(gw);
            if (gw < nrows) { load_row_h(XS + (size_t)gw * D, xn, lane);
                if (moe) { const int2 d = TOKDEST[gw]; pn = TOKP[gw]; LOAD_YB(d.x, fn0); LOAD_YB(d.y, fn1); if (gw + ngw < nrows) dnn = TOKDEST[gw + ngw]; }
                else LOAD_F(gw, fn0); }
            for (int r = gw; r < nrows; r += ngw) {
                f32x4 x[4], f[4], mg[4], msh[4], msc[4], lg_[4], lb_[4];
#pragma unroll
                for (int j = 0; j < 4; ++j) { x[j] = xn[j]; f[j] = moe ? fn0[j] * pn.x + fn1[j] * pn.y : fn0[j]; mg[j] = mgn[j]; }
                { const float* q_ = mod_row(ws, lds, last ? layer : layer + 1, r);
#pragma unroll
                  for (int j = 0; j < 4; ++j) { lg_[j] = *(const f32x4*)(g2p + 256 * j + 4 * lane); lb_[j] = *(const f32x4*)(b2p + 256 * j + 4 * lane); msh[j] = *(const f32x4*)(q_ + 256 * j + 4 * lane); msc[j] = *(const f32x4*)(q_ + 1024 + 256 * j + 4 * lane); } }
                if (r + ngw < nrows) { const int rn = r + ngw; LOAD_MOD2(rn); load_row_h(XS + (size_t)rn * D, xn, lane);
                    if (moe) { const int2 d = dnn; pn = TOKP[rn]; LOAD_YB(d.x, fn0); LOAD_YB(d.y, fn1); if (rn + ngw < nrows) dnn = TOKDEST[rn + ngw]; }
                    else LOAD_F(rn, fn0); }
#pragma unroll
                for (int j = 0; j < 4; ++j) x[j] = x[j] * ALPHA + mg[j] * f[j];
                float mean, rstd; ln_stats(x, mean, rstd);
#pragma unroll
                for (int j = 0; j < 4; ++j) { const int k = 256 * j + 4 * lane; x[j] = (x[j] - mean) * rstd * lg_[j] + lb_[j];
                    if (last) *(f32x4*)(args.out + (size_t)r * D + k) = x[j]; }
                if (!last) store_row_h(XS + (size_t)r * D, x, lane);
                if (!last) row_A_pre(ws, r, x, msh, msc, GT, lane);
            }
            if (!last) { __syncthreads(); conv_layer(ws, layer + 1, lds, gw, ngw, wave, lane, ffn_dma_items(layer + 1, nvb)); }
            SEAM(12);
        } }
#undef STEP
#undef RUN
#undef SEAM
}
__global__ void __launch_bounds__(NTHREADS, 2) mega(Args args) {
    extern __shared__ __attribute__((aligned(16))) unsigned char lds_raw[];
    LAS unsigned char* lds = (LAS unsigned char*)lds_raw;
    const int tid0 = threadIdx.x, wave0 = __builtin_amdgcn_readfirstlane(tid0 >> 6);
    const int vb0 = blockIdx.x, nvb0 = gridDim.x;
    unsigned char* ws0 = args.ws;
    unsigned* ctl = (unsigned*)(ws0 + WS_CTL);
    volatile LAS unsigned* MISC = (volatile LAS unsigned*)(lds + TAIL_OFF);
    if (tid0 < 64) MISC[tid0] = 0u;
    if (tid0 < 29) *(LAS unsigned long long*)(lds + PTAB_OFF + 8 * tid0) = (unsigned long long)args.in[tid0];
    __syncthreads();
#if MK_FUSED
    XcdBarrier bar = xcd_barrier_post(ctl + CW_BAR, MISC + 8);
#else
    XcdBarrier bar; bar.bar = ctl + CW_BAR; bar.x = 0; bar.st = MISC + 8;
#endif
    const int s_lo = args.s_lo, s_hi = args.s_hi; (void)s_lo; (void)s_hi;

    layer_body<0>(args, lds, tid0, wave0, vb0, nvb0, ws0, ctl, bar, s_lo, s_hi);
    layer_body<1>(args, lds, tid0, wave0, vb0, nvb0, ws0, ctl, bar, s_lo, s_hi);
    layer_body<2>(args, lds, tid0, wave0, vb0, nvb0, ws0, ctl, bar, s_lo, s_hi);
    layer_body<3>(args, lds, tid0, wave0, vb0, nvb0, ws0, ctl, bar, s_lo, s_hi);
}

static bool step_applicable(int layer, int p) {
    if (p == 0 || p == 1) return layer == 0;
    if (p == 9) return (layer & 1) != 0;
    return true;
}
extern "C" void kernel_launch(void* const* d_in, const int* in_sizes, int n_in, void* d_out, int out_size, void* d_ws, size_t ws_size, hipStream_t stream) {
    static int grid = 0;
    if (grid == 0) {
        if (n_in != 29 || out_size != ML * D || ws_size < WS_END) { fprintf(stderr, "kernel_launch: unexpected sizes (n_in %d out %d ws %zu need %zu)\n", n_in, out_size, ws_size, (size_t)WS_END); grid = -1; return; }
        int dev = 0, cus = 0, per_cu = 0;
        hipGetDevice(&dev); hipDeviceGetAttribute(&cus, hipDeviceAttributeMultiprocessorCount, dev);
        if (hipFuncSetAttribute((const void*)mega, hipFuncAttributeMaxDynamicSharedMemorySize, LDS_BYTES) != hipSuccess) { fprintf(stderr, "kernel_launch: hipFuncSetAttribute failed\n"); grid = -1; return; }
        if (hipOccupancyMaxActiveBlocksPerMultiprocessor(&per_cu, (const void*)mega, NTHREADS, LDS_BYTES) != hipSuccess || per_cu < 1) { fprintf(stderr, "kernel_launch: occupancy query says %d\n", per_cu); }
        (void)hipGetLastError();
        grid = cus > 0 ? cus : 256;
    }
    if (grid < 0) return;
    hipMemsetAsync((char*)d_ws + WS_CTL, 0, CTL_ZERO_BYTES, stream);
    Args a{};
    for (int i = 0; i < 29; ++i) a.in[i] = (const float*)d_in[i];
    a.out = (float*)d_out; a.ws = (unsigned char*)d_ws;
#if MK_FUSED
    a.s_lo = 0; a.s_hi = DEPTH * NPH;
    hipLaunchKernelGGL(mega, dim3(grid), dim3(NTHREADS), LDS_BYTES, stream, a);
#else
    for (int layer = 0; layer < DEPTH; ++layer)
        for (int p = 0; p < NPH; ++p) {
            if (!step_applicable(layer, p)) continue;
            a.s_lo = layer * NPH + p; a.s_hi = a.s_lo + 1;
            hipLaunchKernelGGL(mega, dim3(grid), dim3(NTHREADS), LDS_BYTES, stream, a);
        }
#endif
}
```

```cpp
#include <hip/hip_runtime.h>
#include <cstdio>
#include <cstdint>

#ifndef MK_FUSED
#define MK_FUSED 1
#endif
#ifndef USE_MLSTM_MFMA
#define USE_MLSTM_MFMA 1
#endif
#ifndef USE_NA_MFMA
#define USE_NA_MFMA 1
#endif
#ifndef PROBE_PH
#define PROBE_PH -1
#endif
#ifndef PROBE_LAYER
#define PROBE_LAYER -1
#endif
#ifndef PROBE_REP
#define PROBE_REP 0
#endif
#ifndef PH_MASK
#define PH_MASK 0xFFFF
#endif
#ifndef USE_MFMA
#define USE_MFMA 1
#endif

#define LAS __attribute__((address_space(3)))
typedef _Float16 f16;
typedef _Float16 f16x8 __attribute__((ext_vector_type(8)));
typedef _Float16 f16x4 __attribute__((ext_vector_type(4)));
typedef _Float16 f16x2 __attribute__((ext_vector_type(2)));
typedef float f32x4 __attribute__((ext_vector_type(4)));
typedef float f32x2 __attribute__((ext_vector_type(2)));
typedef unsigned u32x4 __attribute__((ext_vector_type(4)));
typedef unsigned u32x2 __attribute__((ext_vector_type(2)));

constexpr int D = 1024, NB = 8, SEQ = 2048, CTXL = 256, ML = NB * SEQ, MC = NB * CTXL, MT = ML + MC, DEPTH = 4;
constexpr int NIN = 6160, NP1 = 6144, DFF = 3584, NE = 8, NFF2 = 2 * DFF;
constexpr int MOE_MAXROWS = 38912;
constexpr float ALPHA = 1.6817928305074292f;
constexpr float LN_EPS = 1e-6f;
constexpr int NWAVES = 8, NTHREADS = 512;
constexpr int LDS_BYTES = 155648;

constexpr size_t MiB = 1u << 20;
constexpr size_t WS_CTL = 0, CTL_ZERO_BYTES = 1 * MiB;
constexpr size_t WS_MOD = 2 * MiB;
constexpr size_t WS_ROPE = 2 * MiB + 896 * 1024;
constexpr size_t WS_MLG = 3 * MiB;
constexpr size_t WS_TOK = 5 * MiB;
constexpr size_t WS_XS = 8 * MiB;
constexpr size_t WS_U16 = 80 * MiB;
constexpr size_t WS_P1 = 116 * MiB;
constexpr size_t WS_QK = 382 * MiB;
constexpr size_t WS_HFB = 418 * MiB;
constexpr size_t WS_CAT = 494 * MiB;
constexpr size_t WS_YF = 530 * MiB;
constexpr size_t YF_PART = 80 * MiB;
constexpr size_t WS_Z16 = 682 * MiB;
constexpr size_t WS_W = 718 * MiB;
constexpr size_t WO_IN = 0, WO_BP = 12 * MiB, WO_BN = WO_BP + MiB / 2, WO_BM = WO_BN + MiB / 2, WO_OUT = WO_BM + MiB, WO_13 = WO_OUT + 2 * MiB, WO_2 = WO_13 + 112 * MiB;
constexpr size_t WO_13D = 184 * MiB, WO_2D = WO_13D + 14 * MiB;
constexpr size_t WS_END = WS_W + 206 * MiB;
static_assert(WO_2 + 56 * MiB == 184 * MiB && WO_2D + 7 * MiB <= 206 * MiB, "weight map");
constexpr int CW_TMO = 0;
constexpr int CW_BAR = 4096;
constexpr int CW_MOECNT = 16384;
constexpr size_t TK_E = 0, TK_P = 160 * 1024, TK_POS = 320 * 1024, TK_DEST = 480 * 1024, TK_BLKE = 640 * 1024, TK_BCNT = 704 * 1024;

__device__ __forceinline__ float row16_sum(float v) {
    v += __builtin_bit_cast(float, __builtin_amdgcn_update_dpp(0, __builtin_bit_cast(int, v), 0xB1, 0xF, 0xF, true));
    v += __builtin_bit_cast(float, __builtin_amdgcn_update_dpp(0, __builtin_bit_cast(int, v), 0x4E, 0xF, 0xF, true));
    v += __builtin_bit_cast(float, __builtin_amdgcn_update_dpp(0, __builtin_bit_cast(int, v), 0x141, 0xF, 0xF, true));
    v += __builtin_bit_cast(float, __builtin_amdgcn_update_dpp(0, __builtin_bit_cast(int, v), 0x140, 0xF, 0xF, true));
    return v;
}
__device__ __forceinline__ float wave_sum(float v) {
    v = row16_sum(v);
    v += __shfl_xor(v, 16); v += __shfl_xor(v, 32);
    return v;
}
__device__ __forceinline__ float wave_max(float v) {
#pragma unroll
    for (int o = 1; o < 64; o <<= 1) v = fmaxf(v, __shfl_xor(v, o));
    return v;
}
__device__ __forceinline__ float sigmoid_(float x) { return __builtin_amdgcn_rcpf(1.f + __expf(-x)); }
__device__ __forceinline__ float silu_(float x) { return x * __builtin_amdgcn_rcpf(1.f + __expf(-x)); }
#define LDS_WAIT() asm volatile("s_waitcnt lgkmcnt(0)" ::: "memory")
#define VM_WAIT() asm volatile("s_waitcnt vmcnt(0)" ::: "memory")


__device__ __forceinline__ int opaque_u32(int x) { int t = x; asm volatile("" : "+v"(t)); return __builtin_amdgcn_readfirstlane(t); }
__device__ __forceinline__ unsigned long long opaque_u64(unsigned long long x) { unsigned lo = (unsigned)x, hi = (unsigned)(x >> 32); asm volatile("" : "+v"(lo), "+v"(hi));
    return ((unsigned long long)(unsigned)__builtin_amdgcn_readfirstlane(hi) << 32) | (unsigned)__builtin_amdgcn_readfirstlane(lo); }

#define XB_TMO      128
#define XB_XCNT(j)  (256  + 64 * (j))
#define XB_XSUB(j)  (1280 + 64 * (j))
#define XB_XGEN(j)  (2304 + 64 * (j))
#define XB_TOP      3328
#define XB_TOPGEN   3392
#define XCD_BAR_WORDS 3456
#define XB_SPIN_CAP (1u << 22)
__device__ __forceinline__ unsigned xb_ld(unsigned* p)              { return __hip_atomic_load(p, __ATOMIC_RELAXED, __HIP_MEMORY_SCOPE_AGENT); }
__device__ __forceinline__ unsigned xb_add(unsigned* p, unsigned v) { return __hip_atomic_fetch_add(p, v, __ATOMIC_RELAXED, __HIP_MEMORY_SCOPE_AGENT); }
__device__ __forceinline__ unsigned xb_xcc_id() { return (unsigned)__builtin_amdgcn_s_getreg((3 << 11) | 20) & 0xFu; }
#define XB_SPIN(cond, bar) do { unsigned _sp = 0; while (cond) { __builtin_amdgcn_s_sleep(1); \
    if ((++_sp & 255u) == 0u) { if (xb_ld(&(bar)[XB_TMO])) break; if (_sp > XB_SPIN_CAP) { atomicAdd(&(bar)[XB_TMO], 1u); break; } } } } while (0)
struct XcdBarrier { unsigned* bar; unsigned x; volatile LAS unsigned* st; };
__device__ __forceinline__ XcdBarrier xcd_barrier_post(unsigned* bar, volatile LAS unsigned* st) {
    XcdBarrier b; b.bar = bar; b.x = xb_xcc_id(); b.st = st;
    if (threadIdx.x == 0) (void)xb_add(&bar[XB_XCNT(b.x)], 1u);
    return b;
}
__device__ __forceinline__ void xcd_barrier_complete(unsigned* bar, unsigned x, unsigned& nloc, unsigned& nx) {
    const unsigned G = gridDim.x * gridDim.y * gridDim.z;
    unsigned sum, cnt, mine, sp = 0u;
    for (;;) {
        sum = 0u; cnt = 0u; mine = 0u;
#pragma unroll
        for (unsigned j = 0; j < 16; ++j) { const unsigned c = xb_ld(&bar[XB_XCNT(j)]); sum += c; cnt += (c > 0u) ? 1u : 0u; }
        mine = xb_ld(&bar[XB_XCNT(x)]);
        if (sum == G) break;
        __builtin_amdgcn_s_sleep(1);
        if ((++sp & 255u) == 0u) { if (xb_ld(&bar[XB_TMO])) break; if (sp > XB_SPIN_CAP) { atomicAdd(&bar[XB_TMO], 1u); break; } }
    }
    nloc = mine > 0u ? mine : 1u; nx = cnt > 0u ? cnt : 1u;
}
__device__ __forceinline__ void xcd_barrier(const XcdBarrier& b) {
    asm volatile("s_waitcnt vmcnt(0)" ::: "memory");
    __syncthreads();
    if (threadIdx.x == 0) {
        const unsigned long long bi_ = opaque_u64((unsigned long long)b.bar); unsigned* bar = (unsigned*)(__attribute__((address_space(1))) unsigned*)bi_;
        __builtin_amdgcn_s_waitcnt(0);
        unsigned nloc = b.st[0], nx = b.st[1];
        if (nloc == 0u) { xcd_barrier_complete(bar, b.x, nloc, nx); b.st[0] = nloc; b.st[1] = nx; }
        const unsigned old = xb_add(&bar[XB_XSUB(b.x)], 1u);
        const unsigned gen = old / nloc;
        if (old + 1u == (gen + 1u) * nloc) {
            __builtin_amdgcn_fence(__ATOMIC_RELEASE, "agent");
            asm volatile("s_waitcnt vmcnt(0)" ::: "memory");
            const unsigned og = xb_add(&bar[XB_TOP], 1u);
            const unsigned tg = og / nx;
            if (og + 1u == (tg + 1u) * nx) xb_add(&bar[XB_TOPGEN], 1u);
            else XB_SPIN(xb_ld(&bar[XB_TOPGEN]) == tg, bar);
            __builtin_amdgcn_fence(__ATOMIC_ACQUIRE, "agent");
            xb_add(&bar[XB_XGEN(b.x)], 1u);
            asm volatile("s_waitcnt vmcnt(0)" ::: "memory");
        } else {
            XB_SPIN(xb_ld(&bar[XB_XGEN(b.x)]) == gen, bar);
            __builtin_amdgcn_fence(__ATOMIC_ACQUIRE, "agent");
            asm volatile("s_waitcnt vmcnt(0)" ::: "memory");
        }
    }
    __syncthreads();
}

struct Args { const float* in[29]; float* out; unsigned char* ws; int s_lo, s_hi; };
enum { I_X = 0, I_C, I_CTX, I_CCTX, I_WMOD, I_BMOD, I_WIN, I_GBIAS, I_CONVW, I_NORMW, I_POOLW, I_POOLS, I_RPB, I_WBP, I_WBN, I_WBM, I_WOUT,
       I_LN1G, I_LN1B, I_LN2G, I_LN2B, I_FW1, I_FW3, I_FW2, I_RW, I_RB, I_MW1, I_MW3, I_MW2 };


constexpr int TAIL_OFF = LDS_BYTES - 1024, PTAB_OFF = TAIL_OFF + 256;
__device__ __forceinline__ const float* inp_ptr(LAS unsigned char* lds, int i) {
    const LAS unsigned* t = (const LAS unsigned*)(lds + PTAB_OFF);
    const unsigned lo = __builtin_amdgcn_readfirstlane(t[2 * i]), hi = __builtin_amdgcn_readfirstlane(t[2 * i + 1]);
    return (const float*)(const __attribute__((address_space(1))) float*)(((unsigned long long)hi << 32) | lo);
}
#define INP(i) inp_ptr(lds, (i))

__device__ __forceinline__ u32x4 pack8(const float (&v)[8]) {
    f16x8 h;
#pragma unroll
    for (int i = 0; i < 8; ++i) h[i] = (f16)v[i];
    return __builtin_bit_cast(u32x4, h);
}
struct EpiP1 {
    static constexpr bool MIDK = false, PAIR = false, GU = false;
    f16* P1;
    __device__ __forceinline__ void emit_part(int, int, int, const float (&)[8]) const {}
    __device__ __forceinline__ void emit8(int row, int col, const float (&v)[8]) const {
        const float s = (col >= 256 && col < 512) ? 0.125f : 1.f;
        float w[8];
        if (col >= 2560) {
#pragma unroll
            for (int i = 0; i < 8; ++i) w[i] = sigmoid_(v[i]);
        } else {
#pragma unroll
            for (int i = 0; i < 8; ++i) w[i] = v[i] * s;
        }
        *(u32x4*)(P1 + (size_t)row * NP1 + col) = pack8(w);
    }
};
struct EpiMerge {
    static constexpr bool MIDK = true, PAIR = false, GU = false;
    const f16* P1; f16* Z16; f16* PART;
    __device__ __forceinline__ void emit_part(int part, int row, int col, const float (&v)[8]) const {
        const int gi = part < 2 ? part : 2;
        const f16x8 g = *(const f16x8*)(P1 + (size_t)row * NP1 + 3072 + gi * 1024 + col);
        float w[8];
#pragma unroll
        for (int i = 0; i < 8; ++i) w[i] = v[i] * (gi == 0 ? (float)g[i] : fmaxf((float)g[i], 1e-4f));
        *(u32x4*)(PART + ((size_t)part * MC + (row - ML)) * D + col) = pack8(w);
    }
    __device__ __forceinline__ void mid8(int row, int col, float (&v)[8], int which) const {
        const f16* gp = P1 + (size_t)row * NP1 + 3072 + col;
        const f16x8 gnum = *(const f16x8*)(gp + (which == 0 ? 0 : 1024)), gden = *(const f16x8*)(gp + (which == 0 ? 1024 : 2048));
#pragma unroll
        for (int i = 0; i < 8; ++i) { const float num = which == 0 ? (float)gnum[i] : fmaxf((float)gnum[i], 1e-4f); v[i] *= num * __builtin_amdgcn_rcpf(fmaxf((float)gden[i], 1e-4f)); }
    }
    __device__ __forceinline__ void emit8(int row, int col, const float (&v)[8]) const {
        const f16x8 g = *(const f16x8*)(P1 + (size_t)row * NP1 + 3072 + 2048 + col);
        float w[8];
#pragma unroll
        for (int i = 0; i < 8; ++i) w[i] = v[i] * fmaxf((float)g[i], 1e-4f);
        *(u32x4*)(Z16 + (size_t)row * D + col) = pack8(w);
    }
};
struct EpiF32 {
    static constexpr bool MIDK = false, PAIR = false, GU = false;
    f16* C; int ldc; f16* PART; int prow0, prows;
    __device__ __forceinline__ void emit_part(int part, int row, int col, const float (&v)[8]) const {
        *(u32x4*)(PART + ((size_t)part * prows + (row - prow0)) * ldc + col) = pack8(v); }
    __device__ __forceinline__ void emit8(int row, int col, const float (&v)[8]) const {
        *(u32x4*)(C + (size_t)row * ldc + col) = pack8(v);
    }
};
struct EpiSwiGLU {
    static constexpr bool MIDK = false, PAIR = false, GU = true;
    f16* H;
    __device__ __forceinline__ void emit_gu(int row, int hcol, const float (&gt)[8], const float (&up)[8]) const {
        float w[8];
#pragma unroll
        for (int i = 0; i < 8; ++i) w[i] = silu_(gt[i]) * up[i];
        *(u32x4*)(H + (size_t)row * DFF + hcol) = pack8(w);
    }
    __device__ __forceinline__ void emit_pair(int row0, int col, const float (&va)[8], const float (&vb)[8], int fq) const {
        f16x4 ha, hb;
#pragma unroll
        for (int i = 0; i < 4; ++i) { ha[i] = (f16)(silu_(va[i]) * va[i + 4]); hb[i] = (f16)(silu_(vb[i]) * vb[i + 4]); }
        u32x2 A = __builtin_bit_cast(u32x2, ha), B = __builtin_bit_cast(u32x2, hb);
        { auto r = __builtin_amdgcn_permlane16_swap(A[0], B[0], false, false); A[0] = r[0]; B[0] = r[1]; }
        { auto r = __builtin_amdgcn_permlane16_swap(A[1], B[1], false, false); A[1] = r[0]; B[1] = r[1]; }
        const int odd = fq & 1;
        *(u32x4*)(H + (size_t)(row0 + 16 * odd) * DFF + ((col - 8 * odd) >> 1)) = (u32x4){A[0], A[1], B[0], B[1]};
    }
    __device__ __forceinline__ void emit_part(int, int, int, const float (&)[8]) const {}
    __device__ __forceinline__ void emit8(int row, int col, const float (&v)[8]) const {
        f16x4 h;
#pragma unroll
        for (int i = 0; i < 4; ++i) h[i] = (f16)(silu_(v[i]) * v[i + 4]);
        *(f16x4*)(H + (size_t)row * DFF + (col >> 1)) = h;
    }
};

template <class Epi, class BSel>
__device__ __forceinline__ void gemm_naive(LAS unsigned char* lds, const f16* A, int lda, int K, int nMt, int nNt, const Epi& E, const BSel& bsel, int vb, int nvb, int tid) {
    LAS float* As = (LAS float*)lds;
    LAS float* Bs = As + 32 * 132;
    const int ty = tid >> 4, tx = tid & 15, lr = tid >> 2, kc = (tid & 3) * 8;
    for (int tile = vb; tile < nMt * nNt; tile += nvb) {
        const int tm = tile / nNt, tn = tile % nNt;
        const f16* Bt = bsel(tm * 128);
        float acc[4][8];
#pragma unroll
        for (int i = 0; i < 4; ++i)
#pragma unroll
            for (int j = 0; j < 8; ++j) acc[i][j] = 0.f;
        for (int k0 = 0; k0 < K; k0 += 32) {
            const f16x8 av = *(const f16x8*)(A + (size_t)(tm * 128 + lr) * lda + k0 + kc);
            const f16x8 bv = *(const f16x8*)(Bt + (size_t)(tn * 128 + lr) * K + k0 + kc);
            __syncthreads();
#pragma unroll
            for (int i = 0; i < 8; ++i) { As[(kc + i) * 132 + lr] = (float)av[i]; Bs[(kc + i) * 132 + lr] = (float)bv[i]; }
            __syncthreads();
#pragma unroll 8
            for (int kk = 0; kk < 32; ++kk) {
                const f32x4 a = *(const LAS f32x4*)(As + kk * 132 + ty * 4);
                const f32x4 b0 = *(const LAS f32x4*)(Bs + kk * 132 + tx * 8), b1 = *(const LAS f32x4*)(Bs + kk * 132 + tx * 8 + 4);
#pragma unroll
                for (int i = 0; i < 4; ++i) {
#pragma unroll
                    for (int j = 0; j < 4; ++j) { acc[i][j] += a[i] * b0[j]; acc[i][4 + j] += a[i] * b1[j]; }
                }
            }
        }
#pragma unroll
        for (int i = 0; i < 4; ++i) E.emit8(tm * 128 + ty * 4 + i, tn * 128 + tx * 8, acc[i]);
    }
    __syncthreads();
}
struct BSelOne { const f16* Bt; __device__ __forceinline__ const f16* operator()(int) const { return Bt; } };
struct BSelMoe { const f16* Bt; size_t estride; const int* blke; __device__ __forceinline__ const f16* operator()(int row) const { return Bt + (size_t)blke[row >> 8] * estride; } };


namespace pg8 {
constexpr int BM = 256, BK = 64, HALF = 128, HTB = HALF * BK * 2, STAGE_BYTES = 8 * HTB, NXCD = 8, WGM = 4;
__device__ __forceinline__ int lds_byte(int r, int c) { const int st = (r >> 4) * 2 + (c >> 5), rr = r & 15, cc = c & 31, ob = rr * 64 + cc * 2; return st * 1024 + (ob ^ (((ob >> 9) & 1) << 5)); }
__device__ __forceinline__ void stage_rc(int b, int& R, int& C) { const int st = b / 1024, sb = b % 1024, swz = sb ^ (((sb >> 9) & 1) << 5); R = (st >> 1) * 16 + swz / 64; C = (st & 1) * 32 + (swz % 64) / 2; }
__device__ __forceinline__ int perm32(int rho) { const int n = rho >> 4, i = rho & 15; return 8 * (i >> 2) + 4 * n + (i & 3); }
struct Unit { int pm, pn, eb, kb, nt, part; };
struct Gemm { const f16* A; const f16* Bt; int lda, K; size_t bstride; };
struct Order {
    int nM, nN, nwg, G, c, ntile; const int* blke; int tailM, tailS, tail_nt;
    __device__ void init(int nM_, int nN_, int G_, int c_, const int* blke_, int ntile_) { nM = nM_; nN = nN_; nwg = nM * nN; G = G_; c = c_; blke = blke_; ntile = ntile_; tailM = 0; tailS = 1; tail_nt = ntile_; }
    __device__ void set_tail(int tailM_, int tailS_) { tailM = tailM_; tailS = tailS_; tail_nt = ntile / tailS_; }
    __device__ bool next(int i, Unit& u) const {
        const long L = (long)i * G + c;
        if (L >= nwg) { const int q = (int)(L - nwg); if (q >= tailM * nN * tailS) return false;
            const int uu = q / tailS, ks = q - uu * tailS; u.pm = nM + uu / nN; u.pn = uu % nN; u.eb = blke ? __builtin_amdgcn_readfirstlane(blke[u.pm]) : 0; u.kb = ks * tail_nt; u.nt = tail_nt; u.part = ks; return true; }
        int wgid = (int)L; { const int q = nwg / NXCD, r = nwg % NXCD, xcd = wgid % NXCD, off = wgid / NXCD; wgid = (xcd < r ? xcd * (q + 1) : r * (q + 1) + (xcd - r) * q) + off; }
        const int nig = WGM * nN, gid = wgid / nig, fm = gid * WGM, gsz = (nM - fm) < WGM ? (nM - fm) : WGM;
        u.pm = fm + ((wgid % nig) % gsz); u.pn = (wgid % nig) / gsz; u.eb = blke ? __builtin_amdgcn_readfirstlane(blke[u.pm]) : 0; u.kb = 0; u.nt = ntile; u.part = -1; return true;
    }
};
template <class Epi>
__device__ __forceinline__ void gemm_phase(LAS unsigned char* lds, const Gemm g, const Order& S, const Epi& E, int tid) {
    const int wid = __builtin_amdgcn_readfirstlane(tid >> 6), lane = tid & 63, wr = wid >> 2, wc = wid & 3, fr = lane & 15, fq = lane >> 4;
    const int K = g.K;
    unsigned voffA[2], voffB[2];
#pragma unroll
    for (int i = 0; i < 2; ++i) { int R, C; stage_rc(tid * 16 + i * 8192, R, C); const int Rb = (R & ~31) + perm32(R & 31);
        voffA[i] = (unsigned)(R * g.lda + C) * 2u; voffB[i] = (unsigned)(Rb * K + C) * 2u; }
    const size_t kstep = (size_t)(BK * 2);
    const size_t hstepA = (size_t)HALF * g.lda * 2, tstepA = 2 * hstepA, hstepB = (size_t)HALF * K * 2, tstepB = 2 * hstepB;
    const unsigned ldsw = (unsigned)wid * 1024u;
    const int aoff = lds_byte(wr * 64 + fr, fq * 8), boff = lds_byte(wc * 32 + fr, fq * 8);
#define PG8_SA(b, h) (((b) * 2 + (h)) * HTB)
#define PG8_SB(b, h) ((4 + (b) * 2 + (h)) * HTB)
#define PG8_STAGE(bufoff, gbase, voff) do { _Pragma("unroll") for (int _i = 0; _i < 2; ++_i) \
        __builtin_amdgcn_global_load_lds((const unsigned*)((const char*)(gbase) + (voff)[_i]), (LAS unsigned*)(lds + (bufoff) + ldsw + _i * 8192), 16, 0, 0); } while (0)
#define PG8_LDA(dst, b, h) do { _Pragma("unroll") for (int m = 0; m < 4; ++m) _Pragma("unroll") for (int k = 0; k < 2; ++k) dst[m][k] = *(const LAS f16x8*)(lds + PG8_SA(b, h) + aoff + m * 2048 + k * 1024); } while (0)
#define PG8_LDB(dst, b, h) do { _Pragma("unroll") for (int n = 0; n < 2; ++n) _Pragma("unroll") for (int k = 0; k < 2; ++k) dst[n][k] = *(const LAS f16x8*)(lds + PG8_SB(b, h) + boff + n * 2048 + k * 1024); } while (0)
#define PG8_MMA(ai, bj, At, Bt) do { __builtin_amdgcn_s_setprio(1); _Pragma("unroll") for (int m = 0; m < 4; ++m) _Pragma("unroll") for (int n = 0; n < 2; ++n) _Pragma("unroll") for (int k = 0; k < 2; ++k) \
        acc[ai][bj][m][n] = __builtin_amdgcn_mfma_f32_16x16x32_f16(Bt[n][k], At[m][k], acc[ai][bj][m][n], 0, 0, 0); __builtin_amdgcn_s_setprio(0); } while (0)
#define PG8_WAIT_V(n) asm volatile("s_waitcnt vmcnt(" #n ")" ::: "memory")
#define PG8_WAIT_L(n) asm volatile("s_waitcnt lgkmcnt(" #n ")" ::: "memory")
#define PG8_BAR __builtin_amdgcn_s_barrier()
#define PG8_SCHED __builtin_amdgcn_sched_barrier(0)
    Unit cur, nxt; int ui = 0;
    if (!S.next(0, cur)) return;
    f32x4 acc[2][2][4][2];
#pragma unroll
    for (int a = 0; a < 2; ++a)
#pragma unroll
        for (int b = 0; b < 2; ++b)
#pragma unroll
            for (int m = 0; m < 4; ++m)
#pragma unroll
                for (int n = 0; n < 2; ++n) acc[a][b][m][n] = (f32x4){0.f, 0.f, 0.f, 0.f};
    f16x8 At[4][2], B0[2][2], B1[2][2];
    const char* cA = (const char*)g.A + (size_t)cur.pm * tstepA + (size_t)cur.kb * kstep; const char* cB = (const char*)g.Bt + (size_t)cur.eb * g.bstride * 2 + (size_t)cur.pn * tstepB + (size_t)cur.kb * kstep;
    PG8_STAGE(PG8_SB(0, 0), cB, voffB); PG8_STAGE(PG8_SB(0, 1), cB + hstepB, voffB); PG8_STAGE(PG8_SA(0, 0), cA, voffA); PG8_STAGE(PG8_SA(0, 1), cA + hstepA, voffA);
    if (wr == 1) PG8_BAR;
    PG8_WAIT_V(2); PG8_BAR;
    PG8_STAGE(PG8_SB(1, 0), cB + kstep, voffB); PG8_STAGE(PG8_SA(1, 0), cA + kstep, voffA); PG8_STAGE(PG8_SB(1, 1), cB + hstepB + kstep, voffB);
    PG8_WAIT_V(6); PG8_BAR;
    for (;;) {
        const bool has_next = S.next(ui + 1, nxt);
        const char* nA = has_next ? (const char*)g.A + (size_t)nxt.pm * tstepA + (size_t)nxt.kb * kstep : cA; const char* nB = has_next ? (const char*)g.Bt + (size_t)nxt.eb * g.bstride * 2 + (size_t)nxt.pn * tstepB + (size_t)nxt.kb * kstep : cB;
        const int nt = cur.nt;
        int t = 0;
#pragma unroll 1
        for (int seg = 0; seg < (Epi::MIDK ? 3 : 1); ++seg) {
        const int tend = Epi::MIDK ? (seg == 0 ? (nt < 4 ? nt : 4) : (seg == 1 ? (nt < 8 ? nt : 8) : nt)) : nt;
        for (; t < tend; t += 2) {
            const bool last = (t == nt - 2);
            const char* a1 = cA + (size_t)(t + 1) * kstep;
            const char* a2 = last ? nA : cA + (size_t)(t + 2) * kstep; const char* b2 = last ? nB : cB + (size_t)(t + 2) * kstep;
            const char* a3 = a2 + kstep; const char* b3 = b2 + kstep;
            PG8_LDB(B0, 0, 0); PG8_LDB(B1, 0, 1); PG8_SCHED; PG8_LDA(At, 0, 0); PG8_STAGE(PG8_SA(1, 1), a1 + hstepA, voffA);
            PG8_WAIT_V(8); PG8_WAIT_L(0); PG8_BAR; PG8_MMA(0, 0, At, B0); PG8_MMA(0, 1, At, B1); PG8_BAR; PG8_SCHED;
            PG8_LDA(At, 0, 1); PG8_STAGE(PG8_SB(0, 0), b2, voffB); PG8_STAGE(PG8_SB(0, 1), b2 + hstepB, voffB); PG8_STAGE(PG8_SA(0, 0), a2, voffA);
            PG8_WAIT_V(8); PG8_WAIT_L(0); PG8_BAR; PG8_MMA(1, 0, At, B0); PG8_MMA(1, 1, At, B1); PG8_BAR; PG8_SCHED;
            PG8_LDB(B0, 1, 0); PG8_LDB(B1, 1, 1); PG8_SCHED; PG8_LDA(At, 1, 0); PG8_STAGE(PG8_SA(0, 1), a2 + hstepA, voffA);
            PG8_WAIT_V(8); PG8_WAIT_L(0); PG8_BAR; PG8_MMA(0, 0, At, B0); PG8_MMA(0, 1, At, B1); PG8_BAR; PG8_SCHED;
            PG8_LDA(At, 1, 1); PG8_STAGE(PG8_SB(1, 0), b3, voffB); PG8_STAGE(PG8_SB(1, 1), b3 + hstepB, voffB); PG8_STAGE(PG8_SA(1, 0), a3, voffA);
            PG8_WAIT_V(8); PG8_WAIT_L(0); PG8_BAR; PG8_MMA(1, 0, At, B0); PG8_MMA(1, 1, At, B1); PG8_BAR; PG8_SCHED;
        }
        if constexpr (Epi::MIDK) { if (seg < 2 && cur.part < 0) {
#pragma unroll
                for (int ai = 0; ai < 2; ++ai)
#pragma unroll
                    for (int m = 0; m < 4; ++m) { int row = cur.pm * BM + ai * HALF + wr * 64 + m * 16 + fr; asm volatile("" : "+v"(row));
#pragma unroll
                        for (int bj = 0; bj < 2; ++bj) { const f32x4 v0 = acc[ai][bj][m][0], v1 = acc[ai][bj][m][1];
                            float v[8] = {v0[0], v0[1], v0[2], v0[3], v1[0], v1[1], v1[2], v1[3]};
                            E.mid8(row, cur.pn * BM + bj * HALF + wc * 32 + 8 * fq, v, seg);
                            acc[ai][bj][m][0] = (f32x4){v[0], v[1], v[2], v[3]}; acc[ai][bj][m][1] = (f32x4){v[4], v[5], v[6], v[7]}; }
                        asm volatile("" : "+v"(acc[ai][0][m][0]), "+v"(acc[ai][0][m][1]), "+v"(acc[ai][1][m][0]), "+v"(acc[ai][1][m][1]) :: "memory"); } } }
        }
        if (wr == 0) PG8_BAR;
        if constexpr (Epi::GU) {
#pragma unroll
            for (int ai = 0; ai < 2; ++ai)
#pragma unroll
                for (int m = 0; m < 4; ++m) { const int row = cur.pm * BM + ai * HALF + wr * 64 + m * 16 + fr;
                    const f32x4 g0 = acc[ai][0][m][0], g1 = acc[ai][0][m][1], u0 = acc[ai][1][m][0], u1 = acc[ai][1][m][1];
                    const float gt[8] = {g0[0], g0[1], g0[2], g0[3], g1[0], g1[1], g1[2], g1[3]}, up[8] = {u0[0], u0[1], u0[2], u0[3], u1[0], u1[1], u1[2], u1[3]};
                    E.emit_gu(row, cur.pn * HALF + wc * 32 + 8 * fq, gt, up); }
        } else if constexpr (Epi::PAIR) {
#pragma unroll
            for (int ai = 0; ai < 2; ++ai)
#pragma unroll
                for (int m = 0; m < 4; m += 2) { const int row = cur.pm * BM + ai * HALF + wr * 64 + m * 16 + fr;
#pragma unroll
                    for (int bj = 0; bj < 2; ++bj) { const f32x4 a0 = acc[ai][bj][m][0], a1 = acc[ai][bj][m][1], b0 = acc[ai][bj][m + 1][0], b1 = acc[ai][bj][m + 1][1];
                        const float va[8] = {a0[0], a0[1], a0[2], a0[3], a1[0], a1[1], a1[2], a1[3]}, vb[8] = {b0[0], b0[1], b0[2], b0[3], b1[0], b1[1], b1[2], b1[3]};
                        E.emit_pair(row, cur.pn * BM + bj * HALF + wc * 32 + 8 * fq, va, vb, fq); } }
        } else {
#pragma unroll
            for (int ai = 0; ai < 2; ++ai)
#pragma unroll
                for (int m = 0; m < 4; ++m) { int row = cur.pm * BM + ai * HALF + wr * 64 + m * 16 + fr; if constexpr (Epi::MIDK) asm volatile("" : "+v"(row));
#pragma unroll
                    for (int bj = 0; bj < 2; ++bj) { const f32x4 v0 = acc[ai][bj][m][0], v1 = acc[ai][bj][m][1];
                        const float v[8] = {v0[0], v0[1], v0[2], v0[3], v1[0], v1[1], v1[2], v1[3]};
                        if (cur.part >= 0) E.emit_part(cur.part, row, cur.pn * BM + bj * HALF + wc * 32 + 8 * fq, v); else E.emit8(row, cur.pn * BM + bj * HALF + wc * 32 + 8 * fq, v); } }
        }
        if (!has_next) break;
#pragma unroll
        for (int a = 0; a < 2; ++a)
#pragma unroll
            for (int b = 0; b < 2; ++b)
#pragma unroll
                for (int m = 0; m < 4; ++m)
#pragma unroll
                    for (int n = 0; n < 2; ++n) acc[a][b][m][n] = (f32x4){0.f, 0.f, 0.f, 0.f};
        cur = nxt; cA = nA; cB = nB; ++ui;
        if (wr == 1) PG8_BAR;
    }
    PG8_WAIT_V(0);
    PG8_BAR;
#undef PG8_SA
#undef PG8_SB
#undef PG8_STAGE
#undef PG8_LDA
#undef PG8_LDB
#undef PG8_MMA
#undef PG8_WAIT_V
#undef PG8_WAIT_L
#undef PG8_BAR
#undef PG8_SCHED
}
}
template <class Epi>
__device__ __forceinline__ void gemm_run(LAS unsigned char* lds, const f16* A, int lda, int K, int nrows, int N, const f16* Bt, size_t bstride, const int* blke, const Epi& E, int vb, int nvb, int tid, int tail_rows = 0, int tailS = 1) {
#if USE_MFMA
    pg8::Gemm g{A, Bt, lda, K, bstride}; pg8::Order S; S.init((nrows - tail_rows) / 256, N / 256, nvb, vb, blke, K / 64); if (tail_rows) S.set_tail(tail_rows / 256, tailS);
    pg8::gemm_phase(lds, g, S, E, tid);
#else
    static_assert(!Epi::MIDK, "the naive GEMM has no mid-K hook");
    if (blke) gemm_naive(lds, A, lda, K, nrows / 128, N / 128, E, BSelMoe{Bt, bstride, blke}, vb, nvb, tid);
    else gemm_naive(lds, A, lda, K, nrows / 128, N / 128, E, BSelOne{Bt}, vb, nvb, tid);
#endif
}

__device__ __forceinline__ void conv_item(const float* S0, const float* S1, int ld, int K, int N, f16* dst, int ldd, int mode, int skipfrom, int skip, LAS float* scr, int item, int lane) {
    const int nblk = N / 32, kb = item / nblk, nb = item % nblk, k0 = 64 * kb, n0 = 32 * nb;
    const int n = n0 + (lane & 31);
    const float* sp;
    if (mode == 0) sp = S0 + n + (n >= skipfrom ? skip : 0);
    else sp = ((n & 128) ? S1 : S0) + ((n >> 8) << 7) + (n & 127);
#pragma unroll 8
    for (int i = 0; i < 32; ++i) { const int kk = 2 * i + (lane >> 5); scr[kk * 33 + (lane & 31)] = sp[(size_t)(k0 + kk) * ld]; }
    LDS_WAIT();
    const int c = lane & 7;
#pragma unroll
    for (int j = 0; j < 4; ++j) { const int nn = (lane >> 3) + 8 * j; const LAS float* s = scr + (8 * c) * 33 + nn;
        f16x8 h;
#pragma unroll
        for (int q = 0; q < 8; ++q) h[q] = (f16)s[q * 33];
        *(f16x8*)(dst + (size_t)(n0 + nn) * ldd + k0 + 8 * c) = h; }
    LDS_WAIT();
}
constexpr int FFN_ITEMS = 16 * (NFF2 / 32) + 56 * 32;
__device__ __forceinline__ void conv_layer(unsigned char* ws, int layer, LAS unsigned char* lds, int gw, int ngw, int wave, int lane, int ffn_lo) {
    LAS float* scr = (LAS float*)(lds + wave * 8448);
    unsigned char* W = ws + WS_W;
    const int I_IN = 16 * (NP1 / 32), I_BP = 4 * 32, I_BM = 8 * 32, I_OUT = 16 * 32, I_13 = 16 * (NFF2 / 32), I_2 = 56 * 32;
    const bool moe = (layer & 1); const int fi = layer >> 1;
    const int nexp = moe ? NE : 1;
    const int ncommon = I_IN + 2 * I_BP + I_BM + I_OUT;
    const int total = ncommon + nexp * (I_13 + I_2) - ffn_lo;
    for (int it = gw; it < total; it += ngw) {
        int r = it < ncommon ? it : it + ffn_lo;
        if (r < I_IN) { conv_item(INP(I_WIN) + (size_t)layer * D * NIN, nullptr, NIN, D, NP1, (f16*)(W + WO_IN), D, 0, 3072, 16, scr, r, lane); continue; } r -= I_IN;
        if (r < I_BP) { conv_item(INP(I_WBP) + (size_t)layer * 256 * D, nullptr, D, 256, D, (f16*)(W + WO_BP), D, 0, 1 << 30, 0, scr, r, lane); continue; } r -= I_BP;
        if (r < I_BP) { conv_item(INP(I_WBN) + (size_t)layer * 256 * D, nullptr, D, 256, D, (f16*)(W + WO_BP) + 256, D, 0, 1 << 30, 0, scr, r, lane); continue; } r -= I_BP;
        if (r < I_BM) { conv_item(INP(I_WBM) + (size_t)layer * 512 * D, nullptr, D, 512, D, (f16*)(W + WO_BP) + 512, D, 0, 1 << 30, 0, scr, r, lane); continue; } r -= I_BM;
        if (r < I_OUT) { conv_item(INP(I_WOUT) + (size_t)layer * D * D, nullptr, D, D, D, (f16*)(W + WO_OUT), D, 0, 1 << 30, 0, scr, r, lane); continue; } r -= I_OUT;
        const int e = r / (I_13 + I_2); r -= e * (I_13 + I_2);
        const size_t eo = (size_t)(fi * nexp + e) * D * DFF;
        const float* w1 = (moe ? INP(I_MW1) : INP(I_FW1)) + eo;
        const float* w3 = (moe ? INP(I_MW3) : INP(I_FW3)) + eo;
        const float* w2 = (moe ? INP(I_MW2) : INP(I_FW2)) + eo;
        if (r < I_13) conv_item(w1, w3, DFF, D, NFF2, (f16*)(W + (moe ? WO_13 : WO_13D)) + (size_t)e * NFF2 * D, D, 1, 0, 0, scr, r, lane);
        else conv_item(w2, nullptr, D, DFF, D, (f16*)(W + (moe ? WO_2 : WO_2D)) + (size_t)e * D * DFF, DFF, 0, 1 << 30, 0, scr, r - I_13, lane);
    }
}

__device__ __forceinline__ void conv_seg(int l, int nvb, int& LA, int& a0, int& an, int& LB, int& b0, int& bn) {
    LA = 0; a0 = 0; an = 0; LB = 0; b0 = 0; bn = 0;
    if (nvb != 256) return;
    constexpr int HALF = 9 * NWAVES * 256;
    if (l == 0) { LA = 1; a0 = 0; an = HALF; }
    else if (l == 1) { LA = 1; a0 = HALF; an = HALF; LB = 2; b0 = 0; bn = FFN_ITEMS; }
    else if (l == 2) { LA = 3; a0 = 0; an = HALF; }
    else { LA = 3; a0 = HALF; an = HALF; }
}
__device__ __forceinline__ int ffn_dma_items(int L, int nvb) {
    if (L <= 0 || L >= DEPTH || nvb != 256) return 0;
    const int tot = ((L & 1) ? NE : 1) * FFN_ITEMS, cap = 18 * NWAVES * 256;
    return tot < cap ? tot : cap;
}

__device__ __forceinline__ void ln_stats(const f32x4 (&v)[4], float& mean, float& rstd) {
    float s = 0.f;
#pragma unroll
    for (int j = 0; j < 4; ++j) s += (v[j][0] + v[j][1]) + (v[j][2] + v[j][3]);
    mean = wave_sum(s) * (1.f / D);
    float q = 0.f;
#pragma unroll
    for (int j = 0; j < 4; ++j) { const f32x4 d = v[j] - mean; q += (d[0] * d[0] + d[1] * d[1]) + (d[2] * d[2] + d[3] * d[3]); }
    rstd = 1.f / sqrtf(wave_sum(q) * (1.f / D) + LN_EPS);
}
__device__ __forceinline__ const float* mod_row(unsigned char* ws, LAS unsigned char* lds, int layer, int r) {
    const int rb = r < ML ? r / SEQ : NB;
    return (const float*)(ws + WS_MOD) + (size_t)(layer * 9 + rb) * 6144;
}
__device__ __forceinline__ void load_gate_table(LAS unsigned char* lds, int layer, LAS float* T, int tid) {
    const float* src = INP(I_WIN) + (size_t)layer * D * NIN + 3072;
    for (int i = tid; i < D * 4; i += NTHREADS) { const int k = i >> 2, q = i & 3; const f32x4 w = *(const f32x4*)(src + (size_t)k * NIN + 4 * q);
        T[(4 * q + 0) * D + k] = w[0]; T[(4 * q + 1) * D + k] = w[1]; T[(4 * q + 2) * D + k] = w[2]; T[(4 * q + 3) * D + k] = w[3]; }
    __syncthreads();
}
__device__ __forceinline__ void load_router_table(LAS unsigned char* lds, int mi, LAS float* T, int tid) {
    const float* src = INP(I_RW) + (size_t)mi * D * NE;
    for (int i = tid; i < D * 2; i += NTHREADS) { const int k = i >> 1, q = i & 1; const f32x4 w = *(const f32x4*)(src + (size_t)k * NE + 4 * q);
        T[(4 * q + 0) * D + k] = w[0]; T[(4 * q + 1) * D + k] = w[1]; T[(4 * q + 2) * D + k] = w[2]; T[(4 * q + 3) * D + k] = w[3]; }
    __syncthreads();
}
__device__ __forceinline__ float dot4_rows(const f32x4 (&u)[4], const LAS float* T, int g0, int lane) {
    float p[4];
#pragma unroll
    for (int i = 0; i < 4; ++i) { float s = 0.f;
#pragma unroll
        for (int j = 0; j < 4; ++j) { const f32x4 w = *(const LAS f32x4*)(T + (g0 + i) * D + 256 * j + 4 * lane); s += (u[j][0] * w[0] + u[j][1] * w[1]) + (u[j][2] * w[2] + u[j][3] * w[3]); }
        p[i] = s; }
    const bool b5 = (lane & 32) != 0, b4 = (lane & 16) != 0;
    const float q0 = (b5 ? p[2] : p[0]) + __shfl_xor(b5 ? p[0] : p[2], 32), q1 = (b5 ? p[3] : p[1]) + __shfl_xor(b5 ? p[1] : p[3], 32);
    float s = (b4 ? q1 : q0) + __shfl_xor(b4 ? q0 : q1, 16);
    return row16_sum(s);
}
__device__ __forceinline__ void row_A(unsigned char* ws, LAS unsigned char* lds, int layer, int r, const f32x4 (&x)[4], const LAS float* GT, int lane) {
    float mean, rstd; ln_stats(x, mean, rstd);
    const float* mod = mod_row(ws, lds, layer, r);
    f32x4 u[4];
    f16* up = (f16*)(ws + WS_U16) + (size_t)r * D;
#pragma unroll
    for (int j = 0; j < 4; ++j) { const int k = 256 * j + 4 * lane; const f32x4 sh = *(const f32x4*)(mod + k), sc = *(const f32x4*)(mod + 1024 + k);
        u[j] = (x[j] - mean) * rstd * (sc + 1.f) + sh;
        f16x4 h; h[0] = (f16)u[j][0]; h[1] = (f16)u[j][1]; h[2] = (f16)u[j][2]; h[3] = (f16)u[j][3];
        *(f16x4*)(up + k) = h; }
#pragma unroll 1
    for (int gb = 0; gb < 4; ++gb) { const float s = dot4_rows(u, GT, 4 * gb, lane);
        if ((lane & 15) == 0) ((float*)(ws + WS_MLG))[(size_t)r * 16 + 4 * gb + (lane >> 4)] = s; }
}
__device__ __forceinline__ void row_A_pre(unsigned char* ws, int r, const f32x4 (&x)[4], const f32x4 (&sh)[4], const f32x4 (&sc)[4], const LAS float* GT, int lane) {
    float mean, rstd; ln_stats(x, mean, rstd);
    f32x4 u[4];
    f16* up = (f16*)(ws + WS_U16) + (size_t)r * D;
#pragma unroll
    for (int j = 0; j < 4; ++j) { const int k = 256 * j + 4 * lane;
        u[j] = (x[j] - mean) * rstd * (sc[j] + 1.f) + sh[j];
        f16x4 h; h[0] = (f16)u[j][0]; h[1] = (f16)u[j][1]; h[2] = (f16)u[j][2]; h[3] = (f16)u[j][3];
        *(f16x4*)(up + k) = h; }
#pragma unroll 1
    for (int gb = 0; gb < 4; ++gb) { const float s = dot4_rows(u, GT, 4 * gb, lane);
        if ((lane & 15) == 0) ((float*)(ws + WS_MLG))[(size_t)r * 16 + 4 * gb + (lane >> 4)] = s; }
}
__device__ __forceinline__ void load_row(const float* p, f32x4 (&v)[4], int lane) {
#pragma unroll
    for (int j = 0; j < 4; ++j) v[j] = *(const f32x4*)(p + 256 * j + 4 * lane);
}
__device__ __forceinline__ void load_row_h(const f16* p, f32x4 (&v)[4], int lane) {
#pragma unroll
    for (int j = 0; j < 4; ++j) { const f16x4 h = *(const f16x4*)(p + 256 * j + 4 * lane); v[j] = (f32x4){(float)h[0], (float)h[1], (float)h[2], (float)h[3]}; }
}
__device__ __forceinline__ void store_row_h(f16* p, const f32x4 (&v)[4], int lane) {
#pragma unroll
    for (int j = 0; j < 4; ++j) { f16x4 h; h[0] = (f16)v[j][0]; h[1] = (f16)v[j][1]; h[2] = (f16)v[j][2]; h[3] = (f16)v[j][3]; *(f16x4*)(p + 256 * j + 4 * lane) = h; }
}
template <int layer>
__device__ __forceinline__ void load_x(unsigned char* ws, LAS unsigned char* lds, int r, f32x4 (&v)[4], int lane) {
    if constexpr (layer == 0) load_row(r < ML ? INP(I_X) + (size_t)r * D : INP(I_CTX) + (size_t)(r - ML) * D, v, lane);
    else load_row_h((const f16*)(ws + WS_XS) + (size_t)r * D, v, lane);
}
__device__ __forceinline__ void load_row_sum(const f16* p, size_t stride, int n, f32x4 (&v)[4], int lane) {
    load_row_h(p, v, lane);
    for (int s = 1; s < n; ++s) { f32x4 t[4]; load_row_h(p + (size_t)s * stride, t, lane);
#pragma unroll
        for (int j = 0; j < 4; ++j) v[j] += t[j]; }
}
__device__ __forceinline__ const float* x_src(unsigned char* ws, LAS unsigned char* lds, int layer, int r) {
    if (layer == 0) return r < ML ? INP(I_X) + (size_t)r * D : INP(I_CTX) + (size_t)(r - ML) * D;
    return (const float*)(ws + WS_XS) + (size_t)r * D;
}

__device__ __forceinline__ void pool_phase(unsigned char* ws, int layer, LAS unsigned char* lds, int vb, int nvb, int tid) {
    LAS float* in = (LAS float*)lds;
    LAS f16* dif16 = (LAS f16*)(lds + 80 * 64 * 4);
    LAS f16* Wt16 = dif16 + 64 * 72;
    const f16* P1 = (const f16*)(ws + WS_P1);
    f16* CAT = (f16*)(ws + WS_CAT);
    const int nrows = (layer == DEPTH - 1) ? ML : MT;
    const int nunits = (nrows / 64) * 4;
    const int lane = tid & 63, w = __builtin_amdgcn_readfirstlane(tid >> 6), gq = lane >> 4, c = lane & 15;
    int gl = -1;
    for (int un = vb; un < nunits; un += nvb) {
        const int ch = un >> 2, g = un & 3, r0 = ch * 64;
        const int seq0 = r0 < ML ? (r0 / SEQ) * SEQ : ML + ((r0 - ML) / CTXL) * CTXL, seqlen = r0 < ML ? SEQ : CTXL;
        const int t0 = r0 - seq0, half = 1 << g;
        __syncthreads();
        for (int i = tid; i < 80 * 8; i += NTHREADS) { const int rr = i >> 3, c8 = (i & 7) * 8; const int t = t0 - 8 + rr;
            f16x8 v; if (t >= 0 && t < seqlen) v = *(const f16x8*)(P1 + (size_t)(seq0 + t) * NP1 + g * 64 + c8); else { for (int q = 0; q < 8; ++q) v[q] = (f16)0.f; }
#pragma unroll
            for (int q = 0; q < 8; ++q) in[rr * 64 + c8 + q] = (float)v[q]; }
        if (g != gl) { const float* pw = INP(I_POOLW) + (size_t)(layer * 4 + g) * 4096;
            for (int i = tid; i < 4096; i += NTHREADS) { const int cc = i >> 6, dd = i & 63; Wt16[dd * 72 + cc] = (f16)pw[i]; } gl = g; }
        __syncthreads();
        { const int tt = tid >> 3, c8 = (tid & 7) * 8, t = t0 + tt; int lo = t - half; if (lo < 0) lo = 0; int hi = t + half; if (hi > seqlen) hi = seqlen;
          const float inv = 1.f / (float)(hi - lo);
          float sacc[8];
#pragma unroll
          for (int q = 0; q < 8; ++q) sacc[q] = 0.f;
          for (int p = lo; p < hi; ++p) { const LAS float* ip = in + (p - t0 + 8) * 64 + c8;
#pragma unroll
              for (int q = 0; q < 8; ++q) sacc[q] += ip[q]; }
          f16x8 dv;
#pragma unroll
          for (int q = 0; q < 8; ++q) dv[q] = (f16)(sacc[q] * inv - in[(tt + 8) * 64 + c8 + q]);
          *(LAS f16x8*)(dif16 + tt * 72 + c8) = dv; }
        __syncthreads();
        { const int tt = w >> 1;
          f16x8 bfr[2];
#pragma unroll
          for (int ks = 0; ks < 2; ++ks) bfr[ks] = *(const LAS f16x8*)(dif16 + (16 * tt + c) * 72 + 32 * ks + 8 * gq);
#pragma unroll
          for (int q = 0; q < 2; ++q) { const int dt = (w & 1) * 2 + q;
              f32x4 acc = (f32x4){0.f, 0.f, 0.f, 0.f};
#pragma unroll
              for (int ks = 0; ks < 2; ++ks) { const f16x8 afr = *(const LAS f16x8*)(Wt16 + (16 * dt + c) * 72 + 32 * ks + 8 * gq);
                  acc = __builtin_amdgcn_mfma_f32_16x16x32_f16(afr, bfr[ks], acc, 0, 0, 0); }
              const f32x4 ps = *(const f32x4*)(INP(I_POOLS) + layer * 256 + g * 64 + 16 * dt + 4 * gq);
              f16x4 h; h[0] = (f16)(acc[0] * ps[0]); h[1] = (f16)(acc[1] * ps[1]); h[2] = (f16)(acc[2] * ps[2]); h[3] = (f16)(acc[3] * ps[3]);
              *(f16x4*)(CAT + (size_t)(r0 + 16 * tt + c) * D + g * 64 + 16 * dt + 4 * gq) = h; } }
    }
    __syncthreads();
}
__device__ __forceinline__ void na_phase(unsigned char* ws, int layer, LAS unsigned char* lds, int gw, int ngw, int wave, int lane) {
    LAS float* qs = (LAS float*)(lds + wave * 2048);
    LAS float* ps = qs + 64;
    const f16* P1 = (const f16*)(ws + WS_P1);
    f16* CAT = (f16*)(ws + WS_CAT);
    const float* rpb = INP(I_RPB) + (size_t)layer * 4 * 15 * 31;
    const int nq = (layer == DEPTH - 1) ? ML : MT;
    for (int item = gw; item < nq * 4; item += ngw) {
        const int tq = item >> 2, h = item & 3;
        qs[lane] = (float)P1[(size_t)tq * NP1 + 256 + h * 64 + lane];
        LDS_WAIT();
        const bool lat = tq < ML;
        const int b = lat ? tq / SEQ : (tq - ML) / CTXL;
        const int pos = tq % SEQ, r = pos >> 6, qc = pos & 63;
        int r0 = r - 4; r0 = r0 < 0 ? 0 : (r0 > 24 ? 24 : r0);
        int cs = qc - 8; cs = cs < 0 ? 0 : (cs > 48 ? 48 : cs);
        const int nloc = lat ? 128 : 0, nk = nloc + 256;
        float sc[6]; int tk[6];
        float mx = -3.0e38f;
#pragma unroll
        for (int i = 0; i < 6; ++i) {
            const int j = lane + 64 * i; sc[i] = -3.0e38f; tk[i] = 0;
            if (j < nk) {
                float bias = 0.f; int tok;
                if (j < nloc) { const int w = j >> 4, kk = j & 15; tok = b * SEQ + (r0 + w) * 64 + cs + kk;
                    int co = cs + kk - qc; co = co < -15 ? -15 : (co > 15 ? 15 : co);
                    bias = rpb[(h * 15 + (r0 + w - r + 7)) * 31 + co + 15]; }
                else tok = ML + b * CTXL + (j - nloc);
                tk[i] = tok;
                const f16* kp = P1 + (size_t)tok * NP1 + 512 + h * 64;
                float s = 0.f;
#pragma unroll
                for (int c = 0; c < 8; ++c) { const f16x8 kv = *(const f16x8*)(kp + 8 * c);
#pragma unroll
                    for (int q = 0; q < 8; ++q) s += qs[8 * c + q] * (float)kv[q]; }
                sc[i] = s + bias; mx = fmaxf(mx, sc[i]);
            }
        }
        mx = wave_max(mx);
        float sum = 0.f;
#pragma unroll
        for (int i = 0; i < 6; ++i) { const int j = lane + 64 * i; if (j < nk) { const float p = __expf(sc[i] - mx); sum += p; ps[j] = p; } }
        sum = wave_sum(sum);
        LDS_WAIT();
        float o = 0.f;
        for (int j = 0; j < nk; ++j) {
            int tok;
            if (j < nloc) tok = b * SEQ + (r0 + (j >> 4)) * 64 + cs + (j & 15); else tok = ML + b * CTXL + (j - nloc);
            o += ps[j] * (float)P1[(size_t)tok * NP1 + 768 + h * 64 + lane];
        }
        CAT[(size_t)tq * D + 256 + h * 64 + lane] = (f16)(o / sum);
        LDS_WAIT();
    }
}
__device__ __forceinline__ void mlprep_phase(unsigned char* ws, LAS unsigned char* lds, int layer, int gw, int ngw, int lane) {
    const f16* P1 = (const f16*)(ws + WS_P1);
    f16* QK = (f16*)(ws + WS_QK);
    const float* cw = INP(I_CONVW) + (size_t)layer * 3 * 1024;
    const float2* ROPE = (const float2*)(ws + WS_ROPE);
    float wq[3][8], wk[3][8];
#pragma unroll
    for (int t = 0; t < 3; ++t) { const f32x4 a0 = *(const f32x4*)(cw + t * 1024 + 8 * lane), a1 = *(const f32x4*)(cw + t * 1024 + 8 * lane + 4), b0 = *(const f32x4*)(cw + t * 1024 + 512 + 8 * lane), b1 = *(const f32x4*)(cw + t * 1024 + 512 + 8 * lane + 4);
#pragma unroll
        for (int j = 0; j < 4; ++j) { wq[t][j] = a0[j]; wq[t][4 + j] = a1[j]; wk[t][j] = b0[j]; wk[t][4 + j] = b1[j]; } }
    const int fi0 = (lane & 3) * 8;
    const bool first = (lane & 4) == 0;
    const int half = (lane >> 3) & 1;
    f16x8 z8; for (int j = 0; j < 8; ++j) z8[j] = (f16)0.f;
    f16x8 q0n = z8, q1n = z8, q2n = z8, k0n = z8, k1n = z8, k2n = z8, vvn = z8;
#define PREP_LOAD(r_) do { const bool lat_ = (r_) < ML; const int s0_ = lat_ ? ((r_) / SEQ) * SEQ : ML + (((r_) - ML) / CTXL) * CTXL, sl_ = lat_ ? SEQ : CTXL, t_ = (r_) - s0_; \
        const f16* p_ = P1 + (size_t)(r_) * NP1 + 1024 + 8 * lane; \
        q0n = t_ > 0 ? *(const f16x8*)(p_ - NP1) : z8; q1n = *(const f16x8*)p_; q2n = t_ + 1 < sl_ ? *(const f16x8*)(p_ + NP1) : z8; \
        k0n = t_ > 0 ? *(const f16x8*)(p_ - NP1 + 512) : z8; k1n = *(const f16x8*)(p_ + 512); k2n = t_ + 1 < sl_ ? *(const f16x8*)(p_ + NP1 + 512) : z8; } while (0)
    if (gw < MT) PREP_LOAD(gw);
    for (int r = gw; r < MT; r += ngw) {
        const bool lat = r < ML;
        const int seq0 = lat ? (r / SEQ) * SEQ : ML + ((r - ML) / CTXL) * CTXL, t = r - seq0;
        const f16x8 q0 = q0n, q1 = q1n, q2 = q2n, k0 = k0n, k1 = k1n, k2 = k2n;
        if (r + ngw < MT) PREP_LOAD(r + ngw);
        float vq[8], vk[8];
#pragma unroll
        for (int j = 0; j < 8; ++j) { vq[j] = silu_(wq[0][j] * (float)q0[j] + wq[1][j] * (float)q1[j] + wq[2][j] * (float)q2[j]);
            vk[j] = silu_(wk[0][j] * (float)k0[j] + wk[1][j] * (float)k1[j] + wk[2][j] * (float)k2[j]) * 0.08838834764831845f; }
        if (lat) {
            const int pp = half ? (t & 63) : (t >> 6);
            const float2* rp = ROPE + pp * 32 + fi0;
#pragma unroll
            for (int j = 0; j < 8; ++j) { const float2 cs = rp[j];
                const float oq = __shfl_xor(vq[j], 4), ok = __shfl_xor(vk[j], 4);
                vq[j] = first ? vq[j] * cs.x - oq * cs.y : oq * cs.y + vq[j] * cs.x;
                vk[j] = first ? vk[j] * cs.x - ok * cs.y : ok * cs.y + vk[j] * cs.x; }
        }
        f16x8 hq, hk;
#pragma unroll
        for (int j = 0; j < 8; ++j) { hq[j] = (f16)vq[j]; hk[j] = (f16)vk[j]; }
        *(f16x8*)(QK + (size_t)r * 1024 + 8 * lane) = hq; *(f16x8*)(QK + (size_t)r * 1024 + 512 + 8 * lane) = hk;
    }
}
__device__ __forceinline__ void mlstm_naive_phase(unsigned char* ws, int layer, LAS unsigned char* lds, int vb, int nvb, int tid) {
    LAS float* qs = (LAS float*)lds;
    LAS float* ks = qs + 32 * 128;
    LAS float* vs = ks + 32 * 128;
    LAS float* gi = vs + 32 * 128;
    LAS float* gf = gi + 32;
    LAS float* part = gf + 32;
    LAS float* partd = part + 1024;
    const f16* P1 = (const f16*)(ws + WS_P1);
    const f16* QK = (const f16*)(ws + WS_QK);
    const float* MLG = (const float*)(ws + WS_MLG);
    float* HFB = (float*)(ws + WS_HFB);
    const float* gb = INP(I_GBIAS) + layer * 16;
    const int dg = tid >> 7, e = tid & 127;
    for (int job = vb; job < 64; job += nvb) {
        const int b = job >> 3, h = (job >> 1) & 3, dir = job & 1;
        float C[32], n[32];
#pragma unroll
        for (int i = 0; i < 32; ++i) { C[i] = 0.f; n[i] = 0.f; }
        for (int s0 = 0; s0 < CTXL + SEQ; s0 += 32) {
            __syncthreads();
            for (int i = tid; i < 32 * 128; i += NTHREADS) { const int s = s0 + (i >> 7), d = i & 127;
                const int tok = s < CTXL ? ML + b * CTXL + (dir ? CTXL - 1 - s : s) : b * SEQ + (dir ? SEQ - 1 - (s - CTXL) : (s - CTXL));
                qs[i] = (float)QK[(size_t)tok * 1024 + h * 128 + d]; ks[i] = (float)QK[(size_t)tok * 1024 + 512 + h * 128 + d];
                vs[i] = (float)P1[(size_t)tok * NP1 + 2048 + h * 128 + d];
                if (d == 0) { gi[i >> 7] = __expf(MLG[(size_t)tok * 16 + dir * 8 + h] + gb[dir * 8 + h]); gf[i >> 7] = sigmoid_(MLG[(size_t)tok * 16 + dir * 8 + 4 + h] + gb[dir * 8 + 4 + h]); } }
            __syncthreads();
            for (int s = 0; s < 32; ++s) {
                const float fi = gf[s], ii = gi[s], ve = vs[s * 128 + e] * ii;
                float pn = 0.f, pd = 0.f;
#pragma unroll
                for (int i = 0; i < 32; ++i) { const float kd = ks[s * 128 + dg * 32 + i], qd = qs[s * 128 + dg * 32 + i];
                    C[i] = fi * C[i] + kd * ve; n[i] = fi * n[i] + ii * kd; pn += qd * C[i]; pd += qd * n[i]; }
                part[((s & 1) * 4 + dg) * 128 + e] = pn; if (e == 0) partd[(s & 1) * 4 + dg] = pd;
                __syncthreads();
                if (dg == 0) { const int sb = (s & 1) * 4;
                    const float num = (part[(sb + 0) * 128 + e] + part[(sb + 1) * 128 + e]) + (part[(sb + 2) * 128 + e] + part[(sb + 3) * 128 + e]);
                    const float den = (partd[sb] + partd[sb + 1]) + (partd[sb + 2] + partd[sb + 3]);
                    const int sg = s0 + s;
                    const int tok = sg < CTXL ? ML + b * CTXL + (dir ? CTXL - 1 - sg : sg) : b * SEQ + (dir ? SEQ - 1 - (sg - CTXL) : (sg - CTXL));
                    HFB[((size_t)dir * MT + tok) * 512 + h * 128 + e] = num / fmaxf(fabsf(den), 1.f); }
            }
        }
    }
    __syncthreads();
}

#define TR_READ2(r0, r1, a0, a1) asm volatile("ds_read_b64_tr_b16 %0, %2\n\tds_read_b64_tr_b16 %1, %3\n\ts_waitcnt lgkmcnt(0)" : "=&v"(r0), "=&v"(r1) : "v"(a0), "v"(a1) : "memory")
__device__ __forceinline__ float scan_sum64(float v, int lane) {
    v += __builtin_bit_cast(float, __builtin_amdgcn_update_dpp(0, __builtin_bit_cast(int, v), 0x111, 0xF, 0xF, true));
    v += __builtin_bit_cast(float, __builtin_amdgcn_update_dpp(0, __builtin_bit_cast(int, v), 0x112, 0xF, 0xF, true));
    v += __builtin_bit_cast(float, __builtin_amdgcn_update_dpp(0, __builtin_bit_cast(int, v), 0x114, 0xF, 0xF, true));
    v += __builtin_bit_cast(float, __builtin_amdgcn_update_dpp(0, __builtin_bit_cast(int, v), 0x118, 0xF, 0xF, true));
    const int vi = __builtin_bit_cast(int, v);
    const float t0 = __builtin_bit_cast(float, __builtin_amdgcn_readlane(vi, 15)), t1 = __builtin_bit_cast(float, __builtin_amdgcn_readlane(vi, 31)), t2 = __builtin_bit_cast(float, __builtin_amdgcn_readlane(vi, 47));
    const int row = lane >> 4;
    return v + (row == 0 ? 0.f : (row == 1 ? t0 : (row == 2 ? t0 + t1 : (t0 + t1) + t2)));
}
__device__ __forceinline__ float scan_max64(float v, int lane) {
    const int ninf = __builtin_bit_cast(int, -3.0e38f);
    v = fmaxf(v, __builtin_bit_cast(float, __builtin_amdgcn_update_dpp(ninf, __builtin_bit_cast(int, v), 0x111, 0xF, 0xF, false)));
    v = fmaxf(v, __builtin_bit_cast(float, __builtin_amdgcn_update_dpp(ninf, __builtin_bit_cast(int, v), 0x112, 0xF, 0xF, false)));
    v = fmaxf(v, __builtin_bit_cast(float, __builtin_amdgcn_update_dpp(ninf, __builtin_bit_cast(int, v), 0x114, 0xF, 0xF, false)));
    v = fmaxf(v, __builtin_bit_cast(float, __builtin_amdgcn_update_dpp(ninf, __builtin_bit_cast(int, v), 0x118, 0xF, 0xF, false)));
    const int vi = __builtin_bit_cast(int, v);
    const float t0 = __builtin_bit_cast(float, __builtin_amdgcn_readlane(vi, 15)), t1 = __builtin_bit_cast(float, __builtin_amdgcn_readlane(vi, 31)), t2 = __builtin_bit_cast(float, __builtin_amdgcn_readlane(vi, 47));
    const int row = lane >> 4;
    return fmaxf(v, row == 0 ? -3.0e38f : (row == 1 ? t0 : (row == 2 ? fmaxf(t0, t1) : fmaxf(fmaxf(t0, t1), t2))));
}
__device__ __forceinline__ float log_sigmoid_(float x) { return x >= 0.f ? -log1pf(__expf(-x)) : x - log1pf(__expf(x)); }
__device__ __forceinline__ int ml_tok(int b, int dir, int ch, int s) {
    if (ch < 2) { const int idx = ch * 128 + s; return ML + b * CTXL + (dir ? CTXL - 1 - idx : idx); }
    const int idx = (ch - 2) * 128 + s; return b * SEQ + (dir ? SEQ - 1 - idx : idx);
}
#define TR_READ6(r0, r1, r2, r3, r4, r5, a, o0, o1, o2, o3, o4, o5) asm volatile( \
    "ds_read_b64_tr_b16 %0, %6 offset:" #o0 "\n\tds_read_b64_tr_b16 %1, %6 offset:" #o1 "\n\tds_read_b64_tr_b16 %2, %6 offset:" #o2 "\n\t" \
    "ds_read_b64_tr_b16 %3, %6 offset:" #o3 "\n\tds_read_b64_tr_b16 %4, %6 offset:" #o4 "\n\tds_read_b64_tr_b16 %5, %6 offset:" #o5 "\n\ts_waitcnt lgkmcnt(0)" \
    : "=&v"(r0), "=&v"(r1), "=&v"(r2), "=&v"(r3), "=&v"(r4), "=&v"(r5) : "v"(a) : "memory")
#define TR_READ8(r0, r1, r2, r3, r4, r5, r6, r7, a, b, o0, o1, p0, p1, p2, p3, p4, p5) asm volatile( \
    "ds_read_b64_tr_b16 %0, %8 offset:" #o0 "\n\tds_read_b64_tr_b16 %1, %8 offset:" #o1 "\n\t" \
    "ds_read_b64_tr_b16 %2, %9 offset:" #p0 "\n\tds_read_b64_tr_b16 %3, %9 offset:" #p1 "\n\tds_read_b64_tr_b16 %4, %9 offset:" #p2 "\n\t" \
    "ds_read_b64_tr_b16 %5, %9 offset:" #p3 "\n\tds_read_b64_tr_b16 %6, %9 offset:" #p4 "\n\tds_read_b64_tr_b16 %7, %9 offset:" #p5 "\n\ts_waitcnt lgkmcnt(0)" \
    : "=&v"(r0), "=&v"(r1), "=&v"(r2), "=&v"(r3), "=&v"(r4), "=&v"(r5), "=&v"(r6), "=&v"(r7) : "v"(a), "v"(b) : "memory")
struct FfnItem { unsigned long long s0, s1; f16* dst; int ld, ldd, k0, n0, mode; };
__device__ __forceinline__ void ffn_item(unsigned char* ws, LAS unsigned char* lds, int L, int it, unsigned long long& s0, unsigned long long& s1, f16*& dst, int& ld, int& ldd, int& k0, int& n0, int& mode) {
    const bool moe = (L & 1); const int fi = L >> 1, nexp = moe ? NE : 1;
    const int e = it / FFN_ITEMS, r = it - e * FFN_ITEMS;
    const size_t eo = (size_t)(fi * nexp + e) * D * DFF;
    unsigned char* W = ws + WS_W;
    if (r < 16 * (NFF2 / 32)) { mode = 1; s0 = (unsigned long long)((moe ? INP(I_MW1) : INP(I_FW1)) + eo); s1 = (unsigned long long)((moe ? INP(I_MW3) : INP(I_FW3)) + eo);
        ld = DFF; ldd = D; k0 = 64 * (r / (NFF2 / 32)); n0 = 32 * (r % (NFF2 / 32)); dst = (f16*)(W + (moe ? WO_13 : WO_13D)) + (size_t)e * NFF2 * D; }
    else { const int r2 = r - 16 * (NFF2 / 32); mode = 0; s0 = (unsigned long long)((moe ? INP(I_MW2) : INP(I_FW2)) + eo); s1 = s0;
        ld = D; ldd = DFF; k0 = 64 * (r2 / 32); n0 = 32 * (r2 % 32); dst = (f16*)(W + (moe ? WO_2 : WO_2D)) + (size_t)e * D * DFF; }
}
__device__ __forceinline__ void ffn_dma_issue(unsigned char* ws, LAS unsigned char* lds, LAS unsigned char* cscr, int L, int it, int lane) {
    unsigned long long s0, s1; f16* dst; int ld, ldd, k0, n0, mode; ffn_item(ws, lds, L, it, s0, s1, dst, ld, ldd, k0, n0, mode);
    const int n = n0 + 4 * (lane & 7);
    const bool useS1 = (mode != 0) && (n & 128);
    const unsigned lo = useS1 ? (unsigned)s1 : (unsigned)s0, hi = useS1 ? (unsigned)(s1 >> 32) : (unsigned)(s0 >> 32);
    const float* sp = (const float*)(const __attribute__((address_space(1))) float*)(((unsigned long long)hi << 32) | lo);
    sp += (mode == 0 ? n : ((n >> 8) << 7) + (n & 127)) + (size_t)(k0 + (lane >> 3)) * ld;
#pragma unroll
    for (int j = 0; j < 8; ++j) __builtin_amdgcn_global_load_lds((const unsigned*)(sp + (size_t)(8 * j) * ld), (LAS unsigned*)(cscr + j * 1040), 16, 0, 2);
}
__device__ __forceinline__ void ffn_dma_finish(unsigned char* ws, LAS unsigned char* lds, LAS unsigned char* cscr, int L, int it, int lane) {
    unsigned long long s0, s1; f16* dst; int ld, ldd, k0, n0, mode; ffn_item(ws, lds, L, it, s0, s1, dst, ld, ldd, k0, n0, mode);
    const int c8 = lane & 7;
#pragma unroll
    for (int jj = 0; jj < 4; ++jj) { const int nn = (lane >> 3) + 8 * jj; const LAS float* sc = (const LAS float*)(cscr + c8 * 1040) + nn;
        f16x8 h;
#pragma unroll
        for (int q = 0; q < 8; ++q) h[q] = (f16)sc[q * 32];
        *(f16x8*)(dst + (size_t)(n0 + nn) * ldd + k0 + 8 * c8) = h; }
}
struct ConvSeg { int LA, a0, an, LB, b0, bn; };
__device__ __forceinline__ void mlstm_mfma_phase(unsigned char* ws, int layer, LAS unsigned char* lds, int vb, int nvb, int tid, const ConvSeg cs) {
    const int conv_n = cs.an + cs.bn;
    constexpr int KROW = 272, VROW = 112, CROW = 272;
    static_assert(16 * VROW == 1792 && 4 * VROW == 448 && 4 * KROW == 1088, "TR_READ offsets below are written out as literals");
    constexpr int OFF_K = 0, OFF_V = 128 * KROW, OFF_CT = OFF_V + 128 * VROW, OFF_G = OFF_CT + 48 * CROW, GBUF = 2560, OFF_RAW = OFF_G + 2 * GBUF;
    LAS unsigned char* Ks = lds + OFF_K; LAS unsigned char* Vs = lds + OFF_V; LAS unsigned char* CTs = lds + OFF_CT;
    const f16* P1 = (const f16*)(ws + WS_P1);
    const f16* QK = (const f16*)(ws + WS_QK);
    const float* MLG = (const float*)(ws + WS_MLG);
    float* HFB = (float*)(ws + WS_HFB);
    const float* gb = INP(I_GBIAS) + layer * 16;
    const int lane = tid & 63, w = __builtin_amdgcn_readfirstlane(tid >> 6), g = lane >> 4, c = lane & 15, cq = c >> 2, cp = c & 3;
    const int srow = tid >> 2, sq = tid & 3;
    LAS unsigned char* cscr = lds + OFF_RAW + 2 * 2304 * 4 + w * 8320;
    const int cgw = vb * NWAVES + w, cngw = nvb * NWAVES;
    for (int job = vb; job < 256; job += nvb) {
        const int b = job >> 5, h = (job >> 3) & 3, dir = (job >> 2) & 1, eq = job & 3;
        const float gbi = gb[dir * 8 + h], gbf = gb[dir * 8 + 4 + h];
        __syncthreads();
        for (int i = tid; i < 48 * CROW / 16; i += NTHREADS) *(LAS u32x4*)(CTs + 16 * i) = (u32x4){0u, 0u, 0u, 0u};
        if (sq == 0) { unsigned ob = 0x3C00u, zb = 0u; asm volatile("" : "+v"(ob), "+v"(zb));
            *(LAS u32x4*)(Vs + srow * VROW + 64) = (u32x4){ob, zb, zb, zb}; *(LAS u32x4*)(Vs + srow * VROW + 80) = (u32x4){zb, zb, zb, zb}; }
        f32x4 C[3];
#pragma unroll
        for (int et = 0; et < 3; ++et) C[et] = (f32x4){0.f, 0.f, 0.f, 0.f};
        float m = -1e30f;
        { LAS float* raw = (LAS float*)(lds + OFF_RAW);
          for (int i = tid; i < 2304; i += NTHREADS) { const int tk = ml_tok(b, dir, i >> 7, i & 127); raw[i] = MLG[(size_t)tk * 16 + dir * 8 + h]; raw[2304 + i] = MLG[(size_t)tk * 16 + dir * 8 + 4 + h]; } }
        f16x8 kreg[4], vreg, qreg[4];
        { const int tokS = ml_tok(b, dir, 0, srow);
#pragma unroll
          for (int i = 0; i < 4; ++i) kreg[i] = *(const f16x8*)(QK + (size_t)tokS * 1024 + 512 + h * 128 + (4 * i + sq) * 8);
          vreg = *(const f16x8*)(P1 + (size_t)tokS * NP1 + 2048 + h * 128 + eq * 32 + sq * 8);
          const int tokT = ml_tok(b, dir, 0, 16 * w + c);
#pragma unroll
          for (int kd = 0; kd < 4; ++kd) qreg[kd] = *(const f16x8*)(QK + (size_t)tokT * 1024 + h * 128 + 32 * kd + 8 * g);
        }
        __syncthreads();
#define ML_GATES(chn_) do { LAS float* gq = (LAS float*)(lds + OFF_G + ((chn_) & 1) * GBUF); const LAS float* raw = (const LAS float*)(lds + OFF_RAW) + (chn_) * 128; \
            const float ig0 = raw[lane] + gbi, ig1 = raw[lane + 64] + gbi, lf0 = log_sigmoid_(raw[2304 + lane] + gbf), lf1 = log_sigmoid_(raw[2304 + lane + 64] + gbf); \
            const float b0 = scan_sum64(lf0, lane), tot0 = __shfl(b0, 63), b1 = scan_sum64(lf1, lane) + tot0, b_end = __shfl(b1, 63); \
            const float ct0 = ig0 - b0, ct1 = ig1 - b1; \
            const float a0 = scan_max64(ct0, lane), am0 = __shfl(a0, 63), a1 = fmaxf(scan_max64(ct1, lane), am0), amax = __shfl(a1, 63); \
            const float M = fmaxf(m, amax), Mt0 = fmaxf(a0, m), Mt1 = fmaxf(a1, m); \
            gq[lane] = ct0; gq[lane + 64] = ct1; gq[128 + lane] = Mt0; gq[192 + lane] = Mt1; \
            gq[256 + lane] = __expf(-(b0 + Mt0)); gq[320 + lane] = __expf(-(b1 + Mt1)); gq[384 + lane] = __expf(m - Mt0); gq[448 + lane] = __expf(m - Mt1); \
            ((LAS f16*)(gq + 512))[lane] = (f16)__expf(ct0 - M); ((LAS f16*)(gq + 512))[lane + 64] = (f16)__expf(ct1 - M); \
            if (lane == 0) gq[576] = __expf(m - M); \
            m = b_end + M; } while (0)
        if (w == 0) ML_GATES(0);
        for (int ch = 0; ch < 18; ++ch) {
            LAS float* g_ct = (LAS float*)(lds + OFF_G + (ch & 1) * GBUF); LAS float* g_mt = g_ct + 128; LAS float* g_emt = g_ct + 256; LAS float* g_wi = g_ct + 384; LAS f16* g_w16 = (LAS f16*)(g_ct + 512);
#pragma unroll
            for (int i = 0; i < 4; ++i) *(LAS f16x8*)(Ks + srow * KROW + (4 * i + sq) * 16) = kreg[i];
            *(LAS f16x8*)(Vs + srow * VROW + sq * 16) = vreg;
            f16x8 qf[4];
#pragma unroll
            for (int kd = 0; kd < 4; ++kd) qf[kd] = qreg[kd];
            const int tokT = ml_tok(b, dir, ch, 16 * w + c);
            __syncthreads();
            if (conv_n > 0 && ch > 0) { const int itp = (ch - 1) * cngw + cgw; if (itp < conv_n) { asm volatile("s_waitcnt vmcnt(2)" ::: "memory"); ffn_dma_finish(ws, lds, cscr, itp < cs.an ? cs.LA : cs.LB, itp < cs.an ? cs.a0 + itp : cs.b0 + itp - cs.an, lane); } }
            if (ch + 1 < 18) { const int tokS = ml_tok(b, dir, ch + 1, srow);
#pragma unroll
                for (int i = 0; i < 4; ++i) kreg[i] = *(const f16x8*)(QK + (size_t)tokS * 1024 + 512 + h * 128 + (4 * i + sq) * 8);
                vreg = *(const f16x8*)(P1 + (size_t)tokS * NP1 + 2048 + h * 128 + eq * 32 + sq * 8);
                const int tokN = ml_tok(b, dir, ch + 1, 16 * w + c);
#pragma unroll
                for (int kd = 0; kd < 4; ++kd) qreg[kd] = *(const f16x8*)(QK + (size_t)tokN * 1024 + h * 128 + 32 * kd + 8 * g);
            }
            const float decay = g_ct[576];
            f32x4 st[8];
#pragma unroll
            for (int j = 0; j < 8; ++j) { st[j] = (f32x4){0.f, 0.f, 0.f, 0.f};
                if (j <= w) {
#pragma unroll
                    for (int ks = 0; ks < 4; ++ks) { const f16x8 a = *(const LAS f16x8*)(Ks + (16 * j + c) * KROW + (32 * ks + 8 * g) * 2);
                        st[j] = __builtin_amdgcn_mfma_f32_16x16x32_f16(a, qf[ks], st[j], 0, 0, 0); } } }
            const int tl = 16 * w + c; const float mt = g_mt[tl];
            f16x8 pf[4];
#pragma unroll
            for (int ks = 0; ks < 4; ++ks) {
#pragma unroll
                for (int hh = 0; hh < 2; ++hh) { const int j = 2 * ks + hh;
                    if (j <= w) { const f32x4 cv = *(const LAS f32x4*)(g_ct + 16 * j + 4 * g);
#pragma unroll
                        for (int i = 0; i < 4; ++i) { const int sl = 16 * j + 4 * g + i; const float v = (sl <= tl) ? st[j][i] * __expf(cv[i] - mt) : 0.f; pf[ks][4 * hh + i] = (f16)v; } }
                    else {
#pragma unroll
                        for (int i = 0; i < 4; ++i) pf[ks][4 * hh + i] = (f16)0.f; } } }
            if (conv_n > 0) { const int itc = ch * cngw + cgw; if (itc < conv_n) { LDS_WAIT(); ffn_dma_issue(ws, lds, cscr, itc < cs.an ? cs.LA : cs.LB, itc < cs.an ? cs.a0 + itc : cs.b0 + itc - cs.an, lane); } }
            f32x4 o1[3], o2[3];
#pragma unroll
            for (int et = 0; et < 3; ++et) { o1[et] = (f32x4){0.f, 0.f, 0.f, 0.f}; o2[et] = (f32x4){0.f, 0.f, 0.f, 0.f}; }
            const unsigned vs_base = (unsigned)(size_t)Vs, ks_base = (unsigned)(size_t)Ks;
#pragma unroll
            for (int ks = 0; ks < 4; ++ks) if (2 * ks <= w) {
                f16x4 t0, t1, t2, t3, t4, t5;
                const unsigned a0 = vs_base + (32 * ks + 4 * g + cq) * VROW + (4 * cp) * 2;
                TR_READ6(t0, t1, t2, t3, t4, t5, a0, 0, 1792, 32, 1824, 64, 1856);
                o1[0] = __builtin_amdgcn_mfma_f32_16x16x32_f16(__builtin_shufflevector(t0, t1, 0, 1, 2, 3, 4, 5, 6, 7), pf[ks], o1[0], 0, 0, 0);
                o1[1] = __builtin_amdgcn_mfma_f32_16x16x32_f16(__builtin_shufflevector(t2, t3, 0, 1, 2, 3, 4, 5, 6, 7), pf[ks], o1[1], 0, 0, 0);
                o1[2] = __builtin_amdgcn_mfma_f32_16x16x32_f16(__builtin_shufflevector(t4, t5, 0, 1, 2, 3, 4, 5, 6, 7), pf[ks], o1[2], 0, 0, 0); }
#pragma unroll
            for (int kd = 0; kd < 4; ++kd) {
#pragma unroll
                for (int et = 0; et < 3; ++et) { const f16x8 av = *(const LAS f16x8*)(CTs + (16 * et + c) * CROW + (32 * kd + 8 * g) * 2);
                    o2[et] = __builtin_amdgcn_mfma_f32_16x16x32_f16(av, qf[kd], o2[et], 0, 0, 0); } }
            { const float wi = g_wi[tl];
              const float denl = o1[2][0] + wi * o2[2][0];
              const float den = __shfl(denl, c);
              const float inv = 1.f / fmaxf(fabsf(den), g_emt[tl]);
              float* hp = HFB + ((size_t)dir * MT + tokT) * 512 + h * 128 + eq * 32 + 4 * g;
#pragma unroll
              for (int et = 0; et < 2; ++et) *(f32x4*)(hp + 16 * et) = (o1[et] + o2[et] * wi) * inv; }
#pragma unroll
            for (int et = 0; et < 3; ++et) C[et] = C[et] * decay;
#pragma unroll
            for (int ks = 0; ks < 4; ++ks) { f16x4 k0, k1, v0, v1, v2, v3, v4, v5;
                const unsigned ka = ks_base + (32 * ks + 8 * g + cq) * KROW + (16 * w + 4 * cp) * 2;
                const unsigned va = vs_base + (32 * ks + 8 * g + cq) * VROW + (4 * cp) * 2;
                TR_READ8(k0, k1, v0, v1, v2, v3, v4, v5, ka, va, 0, 1088, 0, 448, 32, 480, 64, 512);
                f16x8 kt = __builtin_shufflevector(k0, k1, 0, 1, 2, 3, 4, 5, 6, 7);
                const f16x8 wv = *(const LAS f16x8*)(g_w16 + 32 * ks + 8 * g);
                kt = kt * wv;
                C[0] = __builtin_amdgcn_mfma_f32_16x16x32_f16(kt, __builtin_shufflevector(v0, v1, 0, 1, 2, 3, 4, 5, 6, 7), C[0], 0, 0, 0);
                C[1] = __builtin_amdgcn_mfma_f32_16x16x32_f16(kt, __builtin_shufflevector(v2, v3, 0, 1, 2, 3, 4, 5, 6, 7), C[1], 0, 0, 0);
                C[2] = __builtin_amdgcn_mfma_f32_16x16x32_f16(kt, __builtin_shufflevector(v4, v5, 0, 1, 2, 3, 4, 5, 6, 7), C[2], 0, 0, 0); }
            if (w == 0 && ch + 1 < 18) ML_GATES(ch + 1);
            __syncthreads();
#pragma unroll
            for (int et = 0; et < 3; ++et) { f16x4 cv; cv[0] = (f16)C[et][0]; cv[1] = (f16)C[et][1]; cv[2] = (f16)C[et][2]; cv[3] = (f16)C[et][3];
                *(LAS f16x4*)(CTs + (16 * et + c) * CROW + (16 * w + 4 * g) * 2) = cv; }
        }
        if (conv_n > 0) { const int itp = 17 * cngw + cgw; if (itp < conv_n) { asm volatile("s_waitcnt vmcnt(2)" ::: "memory"); ffn_dma_finish(ws, lds, cscr, itp < cs.an ? cs.LA : cs.LB, itp < cs.an ? cs.a0 + itp : cs.b0 + itp - cs.an, lane); } }
#undef ML_GATES
    }
    __syncthreads();
}

__device__ __forceinline__ void na_mfma_phase(unsigned char* ws, int layer, LAS unsigned char* lds, int vb, int nvb, int tid) {
    constexpr int VROW = 144;
    constexpr int OFF_B = 768 * VROW, OFF_M = OFF_B + 2048;
    LAS unsigned char* Vs = lds; LAS float* Bs = (LAS float*)(lds + OFF_B); LAS float* Ms = (LAS float*)(lds + OFF_M);
    const f16* P1 = (const f16*)(ws + WS_P1);
    f16* CAT = (f16*)(ws + WS_CAT);
    const int lane = tid & 63, w = __builtin_amdgcn_readfirstlane(tid >> 6), g = lane >> 4, c = lane & 15, cq = c >> 2, cp = c & 3;
    const int qt = w & 3, kh = w >> 2;
    int kst = 16 * qt - 8; kst = kst < 0 ? 0 : (kst > 32 ? 32 : kst);
    const int nU = 1024 + ((layer == DEPTH - 1) ? 0 : 128);
    for (int un = vb; un < nU; un += nvb) {
        const bool lat = un < 1024;
        int b, r, h, qblk;
        if (lat) { b = un >> 7; r = (un >> 2) & 31; h = un & 3; qblk = 0; } else { const int u2 = un - 1024; b = u2 >> 4; h = (u2 >> 2) & 3; qblk = u2 & 3; r = 0; }
        int r0 = r - 4; r0 = r0 < 0 ? 0 : (r0 > 24 ? 24 : r0);
        const int qtok = lat ? b * SEQ + r * 64 + 16 * qt + c : ML + b * CTXL + qblk * 64 + 16 * qt + c;
        __syncthreads();
        {
            const int nch = (lat ? 768 : 256) * 8;
            for (int ch = tid; ch < nch; ch += NTHREADS) { const int row = ch >> 3, pc = ch & 7;
                const int tok = lat ? (row < 512 ? b * SEQ + (r0 + (row >> 6)) * 64 + (row & 63) : ML + b * CTXL + row - 512) : ML + b * CTXL + row;
                *(LAS u32x4*)(Vs + row * VROW + pc * 16) = *(const u32x4*)(P1 + (size_t)tok * NP1 + 768 + h * 64 + pc * 8); }
            if (lat) { const float* rp = INP(I_RPB) + (size_t)(layer * 4 + h) * 465; for (int i = tid; i < 465; i += NTHREADS) Bs[i] = rp[i]; }
        }
        f16x8 qf[2];
#pragma unroll
        for (int ks = 0; ks < 2; ++ks) qf[ks] = *(const f16x8*)(P1 + (size_t)qtok * NP1 + 256 + h * 64 + 32 * ks + 8 * g);
        f32x4 st[16];
#pragma unroll
        for (int idx = 0; idx < 16; ++idx) {
            st[idx] = (f32x4){0.f, 0.f, 0.f, 0.f};
            if (idx >= 8 || lat) {
                int tok;
                if (idx < 8) tok = b * SEQ + (r0 + kh * 4 + (idx >> 1)) * 64 + kst + 16 * (idx & 1) + c;
                else tok = ML + b * CTXL + kh * 128 + 16 * (idx - 8) + c;
                const f16* kp = P1 + (size_t)tok * NP1 + 512 + h * 64 + 8 * g;
                const f16x8 k0 = *(const f16x8*)kp, k1 = *(const f16x8*)(kp + 32);
                st[idx] = __builtin_amdgcn_mfma_f32_16x16x32_f16(k0, qf[0], st[idx], 0, 0, 0);
                st[idx] = __builtin_amdgcn_mfma_f32_16x16x32_f16(k1, qf[1], st[idx], 0, 0, 0);
            }
        }
        __syncthreads();
        const int qc = 16 * qt + c; int cs = qc - 8; cs = cs < 0 ? 0 : (cs > 48 ? 48 : cs);
        float mx = -3.0e38f;
#pragma unroll
        for (int idx = 0; idx < 16; ++idx) {
            if (idx < 8) {
                const int wrow = kh * 4 + (idx >> 1);
#pragma unroll
                for (int i = 0; i < 4; ++i) { const int kc = kst + 16 * (idx & 1) + 4 * g + i; const bool ok = lat && kc >= cs && kc < cs + 16;
                    const float bias = ok ? Bs[(r0 + wrow - r + 7) * 31 + kc - qc + 15] : 0.f;
                    st[idx][i] = ok ? st[idx][i] + bias : -1.0e30f; }
            }
#pragma unroll
            for (int i = 0; i < 4; ++i) mx = fmaxf(mx, st[idx][i]);
        }
        mx = fmaxf(mx, __shfl_xor(mx, 16)); mx = fmaxf(mx, __shfl_xor(mx, 32));
        float l = 0.f;
        f16x8 pf[8];
#pragma unroll
        for (int idx = 0; idx < 16; ++idx) {
#pragma unroll
            for (int i = 0; i < 4; ++i) { const float p = __expf(st[idx][i] - mx); l += p; pf[idx >> 1][4 * (idx & 1) + i] = (f16)p; }
        }
        l += __shfl_xor(l, 16); l += __shfl_xor(l, 32);
        f32x4 o[4];
#pragma unroll
        for (int dt = 0; dt < 4; ++dt) o[dt] = (f32x4){0.f, 0.f, 0.f, 0.f};
        const unsigned vs_base = (unsigned)(size_t)Vs;
#pragma unroll
        for (int kk = 0; kk < 8; ++kk) {
            if (kk >= 4 || lat) {
                int rb0, rb1;
                if (kk < 4) { rb0 = (kh * 4 + kk) * 64 + kst; rb1 = rb0 + 16; }
                else { rb0 = (lat ? 512 : 0) + kh * 128 + 16 * (2 * kk - 8); rb1 = rb0 + 16; }
                { f16x4 x0, x1, x2, x3, y0, y1, y2, y3;
                  const unsigned a0 = vs_base + (rb0 + 4 * g + cq) * VROW + (4 * cp) * 2, a1 = vs_base + (rb1 + 4 * g + cq) * VROW + (4 * cp) * 2;
                  asm volatile("ds_read_b64_tr_b16 %0, %8\n\tds_read_b64_tr_b16 %1, %8 offset:32\n\tds_read_b64_tr_b16 %2, %8 offset:64\n\tds_read_b64_tr_b16 %3, %8 offset:96\n\t"
                               "ds_read_b64_tr_b16 %4, %9\n\tds_read_b64_tr_b16 %5, %9 offset:32\n\tds_read_b64_tr_b16 %6, %9 offset:64\n\tds_read_b64_tr_b16 %7, %9 offset:96\n\ts_waitcnt lgkmcnt(0)"
                               : "=&v"(x0), "=&v"(x1), "=&v"(x2), "=&v"(x3), "=&v"(y0), "=&v"(y1), "=&v"(y2), "=&v"(y3) : "v"(a0), "v"(a1) : "memory");
                  o[0] = __builtin_amdgcn_mfma_f32_16x16x32_f16(__builtin_shufflevector(x0, y0, 0, 1, 2, 3, 4, 5, 6, 7), pf[kk], o[0], 0, 0, 0);
                  o[1] = __builtin_amdgcn_mfma_f32_16x16x32_f16(__builtin_shufflevector(x1, y1, 0, 1, 2, 3, 4, 5, 6, 7), pf[kk], o[1], 0, 0, 0);
                  o[2] = __builtin_amdgcn_mfma_f32_16x16x32_f16(__builtin_shufflevector(x2, y2, 0, 1, 2, 3, 4, 5, 6, 7), pf[kk], o[2], 0, 0, 0);
                  o[3] = __builtin_amdgcn_mfma_f32_16x16x32_f16(__builtin_shufflevector(x3, y3, 0, 1, 2, 3, 4, 5, 6, 7), pf[kk], o[3], 0, 0, 0); }
            }
        }
        LAS float* mp = Ms + (qt * 64 + lane) * 18;
        if (kh == 1) { mp[0] = mx; mp[1] = l;
#pragma unroll
            for (int dt = 0; dt < 4; ++dt) *(LAS f32x4*)(mp + 2 + 4 * dt) = o[dt]; }
        __syncthreads();
        if (kh == 0) {
            const float mx2 = mp[0], l2 = mp[1], mxn = fmaxf(mx, mx2), fa = __expf(mx - mxn), fb = __expf(mx2 - mxn);
            const float inv = 1.f / (l * fa + l2 * fb);
            f16* op = CAT + (size_t)qtok * D + 256 + h * 64 + 4 * g;
#pragma unroll
            for (int dt = 0; dt < 4; ++dt) { const f32x4 o2 = *(const LAS f32x4*)(mp + 2 + 4 * dt); const f32x4 v = (o[dt] * fa + o2 * fb) * inv;
                f16x4 hv; hv[0] = (f16)v[0]; hv[1] = (f16)v[1]; hv[2] = (f16)v[2]; hv[3] = (f16)v[3];
                *(f16x4*)(op + 16 * dt) = hv; }
        }
    }
    __syncthreads();
}

__device__ __forceinline__ void mout_phase(unsigned char* ws, LAS unsigned char* lds, int layer, int gw, int ngw, int lane) {
    const f16* P1 = (const f16*)(ws + WS_P1);
    const float* HFB = (const float*)(ws + WS_HFB);
    f16* CAT = (f16*)(ws + WS_CAT);
    const float* nw = INP(I_NORMW) + layer * 512;
    const int nrows = (layer == DEPTH - 1) ? ML : MT;
    const f32x4 nw0 = *(const f32x4*)(nw + 8 * lane), nw1 = *(const f32x4*)(nw + 8 * lane + 4);
    f32x4 a0n, a1n, b0n, b1n; f16x8 ogn;
#define MOUT_LOAD(r_) do { const float* pf = HFB + (size_t)(r_) * 512 + 8 * lane; const float* pb = HFB + ((size_t)MT + (r_)) * 512 + 8 * lane; \
        a0n = *(const f32x4*)pf; a1n = *(const f32x4*)(pf + 4); b0n = *(const f32x4*)pb; b1n = *(const f32x4*)(pb + 4); ogn = *(const f16x8*)(P1 + (size_t)(r_) * NP1 + 2560 + 8 * lane); } while (0)
    if (gw < nrows) MOUT_LOAD(gw);
    for (int r = gw; r < nrows; r += ngw) {
        const f32x4 a0 = a0n, a1 = a1n, b0 = b0n, b1 = b1n; const f16x8 og = ogn;
        if (r + ngw < nrows) MOUT_LOAD(r + ngw);
        float v[8] = {a0[0] + b0[0], a0[1] + b0[1], a0[2] + b0[2], a0[3] + b0[3], a1[0] + b1[0], a1[1] + b1[1], a1[2] + b1[2], a1[3] + b1[3]};
        float s = 0.f;
#pragma unroll
        for (int i = 0; i < 8; ++i) s += v[i];
        s = row16_sum(s);
        const float mean = s * (1.f / 128.f); float q = 0.f;
#pragma unroll
        for (int i = 0; i < 8; ++i) { v[i] -= mean; q += v[i] * v[i]; }
        q = row16_sum(q);
        const float rstd = 1.f / sqrtf(q * (1.f / 128.f) + LN_EPS);
        f16x8 h;
#pragma unroll
        for (int i = 0; i < 8; ++i) h[i] = (f16)((float)og[i] * v[i] * rstd * (i < 4 ? nw0[i] : nw1[i - 4]));
        *(f16x8*)(CAT + (size_t)r * D + 512 + 8 * lane) = h;
    }
#undef MOUT_LOAD
}

__device__ __forceinline__ void moe_tail(int nblk, int& tail_blocks, int& S) {
    const int R = (nblk & 63) * 4;
    tail_blocks = nblk & 63; S = R == 0 ? 1 : (R <= 36 ? 7 : (R <= 64 ? 4 : (R <= 128 ? 2 : 1)));
    if (S == 1) tail_blocks = 0;
}
constexpr int NPH = 13;
#if MK_FUSED
#define GRID_BAR() xcd_barrier(bar)
#else
#define GRID_BAR() do {} while (0)
#endif
template <int layer>
__device__ __forceinline__ void layer_body(const Args& args, LAS unsigned char* lds, const int tid0, const int wave0, const int vb0, const int nvb0,
                                           unsigned char* ws0, unsigned* ctl, const XcdBarrier& bar, const int s_lo, const int s_hi) {
        constexpr bool last = (layer == DEPTH - 1), moe = (layer & 1) != 0;
        constexpr int mi = layer >> 1;
        const int nrows = last ? ML : MT;
#define STEP(p) (layer * NPH + (p))
#if MK_FUSED
#define RUN(p) (((PH_MASK >> (p)) & 1) != 0)
#else
#define RUN(p) (((PH_MASK >> (p)) & 1) && STEP(p) >= s_lo && STEP(p) < s_hi)
#endif
#define NREP(p) (((p) == PROBE_PH && (PROBE_LAYER < 0 || layer == PROBE_LAYER)) ? 1 + PROBE_REP : 1)
#define FRESH_TID() int tid = tid0; asm volatile("" : "+v"(tid)); const int lane = tid & 63; (void)lane; \
    const unsigned long long wsi_ = opaque_u64((unsigned long long)ws0); unsigned char* ws = (unsigned char*)(__attribute__((address_space(1))) unsigned char*)wsi_; const int wave = opaque_u32(wave0), vb = opaque_u32(vb0), nvb = opaque_u32(nvb0); const int gw = vb * NWAVES + wave, ngw = nvb * NWAVES; (void)gw; (void)ngw; \
    f16* U16 = (f16*)(ws + WS_U16); f16* P1 = (f16*)(ws + WS_P1); f16* CAT = (f16*)(ws + WS_CAT); f16* Z16 = (f16*)(ws + WS_Z16); \
    f16* YF = (f16*)(ws + WS_YF); f16* XS = (f16*)(ws + WS_XS); f16* HB16 = (f16*)(ws + WS_P1); f16* AMOE = (f16*)(ws + WS_HFB); unsigned char* W = ws + WS_W; \
    int2* TOKE = (int2*)(ws + WS_TOK + TK_E); float2* TOKP = (float2*)(ws + WS_TOK + TK_P); int2* TOKPOS = (int2*)(ws + WS_TOK + TK_POS); int2* TOKDEST = (int2*)(ws + WS_TOK + TK_DEST); \
    int* BLKE = (int*)(ws + WS_TOK + TK_BLKE); \
    (void)U16; (void)P1; (void)CAT; (void)Z16; (void)YF; (void)XS; (void)HB16; (void)AMOE; (void)W; (void)TOKE; (void)TOKP; (void)TOKPOS; (void)TOKDEST; (void)BLKE
#if MK_FUSED
#define SEAM(p) do { if (!(last && (p) == NPH - 1)) GRID_BAR(); } while (0)
#else
#define SEAM(p) do { } while (0)
#endif

        if (layer == 0 && RUN(0)) { for (int rep_ = 0; rep_ < NREP(0); ++rep_) {
            FRESH_TID();
            {
                LAS float* sv = (LAS float*)(lds + 69632);
                LAS float* red = sv + 9 * 1024;
                for (int i = tid; i < 9 * 1024; i += NTHREADS) { const int r = i >> 10, k = i & 1023; const float c = r < 8 ? INP(I_C)[r * 1024 + k] : INP(I_CCTX)[k]; sv[i] = silu_(c); }
                __syncthreads();
                const int kg = tid >> 7, jj = tid & 127;
                for (int job = vb; job < 4 * 48; job += nvb) {
                    const int l = job / 48, j = (job % 48) * 128 + jj;
                    const float* wp = INP(I_WMOD) + (size_t)l * D * 6144 + j;
                    float acc[9];
#pragma unroll
                    for (int r = 0; r < 9; ++r) acc[r] = 0.f;
                    for (int k = kg * 256; k < kg * 256 + 256; ++k) { const float w = wp[(size_t)k * 6144];
#pragma unroll
                        for (int r = 0; r < 9; ++r) acc[r] += sv[r * 1024 + k] * w; }
#pragma unroll
                    for (int r = 0; r < 9; ++r) red[(kg * 9 + r) * 128 + jj] = acc[r];
                    __syncthreads();
                    for (int i = tid; i < 9 * 128; i += NTHREADS) { const int r = i >> 7, c = i & 127;
                        const float s = (red[(0 * 9 + r) * 128 + c] + red[(1 * 9 + r) * 128 + c]) + (red[(2 * 9 + r) * 128 + c] + red[(3 * 9 + r) * 128 + c]);
                        const int jc = (job % 48) * 128 + c;
                        ((float*)(ws + WS_MOD))[(size_t)(l * 9 + r) * 6144 + jc] = s + INP(I_BMOD)[l * 6144 + jc]; }
                    __syncthreads();
                }
            }
            if (vb == 0) for (int i = tid; i < 2048; i += NTHREADS) { const int p = i >> 5, fi = i & 31; const float inv = exp2f(-(float)fi * (13.287712379549449f / 32.f));
                float sn, cs; sincosf((float)p * inv, &sn, &cs); ((float2*)(ws + WS_ROPE))[i] = make_float2(cs, sn); }
            conv_layer(ws, 0, lds, gw, ngw, wave, lane, 0);
            SEAM(0);
        } }
        if (layer == 0 && RUN(1)) { for (int rep_ = 0; rep_ < NREP(1); ++rep_) {
            FRESH_TID();
            LAS float* GT = (LAS float*)(lds + 73728);
            load_gate_table(lds, 0, GT, tid);
            { f32x4 xn[4], shn[4], scn[4];
#define LOAD_MOD0(r_) do { const float* q_ = mod_row(ws, lds, 0, (r_)); _Pragma("unroll") for (int j = 0; j < 4; ++j) { shn[j] = *(const f32x4*)(q_ + 256 * j + 4 * lane); scn[j] = *(const f32x4*)(q_ + 1024 + 256 * j + 4 * lane); } } while (0)
              if (gw < MT) { load_x<0>(ws, lds, gw, xn, lane); LOAD_MOD0(gw); }
              for (int r = gw; r < MT; r += ngw) { f32x4 x[4], sh[4], sc[4];
#pragma unroll
                  for (int j = 0; j < 4; ++j) { x[j] = xn[j]; sh[j] = shn[j]; sc[j] = scn[j]; }
                  if (r + ngw < MT) { load_x<0>(ws, lds, r + ngw, xn, lane); LOAD_MOD0(r + ngw); }
                  row_A_pre(ws, r, x, sh, sc, GT, lane); } }
            SEAM(1);
        } }
        if (RUN(2)) { for (int rep_ = 0; rep_ < NREP(2); ++rep_) {
            FRESH_TID();
            EpiP1 E{P1};
            gemm_run(lds, U16, D, D, MT, NP1, (const f16*)(W + WO_IN), 0, nullptr, E, vb, nvb, tid);
            SEAM(2);
        } }
        if (RUN(3)) { for (int rep_ = 0; rep_ < NREP(3); ++rep_) {
            FRESH_TID();
            pool_phase(ws, layer, lds, vb, nvb, tid);
#if USE_NA_MFMA
            na_mfma_phase(ws, layer, lds, vb, nvb, tid);
#else
            na_phase(ws, layer, lds, gw, ngw, wave, lane);
#endif
            mlprep_phase(ws, lds, layer, gw, ngw, lane);
            SEAM(3);
        } }
#if USE_MLSTM_MFMA
        if (RUN(4)) { for (int rep_ = 0; rep_ < NREP(4); ++rep_) { FRESH_TID(); ConvSeg cs; conv_seg(layer, nvb, cs.LA, cs.a0, cs.an, cs.LB, cs.b0, cs.bn); mlstm_mfma_phase(ws, layer, lds, vb, nvb, tid, cs); SEAM(4); } }
#else
        if (RUN(4)) { for (int rep_ = 0; rep_ < NREP(4); ++rep_) { FRESH_TID(); mlstm_naive_phase(ws, layer, lds, vb, nvb, tid); SEAM(4); } }
#endif
        if (RUN(5)) { for (int rep_ = 0; rep_ < NREP(5); ++rep_) { FRESH_TID(); mout_phase(ws, lds, layer, gw, ngw, lane); SEAM(5); } }
        if (RUN(6)) { for (int rep_ = 0; rep_ < NREP(6); ++rep_) {
            FRESH_TID();
            { EpiMerge E{P1, Z16, (f16*)(ws + WS_YF + YF_PART)}; gemm_run(lds, CAT, D, D, nrows, D, (const f16*)(W + WO_BP), 0, nullptr, E, vb, nvb, tid, last ? 0 : MC, 4); }
            SEAM(6);
        } }
        if (RUN(7)) { for (int rep_ = 0; rep_ < NREP(7); ++rep_) {
            FRESH_TID();
            if constexpr (!last) {
                const f16* PZ = (const f16*)(ws + WS_YF + YF_PART);
                for (int r = gw; r < MC; r += ngw) { f32x4 z[4]; load_row_sum(PZ + (size_t)r * D, (size_t)MC * D, 4, z, lane); store_row_h(Z16 + (size_t)(ML + r) * D, z, lane); }
                GRID_BAR();
            }
            EpiF32 E{YF, D, (f16*)(ws + WS_YF + YF_PART), ML, MC};
            gemm_run(lds, Z16, D, D, nrows, D, (const f16*)(W + WO_OUT), 0, nullptr, E, vb, nvb, tid, last ? 0 : MC, 4);
            SEAM(7);
        } }
        if (RUN(8)) { for (int rep_ = 0; rep_ < NREP(8); ++rep_) {
            FRESH_TID();
            LAS float* RT = (LAS float*)lds;
            LAS int* lcnt = (LAS int*)(lds + 32768);
            LAS int* lrec = lcnt + 128;
            if (moe) { load_router_table(lds, mi, RT, tid); if (tid < 128) lcnt[tid] = 0; __syncthreads(); }
            const float* g1p = INP(I_LN1G) + layer * D; const float* b1p = INP(I_LN1B) + layer * D;
            int slot = wave;
            f32x4 xn[4], yn[4];
            const f16* PARTp = (const f16*)(ws + WS_YF + YF_PART);
#define LOAD_Y(r_, dst_) do { if ((r_) >= ML) load_row_sum(PARTp + (size_t)((r_) - ML) * D, (size_t)MC * D, 4, dst_, lane); else load_row_h(YF + (size_t)(r_) * D, dst_, lane); } while (0)
            f32x4 lg_[4], lb_[4], mgn[4], mshn[4], mscn[4];
#pragma unroll
            for (int j = 0; j < 4; ++j) { lg_[j] = *(const f32x4*)(g1p + 256 * j + 4 * lane); lb_[j] = *(const f32x4*)(b1p + 256 * j + 4 * lane); }
#define LOAD_MOD(r_) do { const float* m_ = mod_row(ws, lds, layer, (r_)); _Pragma("unroll") for (int j = 0; j < 4; ++j) { mgn[j] = *(const f32x4*)(m_ + 2048 + 256 * j + 4 * lane); mshn[j] = *(const f32x4*)(m_ + 3072 + 256 * j + 4 * lane); mscn[j] = *(const f32x4*)(m_ + 4096 + 256 * j + 4 * lane); } } while (0)
            if (gw < nrows) { load_x<layer>(ws, lds, gw, xn, lane); LOAD_Y(gw, yn); LOAD_MOD(gw); }
            for (int r = gw; r < nrows; r += ngw, slot += NWAVES) {
                f32x4 x[4], y[4], mg[4], msh[4], msc[4];
#pragma unroll
                for (int j = 0; j < 4; ++j) { x[j] = xn[j]; y[j] = yn[j]; mg[j] = mgn[j]; msh[j] = mshn[j]; msc[j] = mscn[j]; }
                if (r + ngw < nrows) { load_x<layer>(ws, lds, r + ngw, xn, lane); LOAD_Y(r + ngw, yn); LOAD_MOD(r + ngw); }
#pragma unroll
                for (int j = 0; j < 4; ++j) x[j] = x[j] * ALPHA + mg[j] * y[j];
                float mean, rstd; ln_stats(x, mean, rstd);
#pragma unroll
                for (int j = 0; j < 4; ++j) x[j] = (x[j] - mean) * rstd * lg_[j] + lb_[j];
                store_row_h(XS + (size_t)r * D, x, lane);
                ln_stats(x, mean, rstd);
                f32x4 u[4];
#pragma unroll
                for (int j = 0; j < 4; ++j) { const int k = 256 * j + 4 * lane; u[j] = (x[j] - mean) * rstd * (msc[j] + 1.f) + msh[j];
                    f16x4 h; h[0] = (f16)u[j][0]; h[1] = (f16)u[j][1]; h[2] = (f16)u[j][2]; h[3] = (f16)u[j][3];
                    *(f16x4*)(U16 + (size_t)r * D + k) = h; }
                if (moe) {
                    float lg[8];
                    { const float s0 = dot4_rows(u, RT, 0, lane), s1 = dot4_rows(u, RT, 4, lane);
#pragma unroll
                      for (int e = 0; e < 4; ++e) { lg[e] = __shfl(s0, 16 * e) + INP(I_RB)[mi * 8 + e]; lg[4 + e] = __shfl(s1, 16 * e) + INP(I_RB)[mi * 8 + 4 + e]; } }
                    int e1 = 0; float l1 = lg[0];
#pragma unroll
                    for (int e = 1; e < 8; ++e) if (lg[e] > l1) { l1 = lg[e]; e1 = e; }
                    int e2 = -1; float l2 = -3.0e38f;
#pragma unroll
                    for (int e = 0; e < 8; ++e) if (e != e1 && lg[e] > l2) { l2 = lg[e]; e2 = e; }
                    const float p2 = __expf(l2 - l1), inv = 1.f / (1.f + p2);
                    if (lane == 0) { const int lp1 = lcnt[wave * 8 + e1], lp2 = lcnt[wave * 8 + e2]; lcnt[wave * 8 + e1] = lp1 + 1; lcnt[wave * 8 + e2] = lp2 + 1;
                        lrec[slot * 4 + 0] = e1; lrec[slot * 4 + 1] = e2; lrec[slot * 4 + 2] = lp1; lrec[slot * 4 + 3] = lp2;
                        TOKE[r] = make_int2(e1, e2); TOKP[r] = make_float2(inv, p2 * inv); }
                }
            }
            if (moe) {
                __syncthreads();
                if (tid < 64) { const int w_ = tid >> 3, e_ = tid & 7; int b_ = 0; for (int q = 0; q < w_; ++q) b_ += lcnt[q * 8 + e_]; lcnt[64 + tid] = b_;
                    if (w_ == 7) ((int*)(ws + WS_TOK + TK_BCNT))[vb * 8 + e_] = b_ + lcnt[56 + e_]; }
                __syncthreads();
                slot = wave;
                for (int r = gw; r < nrows; r += ngw, slot += NWAVES)
                    if (lane == 0) TOKPOS[r] = make_int2(lcnt[64 + wave * 8 + lrec[slot * 4 + 0]] + lrec[slot * 4 + 2], lcnt[64 + wave * 8 + lrec[slot * 4 + 1]] + lrec[slot * 4 + 3]);
            }
            SEAM(8);
        } }
        if (moe && RUN(9)) { for (int rep_ = 0; rep_ < NREP(9); ++rep_) {
            FRESH_TID();
            LAS int* ps = (LAS int*)lds;
            LAS int* bc = ps + 16;
            { const int* BC = (const int*)(ws + WS_TOK + TK_BCNT); for (int i = tid; i < nvb * 8; i += NTHREADS) bc[i] = BC[i]; }
            __syncthreads();
            if (tid < 8) { int tot = 0, mine = 0; for (int q = 0; q < nvb; ++q) { const int c = bc[q * 8 + tid]; mine += (q < vb) ? c : 0; tot += c; } bc[nvb * 8 + tid] = tot; bc[nvb * 8 + 8 + tid] = mine; }
            __syncthreads();
            if (tid == 0) { int acc = 0;
#pragma unroll 1
                for (int e = 0; e < 8; ++e) { ps[e] = acc + bc[nvb * 8 + 8 + e]; const int c = bc[nvb * 8 + e]; acc += ((c + 255) >> 8) * 256; }
                ps[8] = acc; }
            __syncthreads();
            if (vb == 0) { const int nb = ps[8] >> 8; if (tid == 0) BLKE[160] = nb;
                if (tid < nb) { int e = 0;
#pragma unroll 1
                    for (int q = 1; q < 8; ++q) if (tid * 256 >= ps[q]) e = q;
                    BLKE[tid] = e; } }
            { int2 en = make_int2(0, 0), pnx = make_int2(0, 0); u32x4 vn0, vn1;
#define GATHER_LOAD(r_) do { en = TOKE[(r_)]; pnx = TOKPOS[(r_)]; const u32x4* src_ = (const u32x4*)(U16 + (size_t)(r_) * D); vn0 = src_[lane]; vn1 = src_[lane + 64]; } while (0)
              if (gw < nrows) GATHER_LOAD(gw);
              for (int r = gw; r < nrows; r += ngw) {
                const int2 e = en, p = pnx; const u32x4 v0 = vn0, v1 = vn1;
                if (r + ngw < nrows) GATHER_LOAD(r + ngw);
                const int d0 = ps[e.x] + p.x, d1 = ps[e.y] + p.y;
                u32x4* o0 = (u32x4*)(AMOE + (size_t)d0 * D); u32x4* o1 = (u32x4*)(AMOE + (size_t)d1 * D);
                o0[lane] = v0; o0[lane + 64] = v1; o1[lane] = v0; o1[lane + 64] = v1;
                if (lane == 0) TOKDEST[r] = make_int2(d0, d1);
              }
#undef GATHER_LOAD
            }
            SEAM(9);
        } }
        if (RUN(10)) { for (int rep_ = 0; rep_ < NREP(10); ++rep_) {
            FRESH_TID();
            EpiSwiGLU E{HB16};
            const int nr = moe ? __builtin_amdgcn_readfirstlane(BLKE[160]) * 256 : nrows;
            gemm_run(lds, moe ? AMOE : U16, D, D, nr, NFF2, (const f16*)(W + (moe ? WO_13 : WO_13D)), (size_t)NFF2 * D, moe ? BLKE : nullptr, E, vb, nvb, tid);
            SEAM(10);
        } }
        if (RUN(11)) { for (int rep_ = 0; rep_ < NREP(11); ++rep_) {
            FRESH_TID();
            if (moe) {
                const int nblk = __builtin_amdgcn_readfirstlane(BLKE[160]); int tb, S; moe_tail(nblk, tb, S);
                EpiF32 E{YF, D, (f16*)(ws + WS_HFB), (nblk - tb) * 256, tb * 256};
                gemm_run(lds, HB16, DFF, DFF, nblk * 256, D, (const f16*)(W + WO_2), (size_t)D * DFF, BLKE, E, vb, nvb, tid, tb * 256, S);
            } else {
                EpiF32 E{YF, D, (f16*)(ws + WS_YF + YF_PART), ML, MC};
                gemm_run(lds, HB16, DFF, DFF, nrows, D, (const f16*)(W + WO_2D), (size_t)D * DFF, nullptr, E, vb, nvb, tid, last ? 0 : MC, 7);
            }
            SEAM(11);
        } }
        if (RUN(12)) { for (int rep_ = 0; rep_ < NREP(12); ++rep_) {
            FRESH_TID();
            LAS float* GT = (LAS float*)(lds + 73728);
            if (!last) load_gate_table(lds, layer + 1, GT, tid);
            const float* g2p = INP(I_LN2G) + layer * D; const float* b2p = INP(I_LN2B) + layer * D;
            const f16* PARTp = (const f16*)(ws + WS_YF + YF_PART);
#define LOAD_F(r_, dst_) do { if ((r_) >= ML) load_row_sum(PARTp + (size_t)((r_) - ML) * D, (size_t)MC * D, 7, dst_, lane); else load_row_h(YF + (size_t)(r_) * D, dst_, lane); } while (0)
            int m_split = 1 << 30, m_S = 1, m_trows = 0;
            if (moe) { const int nblk = __builtin_amdgcn_readfirstlane(BLKE[160]); int tb; moe_tail(nblk, tb, m_S); if (tb) { m_split = (nblk - tb) * 256; m_trows = tb * 256; } }
            const f16* MPART = (const f16*)(ws + WS_HFB);
#define LOAD_YB(d_, dst_) do { if ((d_) >= m_split) load_row_sum(MPART + (size_t)((d_) - m_split) * D, (size_t)m_trows * D, m_S, dst_, lane); else load_row_h(YF + (size_t)(d_) * D, dst_, lane); } while (0)
            f32x4 xn[4], fn0[4], fn1[4]; float2 pn = make_float2(0.f, 0.f); int2 dnn = make_int2(0, 0);
            f32x4 mgn[4];
#define LOAD_MOD2(r_) do { const float* m_ = mod_row(ws, lds, layer, (r_)); _Pragma("unroll") for (int j = 0; j < 4; ++j) mgn[j] = *(const f32x4*)(m_ + 5120 + 256 * j + 4 * lane); } while (0)
            if (gw < nrows) LOAD_MOD2(gw);
            if (gw < nrows) { load_row_h(XS + (size_t)gw * D, xn, lane);
                if (moe) { const int2 d = TOKDEST[gw]; pn = TOKP[gw]; LOAD_YB(d.x, fn0); LOAD_YB(d.y, fn1); if (gw + ngw < nrows) dnn = TOKDEST[gw + ngw]; }
                else LOAD_F(gw, fn0); }
            for (int r = gw; r < nrows; r += ngw) {
                f32x4 x[4], f[4], mg[4], msh[4], msc[4], lg_[4], lb_[4];
#pragma unroll
                for (int j = 0; j < 4; ++j) { x[j] = xn[j]; f[j] = moe ? fn0[j] * pn.x + fn1[j] * pn.y : fn0[j]; mg[j] = mgn[j]; }
                { const float* q_ = mod_row(ws, lds, last ? layer : layer + 1, r);
#pragma unroll
                  for (int j = 0; j < 4; ++j) { lg_[j] = *(const f32x4*)(g2p + 256 * j + 4 * lane); lb_[j] = *(const f32x4*)(b2p + 256 * j + 4 * lane); msh[j] = *(const f32x4*)(q_ + 256 * j + 4 * lane); msc[j] = *(const f32x4*)(q_ + 1024 + 256 * j + 4 * lane); } }
                if (r + ngw < nrows) { const int rn = r + ngw; LOAD_MOD2(rn); load_row_h(XS + (size_t)rn * D, xn, lane);
                    if (moe) { const int2 d = dnn; pn = TOKP[rn]; LOAD_YB(d.x, fn0); LOAD_YB(d.y, fn1); if (rn + ngw < nrows) dnn = TOKDEST[rn + ngw]; }
                    else LOAD_F(rn, fn0); }
#pragma unroll
                for (int j = 0; j < 4; ++j) x[j] = x[j] * ALPHA + mg[j] * f[j];
                float mean, rstd; ln_stats(x, mean, rstd);
#pragma unroll
                for (int j = 0; j < 4; ++j) { const int k = 256 * j + 4 * lane; x[j] = (x[j] - mean) * rstd * lg_[j] + lb_[j];
                    if (last) *(f32x4*)(args.out + (size_t)r * D + k) = x[j]; }
                if (!last) store_row_h(XS + (size_t)r * D, x, lane);
                if (!last) row_A_pre(ws, r, x, msh, msc, GT, lane);
            }
            if (!last) { __syncthreads(); conv_layer(ws, layer + 1, lds, gw, ngw, wave, lane, ffn_dma_items(layer + 1, nvb)); }
            SEAM(12);
        } }
#undef STEP
#undef RUN
#undef SEAM
}
__global__ void __launch_bounds__(NTHREADS, 2) mega(Args args) {
    extern __shared__ __attribute__((aligned(16))) unsigned char lds_raw[];
    LAS unsigned char* lds = (LAS unsigned char*)lds_raw;
    const int tid0 = threadIdx.x, wave0 = __builtin_amdgcn_readfirstlane(tid0 >> 6);
    const int vb0 = blockIdx.x, nvb0 = gridDim.x;
    unsigned char* ws0 = args.ws;
    unsigned* ctl = (unsigned*)(ws0 + WS_CTL);
    volatile LAS unsigned* MISC = (volatile LAS unsigned*)(lds + TAIL_OFF);
    if (tid0 < 64) MISC[tid0] = 0u;
    if (tid0 < 29) *(LAS unsigned long long*)(lds + PTAB_OFF + 8 * tid0) = (unsigned long long)args.in[tid0];
    __syncthreads();
#if MK_FUSED
    XcdBarrier bar = xcd_barrier_post(ctl + CW_BAR, MISC + 8);
#else
    XcdBarrier bar; bar.bar = ctl + CW_BAR; bar.x = 0; bar.st = MISC + 8;
#endif
    const int s_lo = args.s_lo, s_hi = args.s_hi; (void)s_lo; (void)s_hi;

    layer_body<0>(args, lds, tid0, wave0, vb0, nvb0, ws0, ctl, bar, s_lo, s_hi);
    layer_body<1>(args, lds, tid0, wave0, vb0, nvb0, ws0, ctl, bar, s_lo, s_hi);
    layer_body<2>(args, lds, tid0, wave0, vb0, nvb0, ws0, ctl, bar, s_lo, s_hi);
    layer_body<3>(args, lds, tid0, wave0, vb0, nvb0, ws0, ctl, bar, s_lo, s_hi);
}

static bool step_applicable(int layer, int p) {
    if (p == 0 || p == 1) return layer == 0;
    if (p == 9) return (layer & 1) != 0;
    return true;
}
extern "C" void kernel_launch(void* const* d_in, const int* in_sizes, int n_in, void* d_out, int out_size, void* d_ws, size_t ws_size, hipStream_t stream) {
    static int grid = 0;
    if (grid == 0) {
        if (n_in != 29 || out_size != ML * D || ws_size < WS_END) { fprintf(stderr, "kernel_launch: unexpected sizes (n_in %d out %d ws %zu need %zu)\n", n_in, out_size, ws_size, (size_t)WS_END); grid = -1; return; }
        int dev = 0, cus = 0, per_cu = 0;
        hipGetDevice(&dev); hipDeviceGetAttribute(&cus, hipDeviceAttributeMultiprocessorCount, dev);
        if (hipFuncSetAttribute((const void*)mega, hipFuncAttributeMaxDynamicSharedMemorySize, LDS_BYTES) != hipSuccess) { fprintf(stderr, "kernel_launch: hipFuncSetAttribute failed\n"); grid = -1; return; }
        if (hipOccupancyMaxActiveBlocksPerMultiprocessor(&per_cu, (const void*)mega, NTHREADS, LDS_BYTES) != hipSuccess || per_cu < 1) { fprintf(stderr, "kernel_launch: occupancy query says %d\n", per_cu); }
        (void)hipGetLastError();
        grid = cus > 0 ? cus : 256;
    }
    if (grid < 0) return;
    hipMemsetAsync((char*)d_ws + WS_CTL, 0, CTL_ZERO_BYTES, stream);
    Args a{};
    for (int i = 0; i < 29; ++i) a.in[i] = (const float*)d_in[i];
    a.out = (float*)d_out; a.ws = (unsigned char*)d_ws;
#if MK_FUSED
    a.s_lo = 0; a.s_hi = DEPTH * NPH;
    hipLaunchKernelGGL(mega, dim3(grid), dim3(NTHREADS), LDS_BYTES, stream, a);
#else
    for (int layer = 0; layer < DEPTH; ++layer)
        for (int p = 0; p < NPH; ++p) {
            if (!step_applicable(layer, p)) continue;
            a.s_lo = layer * NPH + p; a.s_hi = a.s_lo + 1;
            hipLaunchKernelGGL(mega, dim3(grid), dim3(NTHREADS), LDS_BYTES, stream, a);
        }
#endif
}
```
